# Optimizing an MI355X kernel written in HIP

```python
import jax, jax.numpy as jnp
from jax import lax
import numpy as np

D_MODEL = 1024
BATCH = 2
SEQ = 8192
DEPTH = 2

GRID_W = 64
CTX_LEN = 256
N_MIXERS = 2
N_A_LAYERS = (DEPTH + N_MIXERS - 1) // N_MIXERS
N_B_LAYERS = DEPTH // N_MIXERS
EPS = 1e-6
HG_EXPAND = 128
HG_HEADS = D_MODEL // HG_EXPAND
HG_DK = HG_EXPAND
HG_DV = D_MODEL // HG_HEADS
HG_F = HG_HEADS * HG_DK
CHUNK = 64
D_RNN = D_MODEL
LRU_BLOCKS = 4
LRU_BW = D_RNN // LRU_BLOCKS
LRU_CONV_W = 4
LRU_C = 8.0
D_FF = 2816
FFN_CONV_W = 3

kernel_name = "hybrid_hgrn2_rglru_convffn_prefix_dit"


def rmsnorm(x, g):
    xf = x.astype(jnp.float32)
    y = xf * lax.rsqrt(jnp.mean(xf * xf, axis=-1, keepdims=True) + EPS)
    return (y * g).astype(x.dtype)


def modulate(h, shift, scale):
    return h * (1.0 + scale) + shift


def dwconv(x, w, b):
    K = w.shape[0]
    right = (K - 1) // 2
    left = K - 1 - right
    T = x.shape[1]
    xp = jnp.pad(x, ((0, 0), (left, right), (0, 0)))
    return sum(w[k] * xp[:, k:k + T] for k in range(K)) + b


def _flip(t, d, axis):
    return t if d == 0 else jnp.flip(t, axis=axis)


def hgrn2_chunk_scan(q, k, v, logf, s0):
    Bn, H, T, _ = q.shape
    n = T // CHUNK
    rs = lambda t: t.reshape(Bn, H, n, CHUNK, t.shape[-1])
    q, k, v, logf = rs(q), rs(k), rs(v), rs(logf)
    b = jnp.cumsum(logf, axis=3)
    b_ref = b[:, :, :, CHUNK // 2:CHUNK // 2 + 1]
    b_last = b[:, :, :, -1:]
    qe = q * jnp.exp(b - b_ref)
    ke = k * jnp.exp(b_ref - b)
    scores = jnp.einsum('bhnik,bhnjk->bhnij', qe, ke)
    mask = jnp.tril(jnp.ones((CHUNK, CHUNK), dtype=bool))
    scores = jnp.where(mask, scores, 0.0)
    o_intra = jnp.einsum('bhnij,bhnjv->bhniv', scores, v)
    kv = jnp.einsum('bhnjk,bhnjv->bhnkv', k * jnp.exp(b_last - b), v)
    decay = jnp.exp(b_last[:, :, :, 0])

    def step(s, inp):
        dcy, u = inp
        return dcy[..., None] * s + u, s

    s_final, s_start = lax.scan(step, s0, (jnp.moveaxis(decay, 2, 0), jnp.moveaxis(kv, 2, 0)))
    s_start = jnp.moveaxis(s_start, 0, 2)
    o_inter = jnp.einsum('bhnik,bhnkv->bhniv', q * jnp.exp(b), s_start)
    o = (o_intra + o_inter).reshape(Bn, H, T, v.shape[-1])
    return o, s_final


def hgrn2_mixer(h_ctx, h_lat, w_in, lb, g_gain, w_out, need_ctx):
    def prep(h):
        Bn, T, _ = h.shape
        heads = lambda t: t.reshape(Bn, T, HG_HEADS, -1).transpose(0, 2, 1, 3)
        q, zf_fwd, zf_bwd, v, g = jnp.split(h @ w_in, 5, axis=-1)
        q = heads(jax.nn.silu(q))
        v = heads(v)
        logf, k = [], []
        for d, zf in enumerate((zf_fwd, zf_bwd)):
            f = lb[d] + (1.0 - lb[d]) * jax.nn.sigmoid(zf.astype(jnp.float32))
            logf.append(heads(jnp.log(f)))
            k.append(heads(1.0 - f))
        return q, k, v, logf, g

    qc, kc, vc, lfc, gc = prep(h_ctx)
    ql, kl, vl, lfl, gl = prep(h_lat)
    s0 = jnp.zeros((h_lat.shape[0], HG_HEADS, HG_DK, HG_DV), jnp.float32)
    o_c, o_l = 0.0, 0.0
    for d in range(2):
        oc_d, s_ctx = hgrn2_chunk_scan(_flip(qc, d, 2), _flip(kc[d], d, 2), _flip(vc, d, 2),
                                       _flip(lfc[d], d, 2), s0)
        ol_d, _ = hgrn2_chunk_scan(_flip(ql, d, 2), _flip(kl[d], d, 2), _flip(vl, d, 2),
                                   _flip(lfl[d], d, 2), s_ctx)
        o_c = o_c + _flip(oc_d, d, 2)
        o_l = o_l + _flip(ol_d, d, 2)

    def readout(o, g):
        Bn, H, T, DV = o.shape
        o = rmsnorm(o, g_gain).transpose(0, 2, 1, 3).reshape(Bn, T, H * DV)
        return (o * jax.nn.silu(g)) @ w_out

    y_c = readout(o_c, gc) if need_ctx else None
    return y_c, readout(o_l, gl)


def lru_scan(log_a, u, h0):
    a = jnp.exp(log_a)
    u = u.at[:, 0].add(a[:, 0] * h0)

    def combine(l, r):
        al, ul = l
        ar, ur = r
        return al * ar, ar * ul + ur

    _, h = lax.associative_scan(combine, (a, u), axis=1)
    return h


def rglru_mixer(h_ctx, h_lat, w_in, conv_w, conv_b, wa, ba, wx, bx, lam, w_out, need_ctx):
    Bn, T, _ = h_lat.shape
    rows = T // GRID_W
    to_cm = lambda t: t.reshape(Bn, rows, GRID_W, -1).transpose(0, 2, 1, 3).reshape(Bn, T, -1)
    from_cm = lambda t: t.reshape(Bn, GRID_W, rows, -1).transpose(0, 2, 1, 3).reshape(Bn, T, -1)

    def branch(h):
        gate, xr = jnp.split(h @ w_in, 2, axis=-1)
        return gate, dwconv(xr, conv_w, conv_b)

    def gates(xr, d):
        xb = xr.reshape(*xr.shape[:-1], LRU_BLOCKS, LRU_BW)
        r = jax.nn.sigmoid(jnp.einsum('btnk,nkj->btnj', xb, wa[d]).reshape(xr.shape) + ba[d])
        i = jax.nn.sigmoid(jnp.einsum('btnk,nkj->btnj', xb, wx[d]).reshape(xr.shape) + bx[d])
        log_a = -LRU_C * r.astype(jnp.float32) * jax.nn.softplus(-lam[d].astype(jnp.float32))
        mult = jnp.sqrt(-jnp.expm1(2.0 * log_a))
        return log_a, mult * (i * xr)

    gate_c, xc = branch(h_ctx)
    gate_l, xl = branch(to_cm(h_lat))
    h0 = jnp.zeros((Bn, D_RNN), jnp.float32)
    y_c, y_l = 0.0, 0.0
    for d in range(2):
        la_c, u_c = gates(_flip(xc, d, 1), d)
        hc = lru_scan(la_c, u_c, h0)
        la_l, u_l = gates(_flip(xl, d, 1), d)
        hl = lru_scan(la_l, u_l, hc[:, -1])
        y_c = y_c + _flip(hc, d, 1)
        y_l = y_l + _flip(hl, d, 1)
    out_l = from_cm(y_l * jax.nn.gelu(gate_l)) @ w_out
    out_c = (y_c * jax.nn.gelu(gate_c)) @ w_out if need_ctx else None
    return out_c, out_l


def conv_ffn(h, w_up, conv_w, conv_b, w_down):
    u = dwconv(h @ w_up, conv_w, conv_b)
    gate, val = jnp.split(u, 2, axis=-1)
    return (jax.nn.silu(gate) * val) @ w_down


def setup_inputs(seed: int = 0) -> dict:
    key = jax.random.key(seed)
    ks = iter(jax.random.split(key, 32))
    nrm = lambda shape, s: jax.random.normal(next(ks), shape, jnp.float32) * s
    D = D_MODEL
    a0 = jax.random.uniform(next(ks), (N_B_LAYERS, 2, D_RNN), jnp.float32, 0.9, 0.999)
    sig = a0 ** (1.0 / LRU_C)
    lam = jnp.log(sig) - jnp.log1p(-sig)
    return {
        "x": nrm((BATCH, SEQ, D), 1.0),
        "c": nrm((BATCH, D), 1.0),
        "ctx": nrm((BATCH, CTX_LEN, D), 1.0),
        "c_ctx": nrm((D,), 1.0),
        "w_ada": nrm((DEPTH, D, 6 * D), D ** -0.5),
        "b_ada": nrm((DEPTH, 6 * D), 0.02),
        "norm_g": 1.0 + nrm((DEPTH, 2, D), 0.02),
        "hg_w_in": nrm((N_A_LAYERS, D, 5 * D), D ** -0.5),
        "hg_lb_logits": nrm((N_A_LAYERS + 1, 2, HG_F), 0.1),
        "hg_gnorm": 1.0 + nrm((N_A_LAYERS, HG_DV), 0.02),
        "hg_w_out": nrm((N_A_LAYERS, D, D), D ** -0.5),
        "lru_w_in": nrm((N_B_LAYERS, D, 2 * D_RNN), D ** -0.5),
        "lru_conv_w": nrm((N_B_LAYERS, LRU_CONV_W, D_RNN), LRU_CONV_W ** -0.5),
        "lru_conv_b": nrm((N_B_LAYERS, D_RNN), 0.02),
        "lru_wa": nrm((N_B_LAYERS, 2, LRU_BLOCKS, LRU_BW, LRU_BW), LRU_BW ** -0.5),
        "lru_ba": nrm((N_B_LAYERS, 2, D_RNN), 0.02),
        "lru_wx": nrm((N_B_LAYERS, 2, LRU_BLOCKS, LRU_BW, LRU_BW), LRU_BW ** -0.5),
        "lru_bx": nrm((N_B_LAYERS, 2, D_RNN), 0.02),
        "lru_lambda": lam,
        "lru_w_out": nrm((N_B_LAYERS, D_RNN, D), D_RNN ** -0.5),
        "ffn_w_up": nrm((DEPTH, D, 2 * D_FF), D ** -0.5),
        "ffn_conv_w": nrm((DEPTH, FFN_CONV_W, 2 * D_FF), FFN_CONV_W ** -0.5),
        "ffn_conv_b": nrm((DEPTH, 2 * D_FF), 0.02),
        "ffn_w_down": nrm((DEPTH, D_FF, D), D_FF ** -0.5),
        "final_g": 1.0 + nrm((D,), 0.02),
    }


def reference(x, c, ctx, c_ctx, w_ada, b_ada, norm_g, hg_w_in, hg_lb_logits, hg_gnorm, hg_w_out,
              lru_w_in, lru_conv_w, lru_conv_b, lru_wa, lru_ba, lru_wx, lru_bx, lru_lambda, lru_w_out,
              ffn_w_up, ffn_conv_w, ffn_conv_b, ffn_w_down, final_g):
    lower_bounds = jnp.cumsum(jax.nn.softmax(hg_lb_logits.astype(jnp.float32), axis=0), axis=0)
    lat, cx = x, ctx
    sc_lat, sc_ctx = jax.nn.silu(c), jax.nn.silu(c_ctx)
    for l in range(DEPTH):
        last = l == DEPTH - 1
        m_l = (sc_lat @ w_ada[l] + b_ada[l])[:, None, :]
        m_c = sc_ctx @ w_ada[l] + b_ada[l]
        sh1, sc1, g1, sh2, sc2, g2 = jnp.split(m_l, 6, axis=-1)
        csh1, csc1, cg1, csh2, csc2, cg2 = jnp.split(m_c, 6, axis=-1)
        hl = modulate(rmsnorm(lat, norm_g[l, 0]), sh1, sc1)
        hc = modulate(rmsnorm(cx, norm_g[l, 0]), csh1, csc1)
        j = l // N_MIXERS
        if l % N_MIXERS == 0:
            yc, yl = hgrn2_mixer(hc, hl, hg_w_in[j], lower_bounds[j], hg_gnorm[j], hg_w_out[j],
                                 not last)
        else:
            yc, yl = rglru_mixer(hc, hl, lru_w_in[j], lru_conv_w[j], lru_conv_b[j], lru_wa[j],
                                 lru_ba[j], lru_wx[j], lru_bx[j], lru_lambda[j], lru_w_out[j],
                                 not last)
        lat = lat + g1 * yl
        hl = modulate(rmsnorm(lat, norm_g[l, 1]), sh2, sc2)
        lat = lat + g2 * conv_ffn(hl, ffn_w_up[l], ffn_conv_w[l], ffn_conv_b[l], ffn_w_down[l])
        if not last:
            cx = cx + cg1 * yc
            hc = modulate(rmsnorm(cx, norm_g[l, 1]), csh2, csc2)
            cx = cx + cg2 * conv_ffn(hc, ffn_w_up[l], ffn_conv_w[l], ffn_conv_b[l], ffn_w_down[l])
    return rmsnorm(lat, final_g)
```

```cpp
#include <hip/hip_runtime.h>
#include <cstdint>
#include <cstdio>

constexpr int D = 1024, BATCH = 2, SEQ = 8192, CTX = 256, GW = 64, GROWS = SEQ / GW;
constexpr int NH = 8, DK = 128, DV = 128, DFF = 2816;
constexpr int RB = CTX + SEQ;
constexpr float EPS = 1e-6f;

__device__ __forceinline__ float sigmoidf_(float x) { return 1.f / (1.f + __expf(-x)); }
__device__ __forceinline__ float siluf_(float x) { return x * sigmoidf_(x); }
__device__ __forceinline__ float gelu_tanh(float x) { const float k = 0.7978845608028654f; return 0.5f * x * (1.f + tanhf(k * (x + 0.044715f * x * x * x))); }

__global__ void k_adaln(const float* __restrict__ c, const float* __restrict__ cctx, const float* __restrict__ W, const float* __restrict__ bias, float* __restrict__ mod) {
    __shared__ float s[3][D];
    for (int i = threadIdx.x; i < D; i += blockDim.x) { s[0][i] = siluf_(c[i]); s[1][i] = siluf_(c[D + i]); s[2][i] = siluf_(cctx[i]); }
    __syncthreads();
    const int j = blockIdx.x * blockDim.x + threadIdx.x;
    if (j >= 6 * D) return;
    float a0 = 0.f, a1 = 0.f, a2 = 0.f;
    for (int k = 0; k < D; ++k) { const float w = W[(size_t)k * 6 * D + j]; a0 += s[0][k] * w; a1 += s[1][k] * w; a2 += s[2][k] * w; }
    const float bb = bias[j];
    mod[j] = a0 + bb; mod[6 * D + j] = a1 + bb; mod[12 * D + j] = a2 + bb;
}

__global__ void k_lb(const float* __restrict__ logits, float* __restrict__ lb) {
    const int i = blockIdx.x * blockDim.x + threadIdx.x;
    if (i >= 2 * D) return;
    const float l0 = logits[i], l1 = logits[2 * D + i];
    const float m = fmaxf(l0, l1), e0 = __expf(l0 - m), e1 = __expf(l1 - m);
    lb[i] = e0 / (e0 + e1);
}

__global__ void k_norm_mod(const float* in, float* out, const float* __restrict__ g, const float* __restrict__ sh, const float* __restrict__ sc, int rows) {
    const int r = blockIdx.x; if (r >= rows) return;
    const float* x = in + (size_t)r * D; float* o = out + (size_t)r * D;
    float v[4]; float ss = 0.f;
    for (int i = 0; i < 4; ++i) { v[i] = x[threadIdx.x + 256 * i]; ss += v[i] * v[i]; }
    __shared__ float red[256];
    red[threadIdx.x] = ss; __syncthreads();
    for (int s = 128; s > 0; s >>= 1) { if (threadIdx.x < s) red[threadIdx.x] += red[threadIdx.x + s]; __syncthreads(); }
    const float rstd = rsqrtf(red[0] / D + EPS);
    for (int i = 0; i < 4; ++i) { const int cidx = threadIdx.x + 256 * i; float y = v[i] * rstd * g[cidx]; if (sc) y = y * (1.f + sc[cidx]) + sh[cidx]; o[cidx] = y; }
}

__global__ void __launch_bounds__(256) k_gemm(const float* __restrict__ A, int lda, const float* __restrict__ B, int ldb, float* __restrict__ C, int ldc, int M, int N, int K) {
    __shared__ float As[16][64 + 4], Bs[16][64 + 4];
    const int tx = threadIdx.x % 16, ty = threadIdx.x / 16;
    const int m0 = blockIdx.y * 64, n0 = blockIdx.x * 64;
    float acc[4][4] = {};
    for (int k0 = 0; k0 < K; k0 += 16) {
        for (int i = threadIdx.x; i < 64 * 16; i += 256) { const int r = i / 16, kk = i % 16; As[kk][r] = (m0 + r < M) ? A[(size_t)(m0 + r) * lda + k0 + kk] : 0.f; }
        for (int i = threadIdx.x; i < 64 * 16; i += 256) { const int kk = i / 64, cc = i % 64; Bs[kk][cc] = B[(size_t)(k0 + kk) * ldb + n0 + cc]; }
        __syncthreads();
#pragma unroll
        for (int kk = 0; kk < 16; ++kk) {
            float a[4], b[4];
#pragma unroll
            for (int i = 0; i < 4; ++i) { a[i] = As[kk][ty * 4 + i]; b[i] = Bs[kk][tx * 4 + i]; }
#pragma unroll
            for (int i = 0; i < 4; ++i)
#pragma unroll
                for (int j = 0; j < 4; ++j) acc[i][j] += a[i] * b[j];
        }
        __syncthreads();
    }
    for (int i = 0; i < 4; ++i) { const int r = m0 + ty * 4 + i; if (r < M) for (int j = 0; j < 4; ++j) C[(size_t)r * ldc + n0 + tx * 4 + j] = acc[i][j]; }
}

__global__ void __launch_bounds__(128) k_hgrn_scan(const float* __restrict__ Z, const float* __restrict__ lb, float* __restrict__ Of, float* __restrict__ Ob) {
    const int h = blockIdx.x, d = blockIdx.y, t = threadIdx.x;
    float* O = d ? Ob : Of;
    __shared__ float sq[DK], sf[DK], sk[DK];
    float S[DK];
#pragma unroll
    for (int i = 0; i < DK; ++i) S[i] = 0.f;
    const float lbv = lb[d * D + h * DK + t];
    for (int step = 0; step < RB; ++step) {
        int row;
        if (step < CTX) row = d ? (CTX - 1 - step) : step;
        else { const int s = step - CTX; row = CTX + (d ? (SEQ - 1 - s) : s); }
        const float* z = Z + (size_t)row * 5 * D;
        const float qv = siluf_(z[h * DK + t]);
        const float f = lbv + (1.f - lbv) * sigmoidf_(z[(1 + d) * D + h * DK + t]);
        sq[t] = qv; sf[t] = f; sk[t] = 1.f - f;
        const float v = z[3 * D + h * DV + t];
        __syncthreads();
        float o = 0.f;
#pragma unroll
        for (int i = 0; i < DK; ++i) { S[i] = sf[i] * S[i] + sk[i] * v; o += sq[i] * S[i]; }
        O[(size_t)row * D + h * DV + t] = o;
        __syncthreads();
    }
}

__global__ void __launch_bounds__(128) k_hgrn_readout(const float* Of, const float* Ob, const float* __restrict__ Z, const float* __restrict__ gn, float* R, int rows) {
    const int r = blockIdx.x; if (r >= rows) return;
    __shared__ float red[128];
    for (int h = 0; h < NH; ++h) {
        const int cidx = h * DV + threadIdx.x;
        const float o = Of[(size_t)r * D + cidx] + Ob[(size_t)r * D + cidx];
        red[threadIdx.x] = o * o; __syncthreads();
        for (int s = 64; s > 0; s >>= 1) { if (threadIdx.x < s) red[threadIdx.x] += red[threadIdx.x + s]; __syncthreads(); }
        const float rstd = rsqrtf(red[0] / DV + EPS);
        __syncthreads();
        const float gte = siluf_(Z[(size_t)r * 5 * D + 4 * D + cidx]);
        R[(size_t)r * D + cidx] = o * rstd * gn[threadIdx.x] * gte;
    }
}

__global__ void k_resid(const float* base, const float* Y, const float* __restrict__ gate, float* out, size_t n) {
    const size_t i = (size_t)blockIdx.x * blockDim.x + threadIdx.x; if (i >= n) return;
    out[i] = base[i] + gate[i % D] * Y[i];
}

__global__ void k_ffn_conv(const float* __restrict__ U, int urow0, const float* __restrict__ cw, const float* __restrict__ cb, float* __restrict__ G, int r0, int r1, int seq_len) {
    const size_t i = (size_t)blockIdx.x * blockDim.x + threadIdx.x;
    const size_t n = (size_t)(r1 - r0) * DFF; if (i >= n) return;
    const int r = r0 + (int)(i / DFF), cidx = (int)(i % DFF);
    float u[2];
    for (int half = 0; half < 2; ++half) {
        const int cc = cidx + half * DFF; float a = cb[cc];
        for (int k = 0; k < 3; ++k) { const int rr = r + k - 1; if (rr >= 0 && rr < seq_len) a += cw[k * 2 * DFF + cc] * U[(size_t)(rr - urow0) * 2 * DFF + cc]; }
        u[half] = a;
    }
    G[i] = siluf_(u[0]) * u[1];
}

__device__ __forceinline__ int lat_row_of_cm(int p) { return CTX + (p % GROWS) * GW + p / GROWS; }
__global__ void k_lru_conv(const float* __restrict__ Z2, const float* __restrict__ cw, const float* __restrict__ cb, float* __restrict__ XC) {
    const size_t i = (size_t)blockIdx.x * blockDim.x + threadIdx.x; if (i >= (size_t)RB * D) return;
    const int pos = (int)(i / D), cidx = (int)(i % D);
    float a = cb[cidx];
    if (pos < CTX) { for (int k = 0; k < 4; ++k) { const int pp = pos + k - 2; if (pp >= 0 && pp < CTX) a += cw[k * D + cidx] * Z2[(size_t)pp * 2 * D + D + cidx]; } }
    else { const int p = pos - CTX; for (int k = 0; k < 4; ++k) { const int pp = p + k - 2; if (pp >= 0 && pp < SEQ) a += cw[k * D + cidx] * Z2[(size_t)lat_row_of_cm(pp) * 2 * D + D + cidx]; } }
    XC[i] = a;
}
__global__ void k_lru_scan(const float* __restrict__ XC, const float* __restrict__ PA, const float* __restrict__ PX, const float* __restrict__ ba, const float* __restrict__ bx, const float* __restrict__ lam, float* __restrict__ Hd, int d) {
    const int cidx = blockIdx.x * blockDim.x + threadIdx.x; if (cidx >= D) return;
    const float bav = ba[d * D + cidx], bxv = bx[d * D + cidx];
    const float l = lam[d * D + cidx]; const float sp = (l > 0.f) ? log1pf(__expf(-l)) : (-l + log1pf(__expf(l)));
    float h = 0.f;
    for (int step = 0; step < RB; ++step) {
        int pos;
        if (step < CTX) pos = d ? (CTX - 1 - step) : step;
        else { const int s = step - CTX; pos = CTX + (d ? (SEQ - 1 - s) : s); }
        const size_t o = (size_t)pos * D + cidx;
        const float r = sigmoidf_(PA[o] + bav), ig = sigmoidf_(PX[o] + bxv);
        const float la = -8.f * r * sp; const float a = __expf(la); const float mult = sqrtf(-expm1f(2.f * la));
        h = a * h + mult * (ig * XC[o]);
        Hd[o] = h;
    }
}
__global__ void k_lru_out(const float* __restrict__ Hf, const float* __restrict__ Hb, const float* __restrict__ Z2, float* __restrict__ Y) {
    const size_t i = (size_t)blockIdx.x * blockDim.x + threadIdx.x; if (i >= (size_t)SEQ * D) return;
    const int t = (int)(i / D), cidx = (int)(i % D);
    const int p = (t % GW) * GROWS + t / GW; const size_t o = (size_t)(CTX + p) * D + cidx;
    Y[i] = (Hf[o] + Hb[o]) * gelu_tanh(Z2[(size_t)(CTX + t) * 2 * D + cidx]);
}
__global__ void k_copy(const float* __restrict__ a, float* __restrict__ b, size_t n) { const size_t i = (size_t)blockIdx.x * blockDim.x + threadIdx.x; if (i < n) b[i] = a[i]; }

static void gemm(hipStream_t s, const float* A, int lda, const float* B, int ldb, float* C, int ldc, int M, int N, int K) {
    dim3 g(N / 64, (M + 63) / 64);
    hipLaunchKernelGGL(k_gemm, g, dim3(256), 0, s, A, lda, B, ldb, C, ldc, M, N, K);
}

extern "C" void kernel_launch(void* const* d_in, const int* in_sizes, int n_in, void* d_out, int out_size, void* d_ws, size_t ws_size, hipStream_t stream) {
    const float* x = (const float*)d_in[0]; const float* c = (const float*)d_in[1]; const float* ctx = (const float*)d_in[2]; const float* cctx = (const float*)d_in[3];
    const float* w_ada = (const float*)d_in[4]; const float* b_ada = (const float*)d_in[5]; const float* norm_g = (const float*)d_in[6];
    const float* hg_w_in = (const float*)d_in[7]; const float* hg_lb = (const float*)d_in[8]; const float* hg_gn = (const float*)d_in[9]; const float* hg_w_out = (const float*)d_in[10];
    const float* lru_w_in = (const float*)d_in[11]; const float* lru_cw = (const float*)d_in[12]; const float* lru_cb = (const float*)d_in[13];
    const float* lru_wa = (const float*)d_in[14]; const float* lru_ba = (const float*)d_in[15]; const float* lru_wx = (const float*)d_in[16]; const float* lru_bx = (const float*)d_in[17];
    const float* lru_lam = (const float*)d_in[18]; const float* lru_w_out = (const float*)d_in[19];
    const float* ffn_up = (const float*)d_in[20]; const float* ffn_cw = (const float*)d_in[21]; const float* ffn_cb = (const float*)d_in[22]; const float* ffn_down = (const float*)d_in[23];
    const float* final_g = (const float*)d_in[24];
    float* out = (float*)d_out;
    char* ws = (char*)d_ws;
    const size_t MB = 1u << 20;
    float* CXLAT = (float*)(ws);
    float* MOD = (float*)(ws + 2 * MB);
    float* LB = (float*)(ws + 2 * MB + 256 * 1024);
    char* arena = ws + 3 * MB;
    const size_t RBD = (size_t)RB * D * 4;
    float* BUF_H = (float*)(arena);
    float* BUF_O = (float*)(arena + RBD);
    float* BUF_Z = (float*)(arena + 2 * RBD);

    for (int l = 0; l < 2; ++l)
        hipLaunchKernelGGL(k_adaln, dim3(6 * D / 256), dim3(256), 0, stream, c, cctx, w_ada + (size_t)l * D * 6 * D, b_ada + (size_t)l * 6 * D, MOD + (size_t)l * 18 * D);
    hipLaunchKernelGGL(k_lb, dim3(2 * D / 256), dim3(256), 0, stream, hg_lb, LB);
    {
        const size_t n = (size_t)BATCH * SEQ * D; hipLaunchKernelGGL(k_copy, dim3((n + 255) / 256), dim3(256), 0, stream, x, out, n);
        const size_t n2 = (size_t)BATCH * CTX * D; hipLaunchKernelGGL(k_copy, dim3((n2 + 255) / 256), dim3(256), 0, stream, ctx, CXLAT, n2);
    }
    auto ffn = [&](int l, float* lat_seq, int seq_len, const float* modv) {
        const float* sh2 = modv + 3 * D; const float* sc2 = modv + 4 * D; const float* g2 = modv + 5 * D;
        const float* Wup = ffn_up + (size_t)l * D * 2 * DFF; const float* Wdn = ffn_down + (size_t)l * DFF * D;
        const float* cw = ffn_cw + (size_t)l * 3 * 2 * DFF; const float* cb = ffn_cb + (size_t)l * 2 * DFF;
        float* Hn = BUF_H;
        hipLaunchKernelGGL(k_norm_mod, dim3(seq_len), dim3(256), 0, stream, lat_seq, Hn, norm_g + (size_t)(l * 2 + 1) * D, sh2, sc2, seq_len);
        const int CH = 2048;
        float* U = BUF_Z;
        float* G = BUF_Z + (size_t)(CH + 2) * 2 * DFF;
        float* Y = G + (size_t)CH * DFF;
        for (int r0 = 0; r0 < seq_len; r0 += CH) {
            const int r1 = (r0 + CH < seq_len) ? r0 + CH : seq_len;
            const int u0 = r0 > 0 ? r0 - 1 : 0, u1 = r1 < seq_len ? r1 + 1 : seq_len;
            gemm(stream, Hn + (size_t)u0 * D, D, Wup, 2 * DFF, U, 2 * DFF, u1 - u0, 2 * DFF, D);
            const size_t n = (size_t)(r1 - r0) * DFF;
            hipLaunchKernelGGL(k_ffn_conv, dim3((n + 255) / 256), dim3(256), 0, stream, U, u0, cw, cb, G, r0, r1, seq_len);
            gemm(stream, G, DFF, Wdn, D, Y, D, r1 - r0, D, DFF);
            const size_t n2 = (size_t)(r1 - r0) * D;
            hipLaunchKernelGGL(k_resid, dim3((n2 + 255) / 256), dim3(256), 0, stream, lat_seq + (size_t)r0 * D, Y, g2, lat_seq + (size_t)r0 * D, n2);
        }
    };

    for (int b = 0; b < BATCH; ++b) {
        float* latL = out + (size_t)b * SEQ * D; float* latC = CXLAT + (size_t)b * CTX * D;
        {
            const float* modL = MOD + (size_t)b * 6 * D; const float* modC = MOD + (size_t)2 * 6 * D;
            hipLaunchKernelGGL(k_norm_mod, dim3(CTX), dim3(256), 0, stream, latC, BUF_H, norm_g, modC, modC + D, CTX);
            hipLaunchKernelGGL(k_norm_mod, dim3(SEQ), dim3(256), 0, stream, latL, BUF_H + (size_t)CTX * D, norm_g, modL, modL + D, SEQ);
            gemm(stream, BUF_H, D, hg_w_in, 5 * D, BUF_Z, 5 * D, RB, 5 * D, D);
            hipLaunchKernelGGL(k_hgrn_scan, dim3(NH, 2), dim3(128), 0, stream, BUF_Z, LB, BUF_H, BUF_O);
            hipLaunchKernelGGL(k_hgrn_readout, dim3(RB), dim3(128), 0, stream, BUF_H, BUF_O, BUF_Z, hg_gn, BUF_H, RB);
            gemm(stream, BUF_H, D, hg_w_out, D, BUF_O, D, RB, D, D);
            { const size_t n = (size_t)CTX * D; hipLaunchKernelGGL(k_resid, dim3((n + 255) / 256), dim3(256), 0, stream, latC, BUF_O, modC + 2 * D, latC, n); }
            { const size_t n = (size_t)SEQ * D; hipLaunchKernelGGL(k_resid, dim3((n + 255) / 256), dim3(256), 0, stream, latL, BUF_O + (size_t)CTX * D, modL + 2 * D, latL, n); }
            ffn(0, latL, SEQ, modL);
            ffn(0, latC, CTX, modC);
        }
        {
            const float* modL = MOD + (size_t)18 * D + (size_t)b * 6 * D; const float* modC = MOD + (size_t)18 * D + (size_t)2 * 6 * D;
            const float* ng = norm_g + (size_t)2 * D;
            hipLaunchKernelGGL(k_norm_mod, dim3(CTX), dim3(256), 0, stream, latC, BUF_H, ng, modC, modC + D, CTX);
            hipLaunchKernelGGL(k_norm_mod, dim3(SEQ), dim3(256), 0, stream, latL, BUF_H + (size_t)CTX * D, ng, modL, modL + D, SEQ);
            float* Z2 = BUF_Z;
            float* XC = BUF_Z + (size_t)RB * 2 * D;
            float* PA = XC + (size_t)RB * D;
            float* PX = PA + (size_t)RB * D;
            float* Hf = BUF_H; float* Hb = BUF_O;
            gemm(stream, BUF_H, D, lru_w_in, 2 * D, Z2, 2 * D, RB, 2 * D, D);
            { const size_t n = (size_t)RB * D; hipLaunchKernelGGL(k_lru_conv, dim3((n + 255) / 256), dim3(256), 0, stream, Z2, lru_cw, lru_cb, XC); }
            for (int d = 0; d < 2; ++d) {
                for (int nb = 0; nb < 4; ++nb) {
                    gemm(stream, XC + nb * 256, D, lru_wa + (size_t)(d * 4 + nb) * 256 * 256, 256, PA + nb * 256, D, RB, 256, 256);
                    gemm(stream, XC + nb * 256, D, lru_wx + (size_t)(d * 4 + nb) * 256 * 256, 256, PX + nb * 256, D, RB, 256, 256);
                }
                hipLaunchKernelGGL(k_lru_scan, dim3(D / 64), dim3(64), 0, stream, XC, PA, PX, lru_ba, lru_bx, lru_lam, d ? Hb : Hf, d);
            }
            float* Y = PA;
            { const size_t n = (size_t)SEQ * D; hipLaunchKernelGGL(k_lru_out, dim3((n + 255) / 256), dim3(256), 0, stream, Hf, Hb, Z2, Y); }
            float* Y2 = PX;
            gemm(stream, Y, D, lru_w_out, D, Y2, D, SEQ, D, D);
            { const size_t n = (size_t)SEQ * D; hipLaunchKernelGGL(k_resid, dim3((n + 255) / 256), dim3(256), 0, stream, latL, Y2, modL + 2 * D, latL, n); }
            ffn(1, latL, SEQ, modL);
        }
        hipLaunchKernelGGL(k_norm_mod, dim3(SEQ), dim3(256), 0, stream, latL, latL, final_g, (const float*)nullptr, (const float*)nullptr, SEQ);
    }
}
```

```cpp
#define MK_CUT 4
#define MK_ONE_LAUNCH 1
#include <hip/hip_runtime.h>
#include <cstdint>
#include <cstdio>

constexpr int D = 1024, BATCH = 2, SEQ = 8192, CTX = 256, GW = 64, GROWS = SEQ / GW;
constexpr int NH = 8, DK = 128, DV = 128, DFF = 2816;
constexpr int RB = CTX + SEQ;
constexpr float EPS = 1e-6f;

__device__ __forceinline__ float sigmoidf_(float x) { return 1.f / (1.f + __expf(-x)); }
__device__ __forceinline__ float siluf_(float x) { return x * sigmoidf_(x); }
__device__ __forceinline__ float gelu_tanh(float x) { const float k = 0.7978845608028654f; return 0.5f * x * (1.f + tanhf(k * (x + 0.044715f * x * x * x))); }

__global__ void k_adaln(const float* __restrict__ c, const float* __restrict__ cctx, const float* __restrict__ W, const float* __restrict__ bias, float* __restrict__ mod) {
    __shared__ float s[3][D];
    for (int i = threadIdx.x; i < D; i += blockDim.x) { s[0][i] = siluf_(c[i]); s[1][i] = siluf_(c[D + i]); s[2][i] = siluf_(cctx[i]); }
    __syncthreads();
    const int j = blockIdx.x * blockDim.x + threadIdx.x;
    if (j >= 6 * D) return;
    float a0 = 0.f, a1 = 0.f, a2 = 0.f;
    for (int k = 0; k < D; ++k) { const float w = W[(size_t)k * 6 * D + j]; a0 += s[0][k] * w; a1 += s[1][k] * w; a2 += s[2][k] * w; }
    const float bb = bias[j];
    mod[j] = a0 + bb; mod[6 * D + j] = a1 + bb; mod[12 * D + j] = a2 + bb;
}

__global__ void k_lb(const float* __restrict__ logits, float* __restrict__ lb) {
    const int i = blockIdx.x * blockDim.x + threadIdx.x;
    if (i >= 2 * D) return;
    const float l0 = logits[i], l1 = logits[2 * D + i];
    const float m = fmaxf(l0, l1), e0 = __expf(l0 - m), e1 = __expf(l1 - m);
    lb[i] = e0 / (e0 + e1);
}

__global__ void k_norm_mod(const float* in, float* out, const float* __restrict__ g, const float* __restrict__ sh, const float* __restrict__ sc, int rows) {
    const int r = blockIdx.x; if (r >= rows) return;
    const float* x = in + (size_t)r * D; float* o = out + (size_t)r * D;
    float v[4]; float ss = 0.f;
    for (int i = 0; i < 4; ++i) { v[i] = x[threadIdx.x + 256 * i]; ss += v[i] * v[i]; }
    __shared__ float red[256];
    red[threadIdx.x] = ss; __syncthreads();
    for (int s = 128; s > 0; s >>= 1) { if (threadIdx.x < s) red[threadIdx.x] += red[threadIdx.x + s]; __syncthreads(); }
    const float rstd = rsqrtf(red[0] / D + EPS);
    for (int i = 0; i < 4; ++i) { const int cidx = threadIdx.x + 256 * i; float y = v[i] * rstd * g[cidx]; if (sc) y = y * (1.f + sc[cidx]) + sh[cidx]; o[cidx] = y; }
}

__global__ void __launch_bounds__(256) k_gemm(const float* __restrict__ A, int lda, const float* __restrict__ B, int ldb, float* __restrict__ C, int ldc, int M, int N, int K) {
    __shared__ float As[16][64 + 4], Bs[16][64 + 4];
    const int tx = threadIdx.x % 16, ty = threadIdx.x / 16;
    const int m0 = blockIdx.y * 64, n0 = blockIdx.x * 64;
    float acc[4][4] = {};
    for (int k0 = 0; k0 < K; k0 += 16) {
        for (int i = threadIdx.x; i < 64 * 16; i += 256) { const int r = i / 16, kk = i % 16; As[kk][r] = (m0 + r < M) ? A[(size_t)(m0 + r) * lda + k0 + kk] : 0.f; }
        for (int i = threadIdx.x; i < 64 * 16; i += 256) { const int kk = i / 64, cc = i % 64; Bs[kk][cc] = B[(size_t)(k0 + kk) * ldb + n0 + cc]; }
        __syncthreads();
#pragma unroll
        for (int kk = 0; kk < 16; ++kk) {
            float a[4], b[4];
#pragma unroll
            for (int i = 0; i < 4; ++i) { a[i] = As[kk][ty * 4 + i]; b[i] = Bs[kk][tx * 4 + i]; }
#pragma unroll
            for (int i = 0; i < 4; ++i)
#pragma unroll
                for (int j = 0; j < 4; ++j) acc[i][j] += a[i] * b[j];
        }
        __syncthreads();
    }
    for (int i = 0; i < 4; ++i) { const int r = m0 + ty * 4 + i; if (r < M) for (int j = 0; j < 4; ++j) C[(size_t)r * ldc + n0 + tx * 4 + j] = acc[i][j]; }
}

__global__ void __launch_bounds__(128) k_hgrn_scan(const float* __restrict__ Z, const float* __restrict__ lb, float* __restrict__ Of, float* __restrict__ Ob) {
    const int h = blockIdx.x, d = blockIdx.y, t = threadIdx.x;
    float* O = d ? Ob : Of;
    __shared__ float sq[DK], sf[DK], sk[DK];
    float S[DK];
#pragma unroll
    for (int i = 0; i < DK; ++i) S[i] = 0.f;
    const float lbv = lb[d * D + h * DK + t];
    for (int step = 0; step < RB; ++step) {
        int row;
        if (step < CTX) row = d ? (CTX - 1 - step) : step;
        else { const int s = step - CTX; row = CTX + (d ? (SEQ - 1 - s) : s); }
        const float* z = Z + (size_t)row * 5 * D;
        const float qv = siluf_(z[h * DK + t]);
        const float f = lbv + (1.f - lbv) * sigmoidf_(z[(1 + d) * D + h * DK + t]);
        sq[t] = qv; sf[t] = f; sk[t] = 1.f - f;
        const float v = z[3 * D + h * DV + t];
        __syncthreads();
        float o = 0.f;
#pragma unroll
        for (int i = 0; i < DK; ++i) { S[i] = sf[i] * S[i] + sk[i] * v; o += sq[i] * S[i]; }
        O[(size_t)row * D + h * DV + t] = o;
        __syncthreads();
    }
}

__global__ void __launch_bounds__(128) k_hgrn_readout(const float* Of, const float* Ob, const float* __restrict__ Z, const float* __restrict__ gn, float* R, int rows) {
    const int r = blockIdx.x; if (r >= rows) return;
    __shared__ float red[128];
    for (int h = 0; h < NH; ++h) {
        const int cidx = h * DV + threadIdx.x;
        const float o = Of[(size_t)r * D + cidx] + Ob[(size_t)r * D + cidx];
        red[threadIdx.x] = o * o; __syncthreads();
        for (int s = 64; s > 0; s >>= 1) { if (threadIdx.x < s) red[threadIdx.x] += red[threadIdx.x + s]; __syncthreads(); }
        const float rstd = rsqrtf(red[0] / DV + EPS);
        __syncthreads();
        const float gte = siluf_(Z[(size_t)r * 5 * D + 4 * D + cidx]);
        R[(size_t)r * D + cidx] = o * rstd * gn[threadIdx.x] * gte;
    }
}

__global__ void k_resid(const float* base, const float* Y, const float* __restrict__ gate, float* out, size_t n) {
    const size_t i = (size_t)blockIdx.x * blockDim.x + threadIdx.x; if (i >= n) return;
    out[i] = base[i] + gate[i % D] * Y[i];
}

__global__ void k_ffn_conv(const float* __restrict__ U, int urow0, const float* __restrict__ cw, const float* __restrict__ cb, float* __restrict__ G, int r0, int r1, int seq_len) {
    const size_t i = (size_t)blockIdx.x * blockDim.x + threadIdx.x;
    const size_t n = (size_t)(r1 - r0) * DFF; if (i >= n) return;
    const int r = r0 + (int)(i / DFF), cidx = (int)(i % DFF);
    float u[2];
    for (int half = 0; half < 2; ++half) {
        const int cc = cidx + half * DFF; float a = cb[cc];
        for (int k = 0; k < 3; ++k) { const int rr = r + k - 1; if (rr >= 0 && rr < seq_len) a += cw[k * 2 * DFF + cc] * U[(size_t)(rr - urow0) * 2 * DFF + cc]; }
        u[half] = a;
    }
    G[i] = siluf_(u[0]) * u[1];
}

__device__ __forceinline__ int lat_row_of_cm(int p) { return CTX + (p % GROWS) * GW + p / GROWS; }
__global__ void k_lru_conv(const float* __restrict__ Z2, const float* __restrict__ cw, const float* __restrict__ cb, float* __restrict__ XC) {
    const size_t i = (size_t)blockIdx.x * blockDim.x + threadIdx.x; if (i >= (size_t)RB * D) return;
    const int pos = (int)(i / D), cidx = (int)(i % D);
    float a = cb[cidx];
    if (pos < CTX) { for (int k = 0; k < 4; ++k) { const int pp = pos + k - 2; if (pp >= 0 && pp < CTX) a += cw[k * D + cidx] * Z2[(size_t)pp * 2 * D + D + cidx]; } }
    else { const int p = pos - CTX; for (int k = 0; k < 4; ++k) { const int pp = p + k - 2; if (pp >= 0 && pp < SEQ) a += cw[k * D + cidx] * Z2[(size_t)lat_row_of_cm(pp) * 2 * D + D + cidx]; } }
    XC[i] = a;
}
__global__ void k_lru_scan(const float* __restrict__ XC, const float* __restrict__ PA, const float* __restrict__ PX, const float* __restrict__ ba, const float* __restrict__ bx, const float* __restrict__ lam, float* __restrict__ Hd, int d) {
    const int cidx = blockIdx.x * blockDim.x + threadIdx.x; if (cidx >= D) return;
    const float bav = ba[d * D + cidx], bxv = bx[d * D + cidx];
    const float l = lam[d * D + cidx]; const float sp = (l > 0.f) ? log1pf(__expf(-l)) : (-l + log1pf(__expf(l)));
    float h = 0.f;
    for (int step = 0; step < RB; ++step) {
        int pos;
        if (step < CTX) pos = d ? (CTX - 1 - step) : step;
        else { const int s = step - CTX; pos = CTX + (d ? (SEQ - 1 - s) : s); }
        const size_t o = (size_t)pos * D + cidx;
        const float r = sigmoidf_(PA[o] + bav), ig = sigmoidf_(PX[o] + bxv);
        const float la = -8.f * r * sp; const float a = __expf(la); const float mult = sqrtf(-expm1f(2.f * la));
        h = a * h + mult * (ig * XC[o]);
        Hd[o] = h;
    }
}
__global__ void k_lru_out(const float* __restrict__ Hf, const float* __restrict__ Hb, const float* __restrict__ Z2, float* __restrict__ Y) {
    const size_t i = (size_t)blockIdx.x * blockDim.x + threadIdx.x; if (i >= (size_t)SEQ * D) return;
    const int t = (int)(i / D), cidx = (int)(i % D);
    const int p = (t % GW) * GROWS + t / GW; const size_t o = (size_t)(CTX + p) * D + cidx;
    Y[i] = (Hf[o] + Hb[o]) * gelu_tanh(Z2[(size_t)(CTX + t) * 2 * D + cidx]);
}
__global__ void k_copy(const float* __restrict__ a, float* __restrict__ b, size_t n) { const size_t i = (size_t)blockIdx.x * blockDim.x + threadIdx.x; if (i < n) b[i] = a[i]; }


namespace mk {
#define LAS __attribute__((address_space(3)))
typedef unsigned short bf16_t;
typedef short bf16x8 __attribute__((ext_vector_type(8)));
typedef short s16x4 __attribute__((ext_vector_type(4)));
typedef float f32x4 __attribute__((ext_vector_type(4)));
typedef float f32x2 __attribute__((ext_vector_type(2)));
typedef unsigned u32x4 __attribute__((ext_vector_type(4)));
typedef unsigned u32x2 __attribute__((ext_vector_type(2)));

constexpr int NWAVES = 8, NTHR = 512;
constexpr int MT = 16896, ML = 16384, NTM = 66;
constexpr size_t MiB = 1u << 20;
constexpr size_t WS_CTL = 0;
constexpr size_t WS_MOD = 1 * MiB;
constexpr size_t WS_LB = WS_MOD + 160 * 1024;
constexpr size_t WS_CXLAT = 2 * MiB;
constexpr size_t WS_SIDE = 4 * MiB;
constexpr size_t WS_UEDGE = 10 * MiB + 512 * 1024;
constexpr size_t WS_W_HGIN = 14 * MiB, WS_W_HGOUT = 24 * MiB, WS_W_UP = 26 * MiB, WS_W_DN0 = 37 * MiB;
constexpr size_t WS_W_LRUIN = 43 * MiB, WS_W_GATES = 47 * MiB, WS_W_LRUOUT = 49 * MiB, WS_W_DN1 = 51 * MiB;
constexpr size_t WS_ACT = 57 * MiB, ACT_SLOT = 33 * MiB;
constexpr int CW_BAR = 4096;
constexpr int STAGE_BYTES = 131072;
constexpr int EPI_OFF = STAGE_BYTES;
constexpr int MISC_OFF = STAGE_BYTES + 12288;
constexpr int LDS_BYTES = 147456;

#define LDS_WAIT() asm volatile("s_waitcnt lgkmcnt(0)" ::: "memory")
#define VM_WAIT() asm volatile("s_waitcnt vmcnt(0)" ::: "memory")
__device__ __forceinline__ unsigned f2bf(float f) { unsigned u = __builtin_bit_cast(unsigned, f); return (u + 0x7fffu + ((u >> 16) & 1u)) >> 16; }
__device__ __forceinline__ unsigned pk2(float lo, float hi) { return f2bf(lo) | (f2bf(hi) << 16); }
__device__ __forceinline__ float bf2f(unsigned short h) { return __builtin_bit_cast(float, (unsigned)h << 16); }
__device__ __forceinline__ float bflo(unsigned w) { return __builtin_bit_cast(float, w << 16); }
__device__ __forceinline__ float bfhi(unsigned w) { return __builtin_bit_cast(float, w & 0xffff0000u); }
__device__ __forceinline__ float fsigmoid(float x) { return __builtin_amdgcn_rcpf(1.f + __expf(-x)); }
__device__ __forceinline__ float fsilu(float x) { return x * fsigmoid(x); }
__device__ __forceinline__ float fgelu_tanh(float x) { const float u = 0.7978845608028654f * (x + 0.044715f * x * x * x); const float e = __expf(2.f * u); return x * (1.f - __builtin_amdgcn_rcpf(e + 1.f)); }
__device__ __forceinline__ int lane_id_v() { int le; asm volatile("v_mbcnt_lo_u32_b32 %0, -1, 0\n\tv_mbcnt_hi_u32_b32 %0, -1, %0" : "=v"(le)); return le; }
__device__ __forceinline__ float wave_sum(float v) {
#pragma unroll
    for (int o = 1; o < 64; o <<= 1) v += __shfl_xor(v, o);
    return v;
}

#define XB_TMO      128
#define XB_XCNT(j)  (256  + 64 * (j))
#define XB_XSUB(j)  (1280 + 64 * (j))
#define XB_XGEN(j)  (2304 + 64 * (j))
#define XB_TOP      3328
#define XB_TOPGEN   3392
#define XCD_BAR_WORDS 3456
#define XB_SPIN_CAP (1u << 20)
__device__ __forceinline__ unsigned xb_ld(unsigned* p)              { return __hip_atomic_load(p, __ATOMIC_RELAXED, __HIP_MEMORY_SCOPE_AGENT); }
__device__ __forceinline__ unsigned xb_add(unsigned* p, unsigned v) { return __hip_atomic_fetch_add(p, v, __ATOMIC_RELAXED, __HIP_MEMORY_SCOPE_AGENT); }
__device__ __forceinline__ unsigned xb_xcc_id() { return (unsigned)__builtin_amdgcn_s_getreg((3 << 11) | 20) & 0xFu; }
#define XB_SPIN(cond, bar) do { unsigned _sp = 0; while (cond) { __builtin_amdgcn_s_sleep(1); \
    if ((++_sp & 255u) == 0u) { if (xb_ld(&(bar)[XB_TMO])) break; if (_sp > XB_SPIN_CAP) { atomicAdd(&(bar)[XB_TMO], 1u); break; } } } } while (0)
struct XcdBarrier { unsigned* bar; unsigned x; volatile LAS unsigned* st; };
__device__ __forceinline__ XcdBarrier xcd_barrier_post(unsigned* bar, volatile LAS unsigned* st) {
    XcdBarrier b; b.bar = bar; b.x = xb_xcc_id(); b.st = st;
    if (threadIdx.x == 0) (void)xb_add(&bar[XB_XCNT(b.x)], 1u);
    return b;
}
__device__ __forceinline__ void xcd_barrier_complete(unsigned* bar, unsigned x, unsigned& nloc, unsigned& nx) {
    const unsigned G = gridDim.x * gridDim.y * gridDim.z;
    unsigned sum, cnt, mine, sp = 0u;
    for (;;) {
        sum = 0u; cnt = 0u; mine = 0u;
#pragma unroll
        for (unsigned j = 0; j < 16; ++j) { const unsigned c = xb_ld(&bar[XB_XCNT(j)]); sum += c; cnt += (c > 0u) ? 1u : 0u; mine = (j == x) ? c : mine; }
        if (sum == G) break;
        __builtin_amdgcn_s_sleep(1);
        if ((++sp & 255u) == 0u) { if (xb_ld(&bar[XB_TMO])) break; if (sp > XB_SPIN_CAP) { atomicAdd(&bar[XB_TMO], 1u); break; } }
    }
    nloc = mine > 0u ? mine : 1u; nx = cnt > 0u ? cnt : 1u;
}
__device__ __forceinline__ void xcd_barrier(const XcdBarrier& b, int wave_s) {
    asm volatile("s_waitcnt vmcnt(0)" ::: "memory");
    __syncthreads();
    if (wave_s == 0 && lane_id_v() == 0) {
        unsigned* bar = b.bar;
        __builtin_amdgcn_s_waitcnt(0);
        unsigned nloc = b.st[0], nx = b.st[1];
        if (nloc == 0u) { xcd_barrier_complete(bar, b.x, nloc, nx); b.st[0] = nloc; b.st[1] = nx; }
        const unsigned old = xb_add(&bar[XB_XSUB(b.x)], 1u);
        const unsigned gen = old / nloc;
        if (old + 1u == (gen + 1u) * nloc) {
            __builtin_amdgcn_fence(__ATOMIC_RELEASE, "agent");
            asm volatile("s_waitcnt vmcnt(0)" ::: "memory");
            const unsigned og = xb_add(&bar[XB_TOP], 1u);
            const unsigned tg = og / nx;
            if (og + 1u == (tg + 1u) * nx) xb_add(&bar[XB_TOPGEN], 1u);
            else XB_SPIN(xb_ld(&bar[XB_TOPGEN]) == tg, bar);
            __builtin_amdgcn_fence(__ATOMIC_ACQUIRE, "agent");
            xb_add(&bar[XB_XGEN(b.x)], 1u);
            asm volatile("s_waitcnt vmcnt(0)" ::: "memory");
        } else {
            XB_SPIN(xb_ld(&bar[XB_XGEN(b.x)]) == gen, bar);
            __builtin_amdgcn_fence(__ATOMIC_ACQUIRE, "agent");
            asm volatile("s_waitcnt vmcnt(0)" ::: "memory");
        }
    }
    __syncthreads();
}

constexpr int BM = 256, BK = 64, HALF = 128, HTB = HALF * BK * 2, NXCD = 8, WGM = 8;
__host__ __device__ __forceinline__ int lds_byte(int r, int c) { const int st = (r >> 4) * 2 + (c >> 5), rr = r & 15, cc = c & 31, ob = rr * 64 + cc * 2; return st * 1024 + (ob ^ (((ob >> 9) & 1) << 5)); }
__host__ __device__ __forceinline__ void stage_rc(int b, int& R, int& C) { const int st = b / 1024, sb = b % 1024, swz = sb ^ (((sb >> 9) & 1) << 5); R = (st >> 1) * 16 + swz / 64; C = (st & 1) * 32 + (swz % 64) / 2; }
struct Unit { int pm, pn; };
struct Gemm { const bf16_t* A; const bf16_t* Bt; int lda, ldb, K; int acol_shift, acol_step; };
struct StaticOrder {
    int nM, nN, nwg, G, c;
    __device__ __forceinline__ void init(int nM_, int nN_, int G_, int c_) { nM = nM_; nN = nN_; nwg = nM * nN; G = G_; c = c_; }
    __device__ __forceinline__ bool next(int i, Unit& u) const {
        const long L = (long)i * G + c; if (L >= nwg) return false;
        int wgid = (int)L; { const int q = nwg / NXCD, r = nwg % NXCD, xcd = wgid % NXCD, off = wgid / NXCD; wgid = (xcd < r ? xcd * (q + 1) : r * (q + 1) + (xcd - r) * q) + off; }
        const int nig = WGM * nN, gid = wgid / nig, fm = gid * WGM, gsz = (nM - fm) < WGM ? (nM - fm) : WGM;
        u.pm = fm + ((wgid % nig) % gsz); u.pn = (wgid % nig) / gsz; return true;
    }
};
typedef __bf16 bf16x2_t __attribute__((ext_vector_type(2)));
__device__ __forceinline__ unsigned cvt_pk_bf16(float lo, float hi) { f32x2 v = {lo, hi}; bf16x2_t b = __builtin_convertvector(v, bf16x2_t); return __builtin_bit_cast(unsigned, b); }

template <class Epi>
__device__ __forceinline__ void gemm_phase(LAS unsigned char* lds, const Gemm g, const StaticOrder& S, const Epi& E, int wave_s) {
    const int wid = wave_s, lane = lane_id_v(), tid = wid * 64 + lane, wr = wid >> 2, wc = wid & 3, fr = lane & 15, fq = lane >> 4;
    const int K = g.K, nt = K / BK;
    unsigned voffA[2], voffB[2];
#pragma unroll
    for (int i = 0; i < 2; ++i) { int R, C; stage_rc(tid * 16 + i * 8192, R, C); voffA[i] = (unsigned)(R * g.lda + C) * 2u; voffB[i] = (unsigned)(R * g.ldb + C) * 2u; }
    const size_t kstep = (size_t)(BK * 2);
    const size_t hstepA = (size_t)HALF * g.lda * 2, hstepB = (size_t)HALF * g.ldb * 2;
    const size_t tstepA = 2 * hstepA, tstepB = 2 * hstepB;
    const unsigned ldsw = (unsigned)wid * 1024u;
    const int aoff = lds_byte(wr * 64 + fr, fq * 8), boff = lds_byte(wc * 32 + fr, fq * 8);
#define PG8_SA(b, h) (((b) * 2 + (h)) * HTB)
#define PG8_SB(b, h) ((4 + (b) * 2 + (h)) * HTB)
#define PG8_STAGE(bufoff, gbase, voff) do { _Pragma("unroll") for (int _i = 0; _i < 2; ++_i) \
        __builtin_amdgcn_global_load_lds((const unsigned*)((const char*)(gbase) + (voff)[_i]), (LAS unsigned*)(lds + (bufoff) + ldsw + _i * 8192), 16, 0, 0); } while (0)
#define PG8_LDA(dst, b, h) do { _Pragma("unroll") for (int m = 0; m < 4; ++m) _Pragma("unroll") for (int k = 0; k < 2; ++k) dst[m][k] = *(const LAS bf16x8*)(lds + PG8_SA(b, h) + aoff + m * 2048 + k * 1024); } while (0)
#define PG8_LDB(dst, b, h) do { _Pragma("unroll") for (int n = 0; n < 2; ++n) _Pragma("unroll") for (int k = 0; k < 2; ++k) dst[n][k] = *(const LAS bf16x8*)(lds + PG8_SB(b, h) + boff + n * 2048 + k * 1024); } while (0)
#define PG8_MMA(ai, bj, At, Bt) do { __builtin_amdgcn_s_setprio(1); _Pragma("unroll") for (int m = 0; m < 4; ++m) _Pragma("unroll") for (int n = 0; n < 2; ++n) _Pragma("unroll") for (int k = 0; k < 2; ++k) \
        acc[ai][bj][m][n] = __builtin_amdgcn_mfma_f32_16x16x32_bf16(Bt[n][k], At[m][k], acc[ai][bj][m][n], 0, 0, 0); __builtin_amdgcn_s_setprio(0); } while (0)
#define PG8_WAIT_V(n) asm volatile("s_waitcnt vmcnt(" #n ")" ::: "memory")
#define PG8_WAIT_L(n) asm volatile("s_waitcnt lgkmcnt(" #n ")" ::: "memory")
#define PG8_BAR __builtin_amdgcn_s_barrier()
#define PG8_SCHED __builtin_amdgcn_sched_barrier(0)
    Unit cur, nxt; int ui = 0;
    if (!S.next(0, cur)) return;
    f32x4 acc[2][2][4][2];
#pragma unroll
    for (int a = 0; a < 2; ++a)
#pragma unroll
        for (int b = 0; b < 2; ++b)
#pragma unroll
            for (int m = 0; m < 4; ++m)
#pragma unroll
                for (int n = 0; n < 2; ++n) acc[a][b][m][n] = (f32x4){0.f, 0.f, 0.f, 0.f};
    bf16x8 At[4][2], B0[2][2], B1[2][2];
    const char* cA = (const char*)g.A + (size_t)cur.pm * tstepA + (size_t)((cur.pn >> g.acol_shift) * g.acol_step) * 2; const char* cB = (const char*)g.Bt + (size_t)cur.pn * tstepB;
    {
        PG8_STAGE(PG8_SB(0, 0), cB, voffB); PG8_STAGE(PG8_SB(0, 1), cB + hstepB, voffB); PG8_STAGE(PG8_SA(0, 0), cA, voffA); PG8_STAGE(PG8_SA(0, 1), cA + hstepA, voffA);
        if (wr == 1) PG8_BAR;
        PG8_WAIT_V(2); PG8_BAR;
        PG8_STAGE(PG8_SB(1, 0), cB + kstep, voffB); PG8_STAGE(PG8_SA(1, 0), cA + kstep, voffA); PG8_STAGE(PG8_SB(1, 1), cB + hstepB + kstep, voffB);
        PG8_WAIT_V(6); PG8_BAR;
    }
    for (;;) {
        const bool has_next = S.next(ui + 1, nxt);
        const char* nA = has_next ? (const char*)g.A + (size_t)nxt.pm * tstepA + (size_t)((nxt.pn >> g.acol_shift) * g.acol_step) * 2 : cA; const char* nB = has_next ? (const char*)g.Bt + (size_t)nxt.pn * tstepB : cB;
#pragma unroll 1
        for (int t = 0; t < nt; t += 2) {
            const bool last = (t == nt - 2);
            const char* a1 = cA + (size_t)(t + 1) * kstep;
            const char* a2 = last ? nA : cA + (size_t)(t + 2) * kstep; const char* b2 = last ? nB : cB + (size_t)(t + 2) * kstep;
            const char* a3 = a2 + kstep; const char* b3 = b2 + kstep;
            PG8_LDB(B0, 0, 0); PG8_LDB(B1, 0, 1); PG8_SCHED; PG8_LDA(At, 0, 0); PG8_STAGE(PG8_SA(1, 1), a1 + hstepA, voffA);
            PG8_WAIT_V(8); PG8_WAIT_L(0); PG8_BAR; PG8_MMA(0, 0, At, B0); PG8_MMA(0, 1, At, B1); PG8_BAR; PG8_SCHED;
            PG8_LDA(At, 0, 1); PG8_STAGE(PG8_SB(0, 0), b2, voffB); PG8_STAGE(PG8_SB(0, 1), b2 + hstepB, voffB); PG8_STAGE(PG8_SA(0, 0), a2, voffA);
            PG8_WAIT_V(8); PG8_WAIT_L(0); PG8_BAR; PG8_MMA(1, 0, At, B0); PG8_MMA(1, 1, At, B1); PG8_BAR; PG8_SCHED;
            PG8_LDB(B0, 1, 0); PG8_LDB(B1, 1, 1); PG8_SCHED; PG8_LDA(At, 1, 0); PG8_STAGE(PG8_SA(0, 1), a2 + hstepA, voffA);
            PG8_WAIT_V(8); PG8_WAIT_L(0); PG8_BAR; PG8_MMA(0, 0, At, B0); PG8_MMA(0, 1, At, B1); PG8_BAR; PG8_SCHED;
            PG8_LDA(At, 1, 1); PG8_STAGE(PG8_SB(1, 0), b3, voffB); PG8_STAGE(PG8_SB(1, 1), b3 + hstepB, voffB); PG8_STAGE(PG8_SA(1, 0), a3, voffA);
            PG8_WAIT_V(8); PG8_WAIT_L(0); PG8_BAR; PG8_MMA(1, 0, At, B0); PG8_MMA(1, 1, At, B1); PG8_BAR; PG8_SCHED;
        }
        if (wr == 0) PG8_BAR;
        { const int le = lane_id_v();
          E(acc, cur, wr, wc, le & 15, le >> 4, lds + EPI_OFF, wid, le); }
        if (!has_next) break;
#pragma unroll
        for (int a = 0; a < 2; ++a)
#pragma unroll
            for (int b = 0; b < 2; ++b)
#pragma unroll
                for (int m = 0; m < 4; ++m)
#pragma unroll
                    for (int n = 0; n < 2; ++n) acc[a][b][m][n] = (f32x4){0.f, 0.f, 0.f, 0.f};
        cur = nxt; cA = nA; cB = nB; ++ui;
        if (wr == 1) PG8_BAR;
    }
    PG8_WAIT_V(0);
    PG8_BAR;
#undef PG8_SA
#undef PG8_SB
#undef PG8_STAGE
#undef PG8_LDA
#undef PG8_LDB
#undef PG8_MMA
#undef PG8_WAIT_V
#undef PG8_WAIT_L
#undef PG8_SCHED
}
#define MK_BAR __builtin_amdgcn_s_barrier()

__device__ __forceinline__ int mod_variant(int pm) { return pm < 32 ? 0 : (pm < 64 ? 1 : 2); }

struct EpiResid {
    const float* baseL; const float* baseC; float* outL; float* outC; const float* mod; int gate_off;
    __device__ __forceinline__ void operator()(const f32x4 (&acc)[2][2][4][2], const Unit& u, int wr, int wc, int fr, int fq, LAS unsigned char*, int, int) const {
        const int v = mod_variant(u.pm);
        const float* gate = mod + v * 6144 + gate_off;
        const float* base = u.pm < 64 ? baseL + (size_t)u.pm * 256 * 1024 : baseC + (size_t)(u.pm - 64) * 256 * 1024;
        float* out = u.pm < 64 ? outL + (size_t)u.pm * 256 * 1024 : outC + (size_t)(u.pm - 64) * 256 * 1024;
        const int col0 = u.pn * BM + wc * 32 + 4 * fq;
        f32x4 gv[2][2];
#pragma unroll
        for (int bj = 0; bj < 2; ++bj)
#pragma unroll
            for (int n = 0; n < 2; ++n) gv[bj][n] = *(const f32x4*)(gate + col0 + bj * HALF + n * 16);
#pragma unroll
        for (int ai = 0; ai < 2; ++ai)
#pragma unroll
            for (int m = 0; m < 4; ++m) { const size_t off = (size_t)(ai * HALF + wr * 64 + m * 16 + fr) * 1024 + col0;
#pragma unroll
                for (int bj = 0; bj < 2; ++bj)
#pragma unroll
                    for (int n = 0; n < 2; ++n) { const f32x4 bs = *(const f32x4*)(base + off + bj * HALF + n * 16); *(f32x4*)(out + off + bj * HALF + n * 16) = bs + gv[bj][n] * acc[ai][bj][m][n]; } }
    }
};

struct EpiHgIn {
    bf16_t *QmF, *KmF, *QmB, *KmB, *V, *SG; float* side; const float* lb;
    __device__ __forceinline__ void operator()(const f32x4 (&acc)[2][2][4][2], const Unit& u, int wr, int wc, int fr, int fq, LAS unsigned char*, int, int) const {
        const int row0 = u.pm * BM + wr * 64 + fr;
        if (u.pn >= 16) {
            const int col0 = (u.pn - 16) * BM + wc * 32 + 8 * fq;
#pragma unroll
            for (int ai = 0; ai < 2; ++ai)
#pragma unroll
                for (int m = 0; m < 4; ++m) { char* rowp = (char*)SG + (unsigned)(((row0 + ai * HALF + m * 16) * 1024 + col0) * 2);
#pragma unroll
                    for (int bj = 0; bj < 2; ++bj) { f32x4 v0 = acc[ai][bj][m][0], v1 = acc[ai][bj][m][1]; asm volatile("" : "+v"(v0), "+v"(v1)); u32x4 w;
                        w.x = cvt_pk_bf16(fsilu(v0[0]), fsilu(v0[1])); w.y = cvt_pk_bf16(fsilu(v0[2]), fsilu(v0[3])); w.z = cvt_pk_bf16(fsilu(v1[0]), fsilu(v1[1])); w.w = cvt_pk_bf16(fsilu(v1[2]), fsilu(v1[3]));
                        *(u32x4*)(rowp + bj * HALF * 2) = w; }
                    asm volatile("" ::: "memory"); }
            return;
        }
        const int c0 = 64 * u.pn + 16 * wc + 4 * fq;
        const f32x4 lbf = *(const f32x4*)(lb + c0), lbb = *(const f32x4*)(lb + 1024 + c0);
#pragma unroll
        for (int ai = 0; ai < 2; ++ai) {
            const int ck = u.pm * 4 + ai * 2 + wr;
#pragma unroll
            for (int m = 0; m < 4; ++m) { const f32x4 vv = acc[ai][1][m][1]; u32x2 w; w.x = cvt_pk_bf16(vv[0], vv[1]); w.y = cvt_pk_bf16(vv[2], vv[3]);
                *(u32x2*)((char*)V + (unsigned)(((row0 + ai * HALF + m * 16) * 1024 + c0) * 2)) = w; }
#pragma unroll
            for (int d = 0; d < 2; ++d) {
                const f32x4 lbv = d ? lbb : lbf;
                float db[4][4];
                float* sp = (float*)((char*)side + (unsigned)((((ck * 2 + d) * 3) * 1024 + c0) * 4));
#pragma unroll
                for (int j = 0; j < 4; ++j) {
                    float lf[4], bs[4];
#pragma unroll
                    for (int m = 0; m < 4; ++m) { const float z = d ? acc[ai][1][m][0][j] : acc[ai][0][m][1][j]; lf[m] = __logf(lbv[j] + (1.f - lbv[j]) * fsigmoid(z)); }
                    float carry = 0.f;
#pragma unroll
                    for (int m = 0; m < 4; ++m) { float x = lf[m];
#pragma unroll
                        for (int o = 1; o < 16; o <<= 1) { const float y = __shfl_up(x, o, 16); if (fr >= o) x += y; }
                        x += carry; bs[m] = x; carry = __shfl(x, 15, 16); }
                    const float tot = carry; float bmid;
                    if (d == 0) bmid = __shfl(bs[2], 0, 16);
                    else {
#pragma unroll
                        for (int m = 0; m < 4; ++m) bs[m] = tot - bs[m] + lf[m];
                        bmid = __shfl(bs[1], 15, 16); }
#pragma unroll
                    for (int m = 0; m < 4; ++m) db[m][j] = bs[m] - bmid;
                    if (fr == 0) { sp[j] = __expf(bmid); sp[1024 + j] = __expf(tot - bmid); sp[2048 + j] = __expf(tot); }
                }
                bf16_t* Qd = d ? QmB : QmF; bf16_t* Kd = d ? KmB : KmF;
#pragma unroll
                for (int m = 0; m < 4; ++m) { const f32x4 qz = acc[ai][0][m][0]; const f32x4 z = d ? acc[ai][1][m][0] : acc[ai][0][m][1]; float qo[4], ko[4];
#pragma unroll
                    for (int j = 0; j < 4; ++j) { const float kv = (1.f - lbv[j]) * (1.f - fsigmoid(z[j])); qo[j] = fsilu(qz[j]) * __expf(db[m][j]); ko[j] = kv * __expf(-db[m][j]); }
                    const unsigned off = (unsigned)(((row0 + ai * HALF + m * 16) * 1024 + c0) * 2);
                    u32x2 w; w.x = cvt_pk_bf16(qo[0], qo[1]); w.y = cvt_pk_bf16(qo[2], qo[3]); *(u32x2*)((char*)Qd + off) = w;
                    w.x = cvt_pk_bf16(ko[0], ko[1]); w.y = cvt_pk_bf16(ko[2], ko[3]); *(u32x2*)((char*)Kd + off) = w;
                    asm volatile("" ::: "memory"); }
            }
        }
    }
};


__device__ __forceinline__ float dpp_f(float oldv, float src, const int ctrl_sel) {
    const int o = __builtin_bit_cast(int, oldv), x = __builtin_bit_cast(int, src); int r;
    if (ctrl_sel == 0) r = __builtin_amdgcn_update_dpp(o, x, 0x111, 0xF, 0xF, false);
    else if (ctrl_sel == 1) r = __builtin_amdgcn_update_dpp(o, x, 0x101, 0xF, 0xF, false);
    else if (ctrl_sel == 2) r = __builtin_amdgcn_update_dpp(o, x, 0x121, 0xF, 0xF, false);
    else r = __builtin_amdgcn_update_dpp(o, x, 0x12F, 0xF, 0xF, false);
    return __builtin_bit_cast(float, r);
}
struct EpiUpConv {
    bf16_t* G; bf16_t* uedge; const float* cw; const float* cb;
    __device__ __forceinline__ void operator()(const f32x4 (&acc)[2][2][4][2], const Unit& u, int wr, int wc, int fr, int fq, LAS unsigned char* epi, int, int) const {
        LAS float* EX = (LAS float*)epi;
        const int colb = 32 * wc + 4 * fq;
        const int ch0 = 128 * u.pn + 32 * wc + 8 * fq;
#pragma unroll
        for (int ai = 0; ai < 2; ++ai) { const int g = 2 * ai + wr;
#pragma unroll
            for (int bj = 0; bj < 2; ++bj)
#pragma unroll
                for (int n = 0; n < 2; ++n) {
                    if (fr == 0) *(LAS f32x4*)(EX + (g * 2 + 0) * 256 + 128 * bj + 16 * n + colb) = acc[ai][bj][0][n];
                    if (fr == 15) *(LAS f32x4*)(EX + (g * 2 + 1) * 256 + 128 * bj + 16 * n + colb) = acc[ai][bj][3][n];
                } }
        {
            const bool lo = (wr == 0) && (fr < 2), hi = (wr == 1) && (fr >= 14);
            if (lo || hi) { const int slot = lo ? fr : (fr - 12); bf16_t* ue = uedge + ((size_t)u.pm * 4 + slot) * 5632 + ch0;
#pragma unroll
                for (int bj = 0; bj < 2; ++bj)
#pragma unroll
                    for (int n = 0; n < 2; ++n) { const f32x4 x = lo ? acc[0][bj][0][n] : acc[1][bj][3][n]; u32x2 w; w.x = cvt_pk_bf16(x[0], x[1]); w.y = cvt_pk_bf16(x[2], x[3]); *(u32x2*)(ue + bj * 2816 + 4 * n) = w; } }
        }
        LDS_WAIT(); MK_BAR; asm volatile("" ::: "memory");
#pragma unroll
        for (int n = 0; n < 2; ++n) {
            f32x4 wg[4], wv[4];
#pragma unroll
            for (int k = 0; k < 3; ++k) { wg[k] = *(const f32x4*)(cw + k * 5632 + ch0 + 4 * n); wv[k] = *(const f32x4*)(cw + k * 5632 + 2816 + ch0 + 4 * n); }
            wg[3] = *(const f32x4*)(cb + ch0 + 4 * n); wv[3] = *(const f32x4*)(cb + 2816 + ch0 + 4 * n);
#pragma unroll
            for (int ai = 0; ai < 2; ++ai) { const int g = 2 * ai + wr;
                f32x4 pe[2], ne[2];
#pragma unroll
                for (int bj = 0; bj < 2; ++bj) {
                    pe[bj] = (g > 0) ? *(const LAS f32x4*)(EX + ((g - 1) * 2 + 1) * 256 + 128 * bj + 16 * n + colb) : (f32x4){0.f, 0.f, 0.f, 0.f};
                    ne[bj] = (g < 3) ? *(const LAS f32x4*)(EX + ((g + 1) * 2 + 0) * 256 + 128 * bj + 16 * n + colb) : (f32x4){0.f, 0.f, 0.f, 0.f}; }
#pragma unroll
                for (int m = 0; m < 4; ++m) {
                    f32x4 cv2[2];
#pragma unroll
                    for (int bj = 0; bj < 2; ++bj) { const f32x4 x = acc[ai][bj][m][n]; const f32x4* wt = bj ? wv : wg; f32x4 c;
#pragma unroll
                        for (int j = 0; j < 4; ++j) {
                            const float pold = (m > 0) ? dpp_f(0.f, acc[ai][bj][m > 0 ? m - 1 : 0][n][j], 2) : pe[bj][j];
                            const float nold = (m < 3) ? dpp_f(0.f, acc[ai][bj][m < 3 ? m + 1 : 3][n][j], 3) : ne[bj][j];
                            const float pv = dpp_f(pold, x[j], 0), nv = dpp_f(nold, x[j], 1);
                            c[j] = wt[3][j] + wt[0][j] * pv + wt[1][j] * x[j] + wt[2][j] * nv; }
                        cv2[bj] = c; }
                    u32x2 w; w.x = cvt_pk_bf16(fsilu(cv2[0][0]) * cv2[1][0], fsilu(cv2[0][1]) * cv2[1][1]); w.y = cvt_pk_bf16(fsilu(cv2[0][2]) * cv2[1][2], fsilu(cv2[0][3]) * cv2[1][3]);
                    *(u32x2*)((char*)G + (unsigned)(((u.pm * 256 + ai * HALF + wr * 64 + m * 16 + fr) * 2816 + ch0 + 4 * n) * 2)) = w;
                    asm volatile("" ::: "memory");
                }
            }
        }
        LDS_WAIT(); MK_BAR; asm volatile("" ::: "memory");
    }
};
__device__ __forceinline__ void ffn_fix_edges(int tid, int pm, bf16_t* G, const bf16_t* uedge, const float* cw, const float* cb) {
    const bool sstart = (pm == 0) || (pm == 32) || (pm >= 64), send = (pm == 31) || (pm == 63) || (pm >= 64);
    for (int idx = tid; idx < 2 * 2816; idx += NTHR) {
        const int which = idx >= 2816, ch = idx - which * 2816;
        const bf16_t* UE = uedge + (size_t)pm * 4 * 5632;
        float cg = 0.f, cvv = 0.f;
#pragma unroll
        for (int half = 0; half < 2; ++half) { const int col = half * 2816 + ch; float pv, cu, nv;
            if (which == 0) { pv = sstart ? 0.f : bf2f(uedge[((size_t)(pm - 1) * 4 + 3) * 5632 + col]); cu = bf2f(UE[col]); nv = bf2f(UE[5632 + col]); }
            else { pv = bf2f(UE[2 * 5632 + col]); cu = bf2f(UE[3 * 5632 + col]); nv = send ? 0.f : bf2f(uedge[((size_t)(pm + 1) * 4) * 5632 + col]); }
            const float c = cb[col] + cw[col] * pv + cw[5632 + col] * cu + cw[2 * 5632 + col] * nv;
            if (half == 0) cg = c; else cvv = c; }
        G[(size_t)(pm * 256 + (which ? 255 : 0)) * 2816 + ch] = (bf16_t)f2bf(fsilu(cg) * cvv);
    }
}

constexpr int SC_QS = 272, SC_KS = 288;
constexpr int SC_QOFF = 0, SC_KOFF = 64 * SC_QS, SC_VOFF = SC_KOFF + 64 * SC_KS, SC_BUF = SC_VOFF + 64 * SC_KS;
constexpr int SC_POFF = 2 * SC_BUF, SC_PS = 144, SC_SIDE = SC_POFF + 64 * SC_PS;
__device__ __forceinline__ s16x4 ds_tr(const LAS unsigned char* p) { typedef short v4i16_t __attribute__((ext_vector_type(4))); return __builtin_bit_cast(s16x4, __builtin_amdgcn_ds_read_tr16_b64_v4i16((LAS v4i16_t*)p)); }
__device__ __forceinline__ bf16x8 cat8(s16x4 a, s16x4 b) { return (bf16x8){a[0], a[1], a[2], a[3], b[0], b[1], b[2], b[3]}; }

__device__ __forceinline__ void hgrn_chain(LAS unsigned char* lds, bf16_t* Qd, const bf16_t* Kd, const bf16_t* Vt, const float* side, int b, int h, int d, int wave_s) {
    const int w = wave_s, lane = lane_id_v(), tid = w * 64 + lane, l15 = lane & 15, G = lane >> 4;
#ifndef SCAN_NSTEP
#define SCAN_NSTEP 132
#endif
    constexpr int NSTEP = SCAN_NSTEP;
#define SC_CHUNK_ROW(s_) (((s_) < 4) ? (ML + b * 256 + 64 * (d ? (3 - (s_)) : (s_))) : (b * 8192 + 64 * (d ? (127 - ((s_) - 4)) : ((s_) - 4))))
    u32x4 sq0, sq1, sk0, sk1, sv0, sv1; f32x4 ssd = (f32x4){0.f, 0.f, 0.f, 0.f};
    const int st_r0 = tid >> 4, st_c = tid & 15, st_r1 = st_r0 + 32;
#define SC_STAGE_LOAD(s_) do { const int rb_ = SC_CHUNK_ROW(s_); \
        const size_t g0_ = (size_t)(rb_ + st_r0) * 1024 + h * 128 + st_c * 8, g1_ = (size_t)(rb_ + st_r1) * 1024 + h * 128 + st_c * 8; \
        sq0 = *(const u32x4*)(Qd + g0_); sk0 = *(const u32x4*)(Kd + g0_); sv0 = *(const u32x4*)(Vt + g0_); \
        sq1 = *(const u32x4*)(Qd + g1_); sk1 = *(const u32x4*)(Kd + g1_); sv1 = *(const u32x4*)(Vt + g1_); \
        if (tid < 96) { const int ck_ = rb_ >> 6; ssd = *(const f32x4*)(side + ((size_t)(ck_ * 2 + d) * 3 + (tid >> 5)) * 1024 + h * 128 + (tid & 31) * 4); } } while (0)
#define SC_STAGE_STORE(buf_) do { LAS unsigned char* B_ = lds + (buf_) * SC_BUF; \
        *(LAS u32x4*)(B_ + SC_QOFF + st_r0 * SC_QS + st_c * 16) = sq0; *(LAS u32x4*)(B_ + SC_KOFF + st_r0 * SC_KS + st_c * 16) = sk0; *(LAS u32x4*)(B_ + SC_VOFF + st_r0 * SC_KS + st_c * 16) = sv0; \
        *(LAS u32x4*)(B_ + SC_QOFF + st_r1 * SC_QS + st_c * 16) = sq1; *(LAS u32x4*)(B_ + SC_KOFF + st_r1 * SC_KS + st_c * 16) = sk1; *(LAS u32x4*)(B_ + SC_VOFF + st_r1 * SC_KS + st_c * 16) = sv1; \
        if (tid < 96) *(LAS f32x4*)(lds + SC_SIDE + (buf_) * 1536 + tid * 16) = ssd; } while (0)
    f32x4 S[8];
#pragma unroll
    for (int i = 0; i < 8; ++i) S[i] = (f32x4){0.f, 0.f, 0.f, 0.f};
    SC_STAGE_LOAD(0); SC_STAGE_STORE(0);
    LDS_WAIT(); __syncthreads();
    const int ti = w >> 1, tj0 = (w & 1) * 2;
    for (int s = 0; s < NSTEP; ++s) {
        const int cur = s & 1;
        const LAS unsigned char* Bq = lds + cur * SC_BUF + SC_QOFF; const LAS unsigned char* Bk = lds + cur * SC_BUF + SC_KOFF; const LAS unsigned char* Bv = lds + cur * SC_BUF + SC_VOFF;
        const LAS float* sd = (const LAS float*)(lds + SC_SIDE + cur * 1536);
        if (s + 1 < NSTEP) SC_STAGE_LOAD(s + 1);
        {
            f32x4 p0 = (f32x4){0.f, 0.f, 0.f, 0.f}, p1 = p0;
#pragma unroll
            for (int ks = 0; ks < 4; ++ks) {
                const bf16x8 bq = *(const LAS bf16x8*)(Bq + (16 * ti + l15) * SC_QS + (32 * ks + 8 * G) * 2);
                const bf16x8 a0 = *(const LAS bf16x8*)(Bk + (16 * tj0 + l15) * SC_KS + (32 * ks + 8 * G) * 2);
                const bf16x8 a1 = *(const LAS bf16x8*)(Bk + (16 * (tj0 + 1) + l15) * SC_KS + (32 * ks + 8 * G) * 2);
                p0 = __builtin_amdgcn_mfma_f32_16x16x32_bf16(a0, bq, p0, 0, 0, 0);
                p1 = __builtin_amdgcn_mfma_f32_16x16x32_bf16(a1, bq, p1, 0, 0, 0);
            }
            const int i = 16 * ti + l15;
#pragma unroll
            for (int r = 0; r < 4; ++r) { const int j0 = 16 * tj0 + 4 * G + r, j1 = j0 + 16;
                if (d == 0) { if (j0 > i) p0[r] = 0.f; if (j1 > i) p1[r] = 0.f; } else { if (j0 < i) p0[r] = 0.f; if (j1 < i) p1[r] = 0.f; } }
            u32x2 w0, w1; w0.x = cvt_pk_bf16(p0[0], p0[1]); w0.y = cvt_pk_bf16(p0[2], p0[3]); w1.x = cvt_pk_bf16(p1[0], p1[1]); w1.y = cvt_pk_bf16(p1[2], p1[3]);
            *(LAS u32x2*)(lds + SC_POFF + i * SC_PS + (16 * tj0 + 4 * G) * 2) = w0;
            *(LAS u32x2*)(lds + SC_POFF + i * SC_PS + (16 * (tj0 + 1) + 4 * G) * 2) = w1;
        }
        bf16x8 Sp[4];
#pragma unroll
        for (int s4 = 0; s4 < 4; ++s4) {
            const f32x4 e0 = *(const LAS f32x4*)(sd + 16 * (2 * s4) + 4 * G), e1 = *(const LAS f32x4*)(sd + 16 * (2 * s4 + 1) + 4 * G);
#ifdef UNIT_SIDE
            const f32x4 x0 = S[2 * s4] + 0.f * e0, x1 = S[2 * s4 + 1] + 0.f * e1;
#else
            const f32x4 x0 = S[2 * s4] * e0, x1 = S[2 * s4 + 1] * e1;
#endif
            u32x4 t; t.x = cvt_pk_bf16(x0[0], x0[1]); t.y = cvt_pk_bf16(x0[2], x0[3]); t.z = cvt_pk_bf16(x1[0], x1[1]); t.w = cvt_pk_bf16(x1[2], x1[3]);
            Sp[s4] = __builtin_bit_cast(bf16x8, t);
        }
        LDS_WAIT(); __syncthreads();
        bf16x8 vf[2];
        {
            const int q = l15 >> 2, p = l15 & 3;
#pragma unroll
            for (int ks = 0; ks < 2; ++ks) {
                const s16x4 lo = ds_tr(Bv + (32 * ks + 4 * G + q) * SC_KS + (16 * w + 4 * p) * 2);
                const s16x4 hi = ds_tr(Bv + (32 * ks + 16 + 4 * G + q) * SC_KS + (16 * w + 4 * p) * 2);
                vf[ks] = cat8(lo, hi);
            }
        }
        const int rb = SC_CHUNK_ROW(s);
#pragma unroll
        for (int it = 0; it < 4; ++it) {
            f32x4 o = (f32x4){0.f, 0.f, 0.f, 0.f};
            const int tok = 16 * it + l15;
#pragma unroll
            for (int ks = 0; ks < 2; ++ks) {
                const s16x4 lo = *(const LAS s16x4*)(lds + SC_POFF + tok * SC_PS + (32 * ks + 4 * G) * 2);
                const s16x4 hi = *(const LAS s16x4*)(lds + SC_POFF + tok * SC_PS + (32 * ks + 16 + 4 * G) * 2);
                o = __builtin_amdgcn_mfma_f32_16x16x32_bf16(vf[ks], cat8(lo, hi), o, 0, 0, 0);
            }
#pragma unroll
            for (int s4 = 0; s4 < 4; ++s4) {
                const s16x4 lo = *(const LAS s16x4*)(Bq + tok * SC_QS + (32 * s4 + 4 * G) * 2);
                const s16x4 hi = *(const LAS s16x4*)(Bq + tok * SC_QS + (32 * s4 + 16 + 4 * G) * 2);
                o = __builtin_amdgcn_mfma_f32_16x16x32_bf16(Sp[s4], cat8(lo, hi), o, 0, 0, 0);
            }
            u32x2 wv; wv.x = cvt_pk_bf16(o[0], o[1]); wv.y = cvt_pk_bf16(o[2], o[3]);
            *(u32x2*)(Qd + (size_t)(rb + tok) * 1024 + h * 128 + 16 * w + 4 * G) = wv;
        }
        {
            const int q = l15 >> 2, p = l15 & 3;
#pragma unroll
            for (int i = 0; i < 8; ++i) {
                f32x4 U = (f32x4){0.f, 0.f, 0.f, 0.f};
#pragma unroll
                for (int ks = 0; ks < 2; ++ks) {
                    const s16x4 lo = ds_tr(Bk + (32 * ks + 4 * G + q) * SC_KS + (16 * i + 4 * p) * 2);
                    const s16x4 hi = ds_tr(Bk + (32 * ks + 16 + 4 * G + q) * SC_KS + (16 * i + 4 * p) * 2);
                    U = __builtin_amdgcn_mfma_f32_16x16x32_bf16(cat8(lo, hi), vf[ks], U, 0, 0, 0);
                }
                const f32x4 e2 = *(const LAS f32x4*)(sd + 128 + 16 * i + 4 * G), de = *(const LAS f32x4*)(sd + 256 + 16 * i + 4 * G);
#ifdef ZERO_STATE
                S[i] = (f32x4){0.f, 0.f, 0.f, 0.f}; asm volatile("" :: "v"(U), "v"(de), "v"(e2));
#elif defined(UNIT_SIDE)
                S[i] = S[i] + U;
#else
                S[i] = de * S[i] + e2 * U;
#endif
            }
        }
        if (s + 1 < NSTEP) SC_STAGE_STORE(cur ^ 1);
        LDS_WAIT(); __syncthreads();
    }
}

struct Frame {
    LAS unsigned char* lds; int wave, G, gw, NGW;
};
enum ConvKind { CV_NAT = 0, CV_PERM8 = 1, CV_HG = 2, CV_UP = 3, CV_GATES = 4 };
struct ConvJob { int kind; const float* W; const float* W2; int K, N, ld; bf16_t* dst; };
__device__ __forceinline__ const float* conv_colptr(const ConvJob& j, int rho) {
    const int pn = rho >> 8, t = rho & 255, bj = t >> 7, wc = (t >> 5) & 3, n = (t >> 4) & 1, fq = (t >> 2) & 3, jj = t & 3;
    switch (j.kind) {
        case CV_NAT: return j.W + rho;
        case CV_PERM8: return j.W + (pn * 256 + bj * 128 + wc * 32 + fq * 8 + n * 4 + jj);
        case CV_HG: if (pn >= 16) return j.W + (pn * 256 + bj * 128 + wc * 32 + fq * 8 + n * 4 + jj);
                    return j.W + ((2 * bj + n) * 1024 + 64 * pn + 16 * wc + 4 * fq + jj);
        case CV_UP: return j.W + (bj * 2816 + 128 * pn + 32 * wc + 8 * fq + 4 * n + jj);
        default: {
            const int blk = pn >> 2, q = pn & 3, grp = 2 * bj + n, dd = grp >> 1, ax = grp & 1; const int jc = 64 * q + 16 * wc + 4 * fq + jj;
            return (ax ? j.W2 : j.W) + (size_t)(dd * 4 + blk) * 65536 + jc; }
    }
}
__device__ __forceinline__ void conv_item(const ConvJob& j, LAS float* scr, int item, int lane) {
    const int nblk = j.N / 32, kb = item / nblk, nb = item % nblk, k0 = 64 * kb, n0 = 32 * nb;
    const float* cp = conv_colptr(j, n0 + (lane & 31));
#pragma unroll 8
    for (int i = 0; i < 32; ++i) { const int kk = 2 * i + (lane >> 5); scr[kk * 33 + (lane & 31)] = cp[(size_t)(k0 + kk) * j.ld]; }
    LDS_WAIT(); asm volatile("" ::: "memory");
    const int c = lane & 7;
#pragma unroll
    for (int jx = 0; jx < 4; ++jx) { const int n = (lane >> 3) + 8 * jx; const LAS float* s = scr + (8 * c) * 33 + n;
        u32x4 o; o.x = pk2(s[0 * 33], s[1 * 33]); o.y = pk2(s[2 * 33], s[3 * 33]); o.z = pk2(s[4 * 33], s[5 * 33]); o.w = pk2(s[6 * 33], s[7 * 33]);
        *(u32x4*)(j.dst + (size_t)(n0 + n) * j.K + k0 + 8 * c) = o; }
    LDS_WAIT(); asm volatile("" ::: "memory");
}
__device__ __forceinline__ void conv_job(const Frame& F, const ConvJob& j, int gw, int ngw) {
    LAS float* scr = (LAS float*)(F.lds + F.wave * 8448);
    const int nitems = (j.K / 64) * (j.N / 32);
    const int lane = lane_id_v();
    for (int it = gw; it < nitems; it += ngw) conv_item(j, scr, it, lane);
}

__device__ __forceinline__ void adaln_phase(const Frame& F, const float* c, const float* cctx, const float* w_ada, const float* b_ada, float* mod) {
    const int tid = F.wave * 64 + lane_id_v();
    LAS float* sc = (LAS float*)(F.lds + 70000);
    LAS float* red = sc + 3 * 1024;
    for (int item = blockIdx.x; item < 192; item += F.G) {
        const int l = item / 96, j0 = (item % 96) * 64;
        for (int i = tid; i < 1024; i += NTHR) { sc[i] = fsilu(c[i]); sc[1024 + i] = fsilu(c[1024 + i]); sc[2048 + i] = fsilu(cctx[i]); }
        __syncthreads();
        const int kp = tid >> 6, jj = tid & 63;
        const float* W = w_ada + (size_t)l * 1024 * 6144 + j0 + jj;
        float a0 = 0.f, a1 = 0.f, a2 = 0.f;
#pragma unroll 8
        for (int k = kp * 128; k < kp * 128 + 128; ++k) { const float wv = W[(size_t)k * 6144]; a0 += sc[k] * wv; a1 += sc[1024 + k] * wv; a2 += sc[2048 + k] * wv; }
        red[(kp * 3 + 0) * 64 + jj] = a0; red[(kp * 3 + 1) * 64 + jj] = a1; red[(kp * 3 + 2) * 64 + jj] = a2;
        __syncthreads();
        if (tid < 192) { const int v = tid >> 6, j2 = tid & 63; float s = 0.f;
#pragma unroll
            for (int p = 0; p < 8; ++p) s += red[(p * 3 + v) * 64 + j2];
            mod[(size_t)(l * 3 + v) * 6144 + j0 + j2] = s + b_ada[(size_t)l * 6144 + j0 + j2]; }
        __syncthreads();
    }
}

__device__ __forceinline__ void norm_phase(const Frame& F, const float* latL, const float* latC, const float* g, const float* mod, int sh_off, int sc_off, bf16_t* H, int nrows) {
    const int lane = lane_id_v();
    for (int row = F.gw; row < nrows; row += F.NGW) {
        const int v = row < 8192 ? 0 : (row < ML ? 1 : 2);
        const float* x = row < ML ? latL + (size_t)row * 1024 : latC + (size_t)(row - ML) * 1024;
        const float* sh = mod + v * 6144 + sh_off; const float* sc = mod + v * 6144 + sc_off;
        f32x4 xv[4]; float ss = 0.f;
#pragma unroll
        for (int j = 0; j < 4; ++j) { xv[j] = *(const f32x4*)(x + (lane + 64 * j) * 4); ss += (xv[j][0] * xv[j][0] + xv[j][1] * xv[j][1]) + (xv[j][2] * xv[j][2] + xv[j][3] * xv[j][3]); }
        const float rstd = rsqrtf(wave_sum(ss) * (1.f / 1024.f) + 1e-6f);
#pragma unroll
        for (int j = 0; j < 4; ++j) { const int cidx = (lane + 64 * j) * 4; const f32x4 gv = *(const f32x4*)(g + cidx), sv = *(const f32x4*)(sc + cidx), hv = *(const f32x4*)(sh + cidx);
            const f32x4 y = xv[j] * rstd * gv * (sv + 1.f) + hv; u32x2 wv; wv.x = pk2(y[0], y[1]); wv.y = pk2(y[2], y[3]);
            *(u32x2*)(H + (size_t)row * 1024 + cidx) = wv; }
    }
}

__device__ __forceinline__ void readout_phase(const Frame& F, const bf16_t* OF, const bf16_t* OB, const bf16_t* SG, const float* gn, bf16_t* R) {
    const int lane = lane_id_v(); const int l31 = lane & 31;
    const f32x4 gv = *(const f32x4*)(gn + l31 * 4);
    for (int row = F.gw; row < MT; row += F.NGW) {
#pragma unroll
        for (int ps = 0; ps < 4; ++ps) {
            const size_t off = (size_t)row * 1024 + (size_t)((lane >> 5) + 2 * ps) * 128 + l31 * 4;
            const u32x2 a = *(const u32x2*)(OF + off), b = *(const u32x2*)(OB + off), sgw = *(const u32x2*)(SG + off);
            float o[4] = {bflo(a.x) + bflo(b.x), bfhi(a.x) + bfhi(b.x), bflo(a.y) + bflo(b.y), bfhi(a.y) + bfhi(b.y)};
            float ss = (o[0] * o[0] + o[1] * o[1]) + (o[2] * o[2] + o[3] * o[3]);
#pragma unroll
            for (int m = 1; m < 32; m <<= 1) ss += __shfl_xor(ss, m);
            const float rstd = rsqrtf(ss * (1.f / 128.f) + 1e-6f);
            u32x2 wv; wv.x = pk2(o[0] * rstd * gv[0] * bflo(sgw.x), o[1] * rstd * gv[1] * bfhi(sgw.x)); wv.y = pk2(o[2] * rstd * gv[2] * bflo(sgw.y), o[3] * rstd * gv[3] * bfhi(sgw.y));
            *(u32x2*)(R + off) = wv;
        }
    }
}


struct EpiLruIn {
    bf16_t* GG; bf16_t* XR;
    __device__ __forceinline__ void operator()(const f32x4 (&acc)[2][2][4][2], const Unit& u, int wr, int wc, int fr, int fq, LAS unsigned char*, int, int) const {
        const bool isx = u.pn >= 4; const int col0 = (u.pn & 3) * 256 + wc * 32 + 8 * fq;
        bf16_t* dst = isx ? XR : GG;
#pragma unroll
        for (int ai = 0; ai < 2; ++ai)
#pragma unroll
            for (int m = 0; m < 4; ++m) { const int row = u.pm * 256 + ai * HALF + wr * 64 + m * 16 + fr; int drow = row;
                if (isx && row < ML) { const int t = row & 8191; drow = (row & ~8191) + (t & 63) * 128 + (t >> 6); }
#pragma unroll
                for (int bj = 0; bj < 2; ++bj) { f32x4 v0 = acc[ai][bj][m][0], v1 = acc[ai][bj][m][1];
                    if (!isx) {
#pragma unroll
                        for (int j = 0; j < 4; ++j) { v0[j] = fgelu_tanh(v0[j]); v1[j] = fgelu_tanh(v1[j]); } }
                    u32x4 w; w.x = cvt_pk_bf16(v0[0], v0[1]); w.y = cvt_pk_bf16(v0[2], v0[3]); w.z = cvt_pk_bf16(v1[0], v1[1]); w.w = cvt_pk_bf16(v1[2], v1[3]);
                    *(u32x4*)((char*)dst + (unsigned)((drow * 1024 + col0 + bj * HALF) * 2)) = w; }
                asm volatile("" ::: "memory"); }
    }
};
__device__ __forceinline__ void lru_conv_phase(const Frame& F, const bf16_t* XR, const float* cw, const float* cb, bf16_t* XC) {
    const int lane = lane_id_v(); const int gt = F.gw * 64 + lane, ngt = F.NGW * 64;
    for (int it = gt; it < MT * 128; it += ngt) {
        const int row = it >> 7, c8 = (it & 127) * 8;
        const int s0 = row < ML ? (row & ~8191) : (ML + ((row - ML) & ~255)), slen = row < ML ? 8192 : 256, p = row - s0;
        float a[8];
#pragma unroll
        for (int j = 0; j < 8; ++j) a[j] = cb[c8 + j];
#pragma unroll
        for (int k = 0; k < 4; ++k) { const int pp = p + k - 2;
            if (pp >= 0 && pp < slen) { const u32x4 xv = *(const u32x4*)(XR + (size_t)(s0 + pp) * 1024 + c8); const f32x4 w0 = *(const f32x4*)(cw + k * 1024 + c8), w1 = *(const f32x4*)(cw + k * 1024 + c8 + 4);
                a[0] += w0[0] * bflo(xv.x); a[1] += w0[1] * bfhi(xv.x); a[2] += w0[2] * bflo(xv.y); a[3] += w0[3] * bfhi(xv.y);
                a[4] += w1[0] * bflo(xv.z); a[5] += w1[1] * bfhi(xv.z); a[6] += w1[2] * bflo(xv.w); a[7] += w1[3] * bfhi(xv.w); } }
        u32x4 o; o.x = pk2(a[0], a[1]); o.y = pk2(a[2], a[3]); o.z = pk2(a[4], a[5]); o.w = pk2(a[6], a[7]);
        *(u32x4*)(XC + (size_t)row * 1024 + c8) = o;
    }
}
#define MK_DPP(oldv, src, ctrl) __builtin_bit_cast(float, __builtin_amdgcn_update_dpp(__builtin_bit_cast(int, (float)(oldv)), __builtin_bit_cast(int, (float)(src)), ctrl, 0xF, 0xF, false))
struct EpiGates {
    const bf16_t* XC; bf16_t *HLf, *Pf, *HLb, *Pb; float* agg; const float* ba; const float* bx; const float* lam;
    __device__ __forceinline__ void operator()(const f32x4 (&acc)[2][2][4][2], const Unit& u, int wr, int wc, int fr, int fq, LAS unsigned char*, int, int) const {
        const int c0 = 256 * (u.pn >> 2) + 64 * (u.pn & 3) + 16 * wc + 4 * fq;
#pragma unroll
        for (int d = 0; d < 2; ++d) {
            const f32x4 bav = *(const f32x4*)(ba + d * 1024 + c0), bxv = *(const f32x4*)(bx + d * 1024 + c0), lmv = *(const f32x4*)(lam + d * 1024 + c0);
            f32x4 spv;
#pragma unroll
            for (int j = 0; j < 4; ++j) { const float l = lmv[j]; spv[j] = (l > 0.f) ? log1pf(__expf(-l)) : (-l + log1pf(__expf(l))); }
            bf16_t* HL = d ? HLb : HLf; bf16_t* PP = d ? Pb : Pf;
#pragma unroll
            for (int ai = 0; ai < 2; ++ai) {
                const int grow0 = u.pm * 256 + ai * HALF + wr * 64, gidx = grow0 >> 6;
                unsigned hlw[4][2], ppw[4][2];
                u32x2 xw[4];
#pragma unroll
                for (int m = 0; m < 4; ++m) xw[m] = *(const u32x2*)((const char*)XC + (unsigned)(((grow0 + m * 16 + fr) * 1024 + c0) * 2));
#pragma unroll
                for (int jp = 0; jp < 2; ++jp) {
                    __builtin_amdgcn_sched_barrier(0);
                    float A[4][2], U[4][2];
#pragma unroll
                    for (int m = 0; m < 4; ++m) { const unsigned xww = jp ? xw[m].y : xw[m].x; const float xc[2] = {bflo(xww), bfhi(xww)};
                        const f32x4 pa = d ? acc[ai][1][m][0] : acc[ai][0][m][0], px = d ? acc[ai][1][m][1] : acc[ai][0][m][1];
#pragma unroll
                        for (int jj = 0; jj < 2; ++jj) { const int j = 2 * jp + jj; const float r = fsigmoid(pa[j] + bav[j]), ig = fsigmoid(px[j] + bxv[j]); const float la = -8.f * r * spv[j];
                            A[m][jj] = __expf(la); U[m][jj] = sqrtf(fmaxf(1.f - __expf(2.f * la), 0.f)) * (ig * xc[jj]); } }
#pragma unroll
                    for (int jj = 0; jj < 2; ++jj) { const int j = 2 * jp + jj;
                        if (d == 0) {
                            float ca = 1.f, cu = 0.f;
#pragma unroll
                            for (int m = 0; m < 4; ++m) { float a = A[m][jj], x = U[m][jj]; float ap, up;
                                ap = MK_DPP(1.f, a, 0x111); up = MK_DPP(0.f, x, 0x111); x = a * up + x; a = a * ap;
                                ap = MK_DPP(1.f, a, 0x112); up = MK_DPP(0.f, x, 0x112); x = a * up + x; a = a * ap;
                                ap = MK_DPP(1.f, a, 0x114); up = MK_DPP(0.f, x, 0x114); x = a * up + x; a = a * ap;
                                ap = MK_DPP(1.f, a, 0x118); up = MK_DPP(0.f, x, 0x118); x = a * up + x; a = a * ap;
                                x = a * cu + x; a = a * ca; A[m][jj] = a; U[m][jj] = x; ca = __shfl(a, 15, 16); cu = __shfl(x, 15, 16); }
                            if (fr == 15) { agg[((size_t)(gidx * 2 + 0) * 2 + 0) * 1024 + c0 + j] = A[3][jj]; agg[((size_t)(gidx * 2 + 0) * 2 + 1) * 1024 + c0 + j] = U[3][jj]; }
                        } else {
                            float ca = 1.f, cu = 0.f;
#pragma unroll
                            for (int mm = 0; mm < 4; ++mm) { const int m = 3 - mm; float a = A[m][jj], x = U[m][jj]; float ap, up;
                                ap = MK_DPP(1.f, a, 0x101); up = MK_DPP(0.f, x, 0x101); x = a * up + x; a = a * ap;
                                ap = MK_DPP(1.f, a, 0x102); up = MK_DPP(0.f, x, 0x102); x = a * up + x; a = a * ap;
                                ap = MK_DPP(1.f, a, 0x104); up = MK_DPP(0.f, x, 0x104); x = a * up + x; a = a * ap;
                                ap = MK_DPP(1.f, a, 0x108); up = MK_DPP(0.f, x, 0x108); x = a * up + x; a = a * ap;
                                x = a * cu + x; a = a * ca; A[m][jj] = a; U[m][jj] = x; ca = __shfl(a, 0, 16); cu = __shfl(x, 0, 16); }
                            if (fr == 0) { agg[((size_t)(gidx * 2 + 1) * 2 + 0) * 1024 + c0 + j] = A[0][jj]; agg[((size_t)(gidx * 2 + 1) * 2 + 1) * 1024 + c0 + j] = U[0][jj]; }
                        }
                    }
#pragma unroll
                    for (int m = 0; m < 4; ++m) { hlw[m][jp] = cvt_pk_bf16(U[m][0], U[m][1]); ppw[m][jp] = cvt_pk_bf16(A[m][0], A[m][1]); }
                }
#pragma unroll
                for (int m = 0; m < 4; ++m) { const unsigned off = (unsigned)(((grow0 + m * 16 + fr) * 1024 + c0) * 2);
                    *(u32x2*)((char*)HL + off) = (u32x2){hlw[m][0], hlw[m][1]}; *(u32x2*)((char*)PP + off) = (u32x2){ppw[m][0], ppw[m][1]}; }
                asm volatile("" ::: "memory");
            }
        }
    }
};
__device__ __forceinline__ void lru_gscan_phase(const Frame& F, const float* agg, float* hin) {
    const int lane = lane_id_v(); const int gt = F.gw * 64 + lane;
    if (gt >= 4096) return;
    const int b = gt >> 11, d = (gt >> 10) & 1, c = gt & 1023;
    float h = 0.f;
    for (int s = 0; s < 132; ++s) {
        const int g = (s < 4) ? (256 + 4 * b + (d ? (3 - s) : s)) : (128 * b + (d ? (127 - (s - 4)) : (s - 4)));
        const float pt = agg[((size_t)(g * 2 + d) * 2 + 0) * 1024 + c], ht = agg[((size_t)(g * 2 + d) * 2 + 1) * 1024 + c];
        hin[(size_t)(g * 2 + d) * 1024 + c] = h;
        h = pt * h + ht;
    }
}
__device__ __forceinline__ void lru_final_phase(const Frame& F, const bf16_t* HLf, const bf16_t* Pf, const bf16_t* HLb, const bf16_t* Pb, const float* hin, const bf16_t* GG, bf16_t* Y) {
    const int lane = lane_id_v(); const int gt = F.gw * 64 + lane, ngt = F.NGW * 64;
    for (int it = gt; it < ML * 128; it += ngt) {
        const int row = it >> 7, c8 = (it & 127) * 8; const int t = row & 8191; const int prow = (row & ~8191) + (t & 63) * 128 + (t >> 6), g = prow >> 6;
        const size_t po = (size_t)prow * 1024 + c8;
        const u32x4 hf = *(const u32x4*)(HLf + po), pf = *(const u32x4*)(Pf + po), hb = *(const u32x4*)(HLb + po), pb = *(const u32x4*)(Pb + po), gg = *(const u32x4*)(GG + (size_t)row * 1024 + c8);
        const float* hif = hin + (size_t)(g * 2 + 0) * 1024 + c8; const float* hib = hin + (size_t)(g * 2 + 1) * 1024 + c8;
        const f32x4 f0 = *(const f32x4*)hif, f1 = *(const f32x4*)(hif + 4), b0 = *(const f32x4*)hib, b1 = *(const f32x4*)(hib + 4);
        float y[8];
        y[0] = (bflo(hf.x) + bflo(pf.x) * f0[0] + bflo(hb.x) + bflo(pb.x) * b0[0]) * bflo(gg.x); y[1] = (bfhi(hf.x) + bfhi(pf.x) * f0[1] + bfhi(hb.x) + bfhi(pb.x) * b0[1]) * bfhi(gg.x);
        y[2] = (bflo(hf.y) + bflo(pf.y) * f0[2] + bflo(hb.y) + bflo(pb.y) * b0[2]) * bflo(gg.y); y[3] = (bfhi(hf.y) + bfhi(pf.y) * f0[3] + bfhi(hb.y) + bfhi(pb.y) * b0[3]) * bfhi(gg.y);
        y[4] = (bflo(hf.z) + bflo(pf.z) * f1[0] + bflo(hb.z) + bflo(pb.z) * b1[0]) * bflo(gg.z); y[5] = (bfhi(hf.z) + bfhi(pf.z) * f1[1] + bfhi(hb.z) + bfhi(pb.z) * b1[1]) * bfhi(gg.z);
        y[6] = (bflo(hf.w) + bflo(pf.w) * f1[2] + bflo(hb.w) + bflo(pb.w) * b1[2]) * bflo(gg.w); y[7] = (bfhi(hf.w) + bfhi(pf.w) * f1[3] + bfhi(hb.w) + bfhi(pb.w) * b1[3]) * bfhi(gg.w);
        u32x4 o; o.x = pk2(y[0], y[1]); o.y = pk2(y[2], y[3]); o.z = pk2(y[4], y[5]); o.w = pk2(y[6], y[7]);
        *(u32x4*)(Y + (size_t)row * 1024 + c8) = o;
    }
}
__device__ __forceinline__ void final_norm_phase(const Frame& F, float* lat, const float* g) {
    const int lane = lane_id_v();
    for (int row = F.gw; row < ML; row += F.NGW) {
        float* x = lat + (size_t)row * 1024; f32x4 xv[4]; float ss = 0.f;
#pragma unroll
        for (int j = 0; j < 4; ++j) { xv[j] = *(const f32x4*)(x + (lane + 64 * j) * 4); ss += (xv[j][0] * xv[j][0] + xv[j][1] * xv[j][1]) + (xv[j][2] * xv[j][2] + xv[j][3] * xv[j][3]); }
        const float rstd = rsqrtf(wave_sum(ss) * (1.f / 1024.f) + 1e-6f);
#pragma unroll
        for (int j = 0; j < 4; ++j) { const int cidx = (lane + 64 * j) * 4; *(f32x4*)(x + cidx) = xv[j] * rstd * *(const f32x4*)(g + cidx); }
    }
}

struct Args { const float* in[25]; float* out; unsigned char* ws; int ph_lo, ph_hi; };
__global__ void __launch_bounds__(NTHR, 2) mega(Args args) {
    extern __shared__ __attribute__((aligned(16))) unsigned char lds_raw[];
    LAS unsigned char* lds = (LAS unsigned char*)lds_raw;
    Frame F; F.lds = lds; F.wave = __builtin_amdgcn_readfirstlane(threadIdx.x >> 6); F.G = gridDim.x;
    F.gw = blockIdx.x * NWAVES + F.wave; F.NGW = F.G * NWAVES;
    volatile LAS unsigned* MISC = (volatile LAS unsigned*)(lds + MISC_OFF);
    if (threadIdx.x < 64) MISC[threadIdx.x] = 0u;
    __syncthreads();
    unsigned char* ws = args.ws;
    XcdBarrier bar = xcd_barrier_post((unsigned*)(ws + WS_CTL) + CW_BAR, MISC + 8);
    const float* x = args.in[0]; const float* cvec = args.in[1]; const float* ctx = args.in[2]; const float* cctx = args.in[3];
    const float* w_ada = args.in[4]; const float* b_ada = args.in[5]; const float* norm_g = args.in[6];
    const float* hg_w_in = args.in[7]; const float* hg_lb = args.in[8]; const float* hg_gn = args.in[9]; const float* hg_w_out = args.in[10];
    float* MOD = (float*)(ws + WS_MOD); float* LB = (float*)(ws + WS_LB); float* CXLAT = (float*)(ws + WS_CXLAT); float* SIDE = (float*)(ws + WS_SIDE);
    bf16_t* W_HGIN = (bf16_t*)(ws + WS_W_HGIN); bf16_t* W_HGOUT = (bf16_t*)(ws + WS_W_HGOUT); bf16_t* W_UP = (bf16_t*)(ws + WS_W_UP); bf16_t* W_DN0 = (bf16_t*)(ws + WS_W_DN0);
    bf16_t* W_LRUIN = (bf16_t*)(ws + WS_W_LRUIN); bf16_t* W_GATES = (bf16_t*)(ws + WS_W_GATES); bf16_t* W_LRUOUT = (bf16_t*)(ws + WS_W_LRUOUT); bf16_t* W_DN1 = (bf16_t*)(ws + WS_W_DN1);
    bf16_t* UEDGE = (bf16_t*)(ws + WS_UEDGE);
    const float* lru_w_in = args.in[11]; const float* lru_cw = args.in[12]; const float* lru_cb = args.in[13]; const float* lru_wa = args.in[14]; const float* lru_ba = args.in[15];
    const float* lru_wx = args.in[16]; const float* lru_bx = args.in[17]; const float* lru_lam = args.in[18]; const float* lru_w_out = args.in[19];
    const float* ffn_up = args.in[20]; const float* ffn_cw = args.in[21]; const float* ffn_cb = args.in[22]; const float* ffn_down = args.in[23]; const float* final_g = args.in[24];
    bf16_t* ACT[6];
#pragma unroll
    for (int i = 0; i < 6; ++i) ACT[i] = (bf16_t*)(ws + WS_ACT + (size_t)i * ACT_SLOT);
    bf16_t* Hd = (bf16_t*)args.out;
    const int lo = args.ph_lo, hi = args.ph_hi;
#define IN(k) (lo <= (k) && (k) < hi)
#define SEAM(k) do { if (IN(k) && IN((k) + 1)) xcd_barrier(bar, F.wave); } while (0)

    if (IN(0)) {
        adaln_phase(F, cvec, cctx, w_ada, b_ada, MOD);
        if (blockIdx.x == F.G - 1) for (int i = F.wave * 64 + lane_id_v(); i < 2048; i += NTHR) { const float l0 = hg_lb[i], l1 = hg_lb[2048 + i]; const float m = fmaxf(l0, l1), e0 = __expf(l0 - m), e1 = __expf(l1 - m); LB[i] = e0 / (e0 + e1); }
        __syncthreads();
        { ConvJob j{CV_HG, hg_w_in, nullptr, 1024, 5120, 5120, W_HGIN}; conv_job(F, j, F.gw, F.NGW); }
        { ConvJob j{CV_NAT, hg_w_out, nullptr, 1024, 1024, 1024, W_HGOUT}; conv_job(F, j, F.gw, F.NGW); }
        { ConvJob j{CV_UP, ffn_up, nullptr, 1024, 5632, 5632, W_UP}; conv_job(F, j, F.gw, F.NGW); }
        { ConvJob j{CV_NAT, ffn_down, nullptr, 2816, 1024, 1024, W_DN0}; conv_job(F, j, F.gw, F.NGW); }
    }
    SEAM(0);
    if (IN(1)) norm_phase(F, x, ctx, norm_g, MOD, 0, 1024, Hd, MT);
    SEAM(1);
    if (IN(2)) {
        Gemm g{Hd, W_HGIN, 1024, 1024, 1024, 0, 0}; StaticOrder S; S.init(NTM, 20, F.G, (int)blockIdx.x);
        EpiHgIn E{ACT[0], ACT[1], ACT[2], ACT[3], ACT[4], ACT[5], SIDE, LB};
        gemm_phase(lds, g, S, E, F.wave);
    }
    SEAM(2);
    if (IN(3)) {
        for (int ch = blockIdx.x; ch < 32; ch += F.G) { const int b = ch >> 4, h = (ch >> 1) & 7, d = ch & 1;
            hgrn_chain(lds, d ? ACT[2] : ACT[0], d ? ACT[3] : ACT[1], ACT[4], SIDE, b, h, d, F.wave); }
        if ((int)blockIdx.x >= 32) {
            const int gw2 = ((int)blockIdx.x - 32) * NWAVES + F.wave, ngw2 = (F.G - 32) * NWAVES;
            { ConvJob j{CV_PERM8, lru_w_in, nullptr, 1024, 2048, 2048, W_LRUIN}; conv_job(F, j, gw2, ngw2); }
            { ConvJob j{CV_GATES, lru_wa, lru_wx, 256, 4096, 256, W_GATES}; conv_job(F, j, gw2, ngw2); }
            { ConvJob j{CV_NAT, lru_w_out, nullptr, 1024, 1024, 1024, W_LRUOUT}; conv_job(F, j, gw2, ngw2); }
            { ConvJob j{CV_NAT, ffn_down + (size_t)2816 * 1024, nullptr, 2816, 1024, 1024, W_DN1}; conv_job(F, j, gw2, ngw2); }
        }
    }
    SEAM(3);
    if (IN(4)) readout_phase(F, ACT[0], ACT[2], ACT[5], hg_gn, ACT[1]);
    SEAM(4);
    if (IN(5)) {
        Gemm g{ACT[1], W_HGOUT, 1024, 1024, 1024, 0, 0}; StaticOrder S; S.init(NTM, 4, F.G, (int)blockIdx.x);
        EpiResid E{x, ctx, args.out, CXLAT, MOD, 2048};
        gemm_phase(lds, g, S, E, F.wave);
    }
    SEAM(5);
    if (IN(6)) norm_phase(F, args.out, CXLAT, norm_g + 1024, MOD, 3072, 4096, ACT[5], MT);
    SEAM(6);
    if (IN(7)) {
        Gemm g{ACT[5], W_UP, 1024, 1024, 1024, 0, 0}; StaticOrder S; S.init(NTM, 22, F.G, (int)blockIdx.x);
        EpiUpConv E{ACT[0], UEDGE, ffn_cw, ffn_cb};
        gemm_phase(lds, g, S, E, F.wave);
    }
    SEAM(7);
    if (IN(8)) {
        StaticOrder S; S.init(NTM, 4, F.G, (int)blockIdx.x);
        { Unit u; const int tid = F.wave * 64 + lane_id_v(); for (int i = 0; S.next(i, u); ++i) ffn_fix_edges(tid, u.pm, ACT[0], UEDGE, ffn_cw, ffn_cb); }
        VM_WAIT(); __syncthreads();
        Gemm g{ACT[0], W_DN0, 2816, 2816, 2816, 0, 0};
        EpiResid E{args.out, CXLAT, args.out, CXLAT, MOD, 5120};
        gemm_phase(lds, g, S, E, F.wave);
    }
    SEAM(8);
    float* MOD1 = MOD + 3 * 6144; float* AGG = SIDE; float* HIN = (float*)(ws + WS_SIDE + 4 * MiB + 256 * 1024);
    if (IN(9)) {
        norm_phase(F, args.out, CXLAT, norm_g + 2048, MOD1, 0, 1024, ACT[0], MT);
        { ConvJob j{CV_UP, ffn_up + (size_t)1024 * 5632, nullptr, 1024, 5632, 5632, W_UP}; conv_job(F, j, F.gw, F.NGW); }
    }
    SEAM(9);
    if (IN(10)) {
        Gemm g{ACT[0], W_LRUIN, 1024, 1024, 1024, 0, 0}; StaticOrder S; S.init(NTM, 8, F.G, (int)blockIdx.x);
        EpiLruIn E{ACT[1], ACT[2]};
        gemm_phase(lds, g, S, E, F.wave);
    }
    SEAM(10);
    if (IN(11)) lru_conv_phase(F, ACT[2], lru_cw, lru_cb, ACT[3]);
    SEAM(11);
    if (IN(12)) {
        Gemm g{ACT[3], W_GATES, 1024, 256, 256, 2, 256}; StaticOrder S; S.init(NTM, 16, F.G, (int)blockIdx.x);
        EpiGates E{ACT[3], ACT[0], ACT[4], ACT[5], ACT[2], AGG, lru_ba, lru_bx, lru_lam};
        gemm_phase(lds, g, S, E, F.wave);
    }
    SEAM(12);
    if (IN(13)) lru_gscan_phase(F, AGG, HIN);
    SEAM(13);
    if (IN(14)) lru_final_phase(F, ACT[0], ACT[4], ACT[5], ACT[2], HIN, ACT[1], ACT[3]);
    SEAM(14);
    if (IN(15)) {
        Gemm g{ACT[3], W_LRUOUT, 1024, 1024, 1024, 0, 0}; StaticOrder S; S.init(64, 4, F.G, (int)blockIdx.x);
        EpiResid E{args.out, CXLAT, args.out, CXLAT, MOD1, 2048};
        gemm_phase(lds, g, S, E, F.wave);
    }
    SEAM(15);
    if (IN(16)) norm_phase(F, args.out, CXLAT, norm_g + 3072, MOD1, 3072, 4096, ACT[5], ML);
    SEAM(16);
    if (IN(17)) {
        Gemm g{ACT[5], W_UP, 1024, 1024, 1024, 0, 0}; StaticOrder S; S.init(64, 22, F.G, (int)blockIdx.x);
        EpiUpConv E{ACT[0], UEDGE, ffn_cw + 3 * 5632, ffn_cb + 5632};
        gemm_phase(lds, g, S, E, F.wave);
    }
    SEAM(17);
    if (IN(18)) {
        StaticOrder S; S.init(64, 4, F.G, (int)blockIdx.x);
        { Unit u; const int tid = F.wave * 64 + lane_id_v(); for (int i = 0; S.next(i, u); ++i) ffn_fix_edges(tid, u.pm, ACT[0], UEDGE, ffn_cw + 3 * 5632, ffn_cb + 5632); }
        VM_WAIT(); __syncthreads();
        Gemm g{ACT[0], W_DN1, 2816, 2816, 2816, 0, 0};
        EpiResid E{args.out, CXLAT, args.out, CXLAT, MOD1, 5120};
        gemm_phase(lds, g, S, E, F.wave);
    }
    SEAM(18);
    if (IN(19)) final_norm_phase(F, args.out, final_g);
#undef IN
#undef SEAM
}
}
__global__ void __launch_bounds__(128) k_refscan(unsigned short* QF, const unsigned short* KF, unsigned short* QB, const unsigned short* KB, const unsigned short* V, const float* side) {
    const int ch = blockIdx.x, b = ch >> 4, h = (ch >> 1) & 7, d = ch & 1, t = threadIdx.x;
    unsigned short* Qd = d ? QB : QF; const unsigned short* Kd = d ? KB : KF;
    __shared__ float q[64][129], k[64][129], vs[64][128], P[64][65], e1[128], e2[128], dec[128];
    float S[128];
#pragma unroll
    for (int i = 0; i < 128; ++i) S[i] = 0.f;
    for (int s = 0; s < 132; ++s) {
        const int rb = (s < 4) ? (16384 + b * 256 + 64 * (d ? (3 - s) : s)) : (b * 8192 + 64 * (d ? (127 - (s - 4)) : (s - 4)));
        const int ck = rb >> 6;
        for (int idx = t; idx < 8192; idx += 128) { const int r = idx >> 7, c = idx & 127; const size_t g = (size_t)(rb + r) * 1024 + h * 128 + c;
            q[r][c] = mk::bf2f(Qd[g]); k[r][c] = mk::bf2f(Kd[g]); vs[r][c] = mk::bf2f(V[g]); }
        e1[t] = side[((size_t)(ck * 2 + d) * 3 + 0) * 1024 + h * 128 + t]; e2[t] = side[((size_t)(ck * 2 + d) * 3 + 1) * 1024 + h * 128 + t]; dec[t] = side[((size_t)(ck * 2 + d) * 3 + 2) * 1024 + h * 128 + t];
        __syncthreads();
        for (int idx = t; idx < 4096; idx += 128) { const int i = idx >> 6, j = idx & 63; const bool ok = d ? (j >= i) : (j <= i); float p = 0.f;
            if (ok) for (int c = 0; c < 128; ++c) p += q[i][c] * k[j][c];
            P[i][j] = p; }
        __syncthreads();
        for (int i = 0; i < 64; ++i) { float o = 0.f;
#pragma unroll
            for (int c = 0; c < 128; ++c)
#ifdef UNIT_SIDE
                o += q[i][c] * S[c];
#else
                o += q[i][c] * (e1[c] * S[c]);
#endif

            for (int j = 0; j < 64; ++j) o += P[i][j] * vs[j][t];
            Qd[(size_t)(rb + i) * 1024 + h * 128 + t] = (unsigned short)mk::f2bf(o); }
#pragma unroll
        for (int c = 0; c < 128; ++c) { float u = 0.f; for (int j = 0; j < 64; ++j) u += k[j][c] * vs[j][t];
#ifdef ZERO_STATE
            S[c] = 0.f;
#elif defined(UNIT_SIDE)
            S[c] = S[c] + u;
#else
            S[c] = dec[c] * S[c] + e2[c] * u;
#endif
        }
        __syncthreads();
    }
}

#ifndef MK_CUT
#define MK_CUT 1
#endif
#ifndef MK_ONE_LAUNCH
#define MK_ONE_LAUNCH 0
#endif
static void gemm(hipStream_t s, const float* A, int lda, const float* B, int ldb, float* C, int ldc, int M, int N, int K) {
    dim3 g(N / 64, (M + 63) / 64);
    hipLaunchKernelGGL(k_gemm, g, dim3(256), 0, s, A, lda, B, ldb, C, ldc, M, N, K);
}

extern "C" void kernel_launch(void* const* d_in, const int* in_sizes, int n_in, void* d_out, int out_size, void* d_ws, size_t ws_size, hipStream_t stream) {
    const float* norm_g = (const float*)d_in[6];
    const float* lru_w_in = (const float*)d_in[11]; const float* lru_cw = (const float*)d_in[12]; const float* lru_cb = (const float*)d_in[13];
    const float* lru_wa = (const float*)d_in[14]; const float* lru_ba = (const float*)d_in[15]; const float* lru_wx = (const float*)d_in[16]; const float* lru_bx = (const float*)d_in[17];
    const float* lru_lam = (const float*)d_in[18]; const float* lru_w_out = (const float*)d_in[19];
    const float* ffn_up = (const float*)d_in[20]; const float* ffn_cw = (const float*)d_in[21]; const float* ffn_cb = (const float*)d_in[22]; const float* ffn_down = (const float*)d_in[23];
    const float* final_g = (const float*)d_in[24];
    float* out = (float*)d_out;
    char* ws = (char*)d_ws;
    static int grid = 0;
    if (grid == 0) {
        int dev = 0, cus = 0, per_cu = 0;
        hipGetDevice(&dev); hipDeviceGetAttribute(&cus, hipDeviceAttributeMultiprocessorCount, dev);
        hipFuncSetAttribute((const void*)mk::mega, hipFuncAttributeMaxDynamicSharedMemorySize, mk::LDS_BYTES);
        hipOccupancyMaxActiveBlocksPerMultiprocessor(&per_cu, (const void*)mk::mega, mk::NTHR, mk::LDS_BYTES);
        (void)hipGetLastError();
        if (per_cu < 1) fprintf(stderr, "kernel_launch: occupancy query says %d blocks/CU\n", per_cu);
        grid = cus > 0 ? cus : 256;
    }
    hipMemsetAsync(ws + mk::WS_CTL, 0, 1u << 20, stream);
    mk::Args a{};
    for (int i = 0; i < 25; ++i) a.in[i] = (const float*)d_in[i];
    a.out = out; a.ws = (unsigned char*)d_ws;
    const int nph = (MK_CUT == 1) ? 6 : (MK_CUT == 2) ? 9 : (MK_CUT == 3) ? 16 : 20;
#if MK_ONE_LAUNCH
    a.ph_lo = 0; a.ph_hi = nph;
    hipLaunchKernelGGL(mk::mega, dim3(grid), dim3(mk::NTHR), mk::LDS_BYTES, stream, a);
#else
    for (int p = 0; p < nph; ++p) { a.ph_lo = p; a.ph_hi = p + 1;
#ifdef CMP_SCAN
        if (p == 3) { unsigned short* A0 = (unsigned short*)(ws + mk::WS_ACT); const size_t SL = mk::ACT_SLOT / 2; int* flag = (int*)(ws + 255 * (1u << 20));
            hipMemcpyAsync(d_out, A0, mk::ACT_SLOT, hipMemcpyDeviceToDevice, stream);
            hipLaunchKernelGGL(k_refscan, dim3(32), dim3(128), 0, stream, (unsigned short*)d_out, A0 + SL, A0 + 2 * SL, A0 + 3 * SL, A0 + 4 * SL, (const float*)(ws + mk::WS_SIDE));
            hipMemcpyAsync(A0 + 2 * SL, A0 + 2 * SL, 0, hipMemcpyDeviceToDevice, stream);
            hipLaunchKernelGGL(mk::mega, dim3(grid), dim3(mk::NTHR), mk::LDS_BYTES, stream, a);
            hipLaunchKernelGGL(k_flag1000, dim3(1), dim3(64), 0, stream, flag);
            hipLaunchKernelGGL(k_cmpscan, dim3(132, 16), dim3(256), 0, stream, A0, (const unsigned short*)d_out, flag);
            { const size_t n = (size_t)16384 * 1024; hipLaunchKernelGGL(k_diagout2, dim3((n + 255) / 256), dim3(256), 0, stream, (float*)d_out, n, flag); }
            return; }
#endif
#ifdef USE_REFSCAN
        if (p == 3) { unsigned short* A0 = (unsigned short*)(ws + mk::WS_ACT); const size_t SL = mk::ACT_SLOT / 2;
            hipLaunchKernelGGL(k_refscan, dim3(32), dim3(128), 0, stream, A0, A0 + SL, A0 + 2 * SL, A0 + 3 * SL, A0 + 4 * SL, (const float*)(ws + mk::WS_SIDE)); continue; }
#endif
        hipLaunchKernelGGL(mk::mega, dim3(grid), dim3(mk::NTHR), mk::LDS_BYTES, stream, a); }
#endif
    const size_t MB = 1u << 20;
    float* CXLAT = (float*)(ws + mk::WS_CXLAT);
    float* MOD = (float*)(ws + mk::WS_MOD);
    char* arena = ws + 14 * MB;
    const size_t RBD = (size_t)RB * D * 4;
    float* BUF_H = (float*)(arena);
    float* BUF_O = (float*)(arena + RBD);
    float* BUF_Z = (float*)(arena + 2 * RBD);
    auto ffn = [&](int l, float* lat_seq, int seq_len, const float* modv) {
        const float* sh2 = modv + 3 * D; const float* sc2 = modv + 4 * D; const float* g2 = modv + 5 * D;
        const float* Wup = ffn_up + (size_t)l * D * 2 * DFF; const float* Wdn = ffn_down + (size_t)l * DFF * D;
        const float* cw = ffn_cw + (size_t)l * 3 * 2 * DFF; const float* cb = ffn_cb + (size_t)l * 2 * DFF;
        float* Hn = BUF_H;
        hipLaunchKernelGGL(k_norm_mod, dim3(seq_len), dim3(256), 0, stream, lat_seq, Hn, norm_g + (size_t)(l * 2 + 1) * D, sh2, sc2, seq_len);
        const int CH = 2048;
        float* U = BUF_Z; float* G = BUF_Z + (size_t)(CH + 2) * 2 * DFF; float* Y = G + (size_t)CH * DFF;
        for (int r0 = 0; r0 < seq_len; r0 += CH) {
            const int r1 = (r0 + CH < seq_len) ? r0 + CH : seq_len;
            const int u0 = r0 > 0 ? r0 - 1 : 0, u1 = r1 < seq_len ? r1 + 1 : seq_len;
            gemm(stream, Hn + (size_t)u0 * D, D, Wup, 2 * DFF, U, 2 * DFF, u1 - u0, 2 * DFF, D);
            const size_t n = (size_t)(r1 - r0) * DFF;
            hipLaunchKernelGGL(k_ffn_conv, dim3((n + 255) / 256), dim3(256), 0, stream, U, u0, cw, cb, G, r0, r1, seq_len);
            gemm(stream, G, DFF, Wdn, D, Y, D, r1 - r0, D, DFF);
            const size_t n2 = (size_t)(r1 - r0) * D;
            hipLaunchKernelGGL(k_resid, dim3((n2 + 255) / 256), dim3(256), 0, stream, lat_seq + (size_t)r0 * D, Y, g2, lat_seq + (size_t)r0 * D, n2);
        }
    };
    for (int b = 0; b < BATCH; ++b) {
        float* latL = out + (size_t)b * SEQ * D; float* latC = CXLAT + (size_t)b * CTX * D;
        if (MK_CUT < 2) {
            const float* modL = MOD + (size_t)b * 6 * D; const float* modC = MOD + (size_t)2 * 6 * D;
            ffn(0, latL, SEQ, modL);
            ffn(0, latC, CTX, modC);
        }
        if (MK_CUT < 3) {
            const float* modL = MOD + (size_t)18 * D + (size_t)b * 6 * D; const float* modC = MOD + (size_t)18 * D + (size_t)2 * 6 * D;
            const float* ng = norm_g + (size_t)2 * D;
            hipLaunchKernelGGL(k_norm_mod, dim3(CTX), dim3(256), 0, stream, latC, BUF_H, ng, modC, modC + D, CTX);
            hipLaunchKernelGGL(k_norm_mod, dim3(SEQ), dim3(256), 0, stream, latL, BUF_H + (size_t)CTX * D, ng, modL, modL + D, SEQ);
            float* Z2 = BUF_Z; float* XC = BUF_Z + (size_t)RB * 2 * D; float* PA = XC + (size_t)RB * D; float* PX = PA + (size_t)RB * D;
            float* Hf = BUF_H; float* Hb = BUF_O;
            gemm(stream, BUF_H, D, lru_w_in, 2 * D, Z2, 2 * D, RB, 2 * D, D);
            { const size_t n = (size_t)RB * D; hipLaunchKernelGGL(k_lru_conv, dim3((n + 255) / 256), dim3(256), 0, stream, Z2, lru_cw, lru_cb, XC); }
            for (int d = 0; d < 2; ++d) {
                for (int nb = 0; nb < 4; ++nb) {
                    gemm(stream, XC + nb * 256, D, lru_wa + (size_t)(d * 4 + nb) * 256 * 256, 256, PA + nb * 256, D, RB, 256, 256);
                    gemm(stream, XC + nb * 256, D, lru_wx + (size_t)(d * 4 + nb) * 256 * 256, 256, PX + nb * 256, D, RB, 256, 256);
                }
                hipLaunchKernelGGL(k_lru_scan, dim3(D / 64), dim3(64), 0, stream, XC, PA, PX, lru_ba, lru_bx, lru_lam, d ? Hb : Hf, d);
            }
            float* Y = PA;
            { const size_t n = (size_t)SEQ * D; hipLaunchKernelGGL(k_lru_out, dim3((n + 255) / 256), dim3(256), 0, stream, Hf, Hb, Z2, Y); }
            float* Y2 = PX;
            gemm(stream, Y, D, lru_w_out, D, Y2, D, SEQ, D, D);
            { const size_t n = (size_t)SEQ * D; hipLaunchKernelGGL(k_resid, dim3((n + 255) / 256), dim3(256), 0, stream, latL, Y2, modL + 2 * D, latL, n); }
        }
        if (MK_CUT < 4) {
            const float* modL = MOD + (size_t)18 * D + (size_t)b * 6 * D;
            ffn(1, latL, SEQ, modL);
            hipLaunchKernelGGL(k_norm_mod, dim3(SEQ), dim3(256), 0, stream, latL, latL, final_g, (const float*)nullptr, (const float*)nullptr, SEQ);
        }
    }
}
```

```cpp
#define MK_CUT 4
#define MK_ONE_LAUNCH 1
#include <hip/hip_runtime.h>
#include <cstdint>
#include <cstdio>

constexpr int D = 1024, BATCH = 2, SEQ = 8192, CTX = 256, GW = 64, GROWS = SEQ / GW;
constexpr int NH = 8, DK = 128, DV = 128, DFF = 2816;
constexpr int RB = CTX + SEQ;
constexpr float EPS = 1e-6f;

__device__ __forceinline__ float sigmoidf_(float x) { return 1.f / (1.f + __expf(-x)); }
__device__ __forceinline__ float siluf_(float x) { return x * sigmoidf_(x); }
__device__ __forceinline__ float gelu_tanh(float x) { const float k = 0.7978845608028654f; return 0.5f * x * (1.f + tanhf(k * (x + 0.044715f * x * x * x))); }

__global__ void k_adaln(const float* __restrict__ c, const float* __restrict__ cctx, const float* __restrict__ W, const float* __restrict__ bias, float* __restrict__ mod) {
    __shared__ float s[3][D];
    for (int i = threadIdx.x; i < D; i += blockDim.x) { s[0][i] = siluf_(c[i]); s[1][i] = siluf_(c[D + i]); s[2][i] = siluf_(cctx[i]); }
    __syncthreads();
    const int j = blockIdx.x * blockDim.x + threadIdx.x;
    if (j >= 6 * D) return;
    float a0 = 0.f, a1 = 0.f, a2 = 0.f;
    for (int k = 0; k < D; ++k) { const float w = W[(size_t)k * 6 * D + j]; a0 += s[0][k] * w; a1 += s[1][k] * w; a2 += s[2][k] * w; }
    const float bb = bias[j];
    mod[j] = a0 + bb; mod[6 * D + j] = a1 + bb; mod[12 * D + j] = a2 + bb;
}

__global__ void k_lb(const float* __restrict__ logits, float* __restrict__ lb) {
    const int i = blockIdx.x * blockDim.x + threadIdx.x;
    if (i >= 2 * D) return;
    const float l0 = logits[i], l1 = logits[2 * D + i];
    const float m = fmaxf(l0, l1), e0 = __expf(l0 - m), e1 = __expf(l1 - m);
    lb[i] = e0 / (e0 + e1);
}

__global__ void k_norm_mod(const float* in, float* out, const float* __restrict__ g, const float* __restrict__ sh, const float* __restrict__ sc, int rows) {
    const int r = blockIdx.x; if (r >= rows) return;
    const float* x = in + (size_t)r * D; float* o = out + (size_t)r * D;
    float v[4]; float ss = 0.f;
    for (int i = 0; i < 4; ++i) { v[i] = x[threadIdx.x + 256 * i]; ss += v[i] * v[i]; }
    __shared__ float red[256];
    red[threadIdx.x] = ss; __syncthreads();
    for (int s = 128; s > 0; s >>= 1) { if (threadIdx.x < s) red[threadIdx.x] += red[threadIdx.x + s]; __syncthreads(); }
    const float rstd = rsqrtf(red[0] / D + EPS);
    for (int i = 0; i < 4; ++i) { const int cidx = threadIdx.x + 256 * i; float y = v[i] * rstd * g[cidx]; if (sc) y = y * (1.f + sc[cidx]) + sh[cidx]; o[cidx] = y; }
}

__global__ void __launch_bounds__(256) k_gemm(const float* __restrict__ A, int lda, const float* __restrict__ B, int ldb, float* __restrict__ C, int ldc, int M, int N, int K) {
    __shared__ float As[16][64 + 4], Bs[16][64 + 4];
    const int tx = threadIdx.x % 16, ty = threadIdx.x / 16;
    const int m0 = blockIdx.y * 64, n0 = blockIdx.x * 64;
    float acc[4][4] = {};
    for (int k0 = 0; k0 < K; k0 += 16) {
        for (int i = threadIdx.x; i < 64 * 16; i += 256) { const int r = i / 16, kk = i % 16; As[kk][r] = (m0 + r < M) ? A[(size_t)(m0 + r) * lda + k0 + kk] : 0.f; }
        for (int i = threadIdx.x; i < 64 * 16; i += 256) { const int kk = i / 64, cc = i % 64; Bs[kk][cc] = B[(size_t)(k0 + kk) * ldb + n0 + cc]; }
        __syncthreads();
#pragma unroll
        for (int kk = 0; kk < 16; ++kk) {
            float a[4], b[4];
#pragma unroll
            for (int i = 0; i < 4; ++i) { a[i] = As[kk][ty * 4 + i]; b[i] = Bs[kk][tx * 4 + i]; }
#pragma unroll
            for (int i = 0; i < 4; ++i)
#pragma unroll
                for (int j = 0; j < 4; ++j) acc[i][j] += a[i] * b[j];
        }
        __syncthreads();
    }
    for (int i = 0; i < 4; ++i) { const int r = m0 + ty * 4 + i; if (r < M) for (int j = 0; j < 4; ++j) C[(size_t)r * ldc + n0 + tx * 4 + j] = acc[i][j]; }
}

__global__ void __launch_bounds__(128) k_hgrn_scan(const float* __restrict__ Z, const float* __restrict__ lb, float* __restrict__ Of, float* __restrict__ Ob) {
    const int h = blockIdx.x, d = blockIdx.y, t = threadIdx.x;
    float* O = d ? Ob : Of;
    __shared__ float sq[DK], sf[DK], sk[DK];
    float S[DK];
#pragma unroll
    for (int i = 0; i < DK; ++i) S[i] = 0.f;
    const float lbv = lb[d * D + h * DK + t];
    for (int step = 0; step < RB; ++step) {
        int row;
        if (step < CTX) row = d ? (CTX - 1 - step) : step;
        else { const int s = step - CTX; row = CTX + (d ? (SEQ - 1 - s) : s); }
        const float* z = Z + (size_t)row * 5 * D;
        const float qv = siluf_(z[h * DK + t]);
        const float f = lbv + (1.f - lbv) * sigmoidf_(z[(1 + d) * D + h * DK + t]);
        sq[t] = qv; sf[t] = f; sk[t] = 1.f - f;
        const float v = z[3 * D + h * DV + t];
        __syncthreads();
        float o = 0.f;
#pragma unroll
        for (int i = 0; i < DK; ++i) { S[i] = sf[i] * S[i] + sk[i] * v; o += sq[i] * S[i]; }
        O[(size_t)row * D + h * DV + t] = o;
        __syncthreads();
    }
}

__global__ void __launch_bounds__(128) k_hgrn_readout(const float* Of, const float* Ob, const float* __restrict__ Z, const float* __restrict__ gn, float* R, int rows) {
    const int r = blockIdx.x; if (r >= rows) return;
    __shared__ float red[128];
    for (int h = 0; h < NH; ++h) {
        const int cidx = h * DV + threadIdx.x;
        const float o = Of[(size_t)r * D + cidx] + Ob[(size_t)r * D + cidx];
        red[threadIdx.x] = o * o; __syncthreads();
        for (int s = 64; s > 0; s >>= 1) { if (threadIdx.x < s) red[threadIdx.x] += red[threadIdx.x + s]; __syncthreads(); }
        const float rstd = rsqrtf(red[0] / DV + EPS);
        __syncthreads();
        const float gte = siluf_(Z[(size_t)r * 5 * D + 4 * D + cidx]);
        R[(size_t)r * D + cidx] = o * rstd * gn[threadIdx.x] * gte;
    }
}

__global__ void k_resid(const float* base, const float* Y, const float* __restrict__ gate, float* out, size_t n) {
    const size_t i = (size_t)blockIdx.x * blockDim.x + threadIdx.x; if (i >= n) return;
    out[i] = base[i] + gate[i % D] * Y[i];
}

__global__ void k_ffn_conv(const float* __restrict__ U, int urow0, const float* __restrict__ cw, const float* __restrict__ cb, float* __restrict__ G, int r0, int r1, int seq_len) {
    const size_t i = (size_t)blockIdx.x * blockDim.x + threadIdx.x;
    const size_t n = (size_t)(r1 - r0) * DFF; if (i >= n) return;
    const int r = r0 + (int)(i / DFF), cidx = (int)(i % DFF);
    float u[2];
    for (int half = 0; half < 2; ++half) {
        const int cc = cidx + half * DFF; float a = cb[cc];
        for (int k = 0; k < 3; ++k) { const int rr = r + k - 1; if (rr >= 0 && rr < seq_len) a += cw[k * 2 * DFF + cc] * U[(size_t)(rr - urow0) * 2 * DFF + cc]; }
        u[half] = a;
    }
    G[i] = siluf_(u[0]) * u[1];
}

__device__ __forceinline__ int lat_row_of_cm(int p) { return CTX + (p % GROWS) * GW + p / GROWS; }
__global__ void k_lru_conv(const float* __restrict__ Z2, const float* __restrict__ cw, const float* __restrict__ cb, float* __restrict__ XC) {
    const size_t i = (size_t)blockIdx.x * blockDim.x + threadIdx.x; if (i >= (size_t)RB * D) return;
    const int pos = (int)(i / D), cidx = (int)(i % D);
    float a = cb[cidx];
    if (pos < CTX) { for (int k = 0; k < 4; ++k) { const int pp = pos + k - 2; if (pp >= 0 && pp < CTX) a += cw[k * D + cidx] * Z2[(size_t)pp * 2 * D + D + cidx]; } }
    else { const int p = pos - CTX; for (int k = 0; k < 4; ++k) { const int pp = p + k - 2; if (pp >= 0 && pp < SEQ) a += cw[k * D + cidx] * Z2[(size_t)lat_row_of_cm(pp) * 2 * D + D + cidx]; } }
    XC[i] = a;
}
__global__ void k_lru_scan(const float* __restrict__ XC, const float* __restrict__ PA, const float* __restrict__ PX, const float* __restrict__ ba, const float* __restrict__ bx, const float* __restrict__ lam, float* __restrict__ Hd, int d) {
    const int cidx = blockIdx.x * blockDim.x + threadIdx.x; if (cidx >= D) return;
    const float bav = ba[d * D + cidx], bxv = bx[d * D + cidx];
    const float l = lam[d * D + cidx]; const float sp = (l > 0.f) ? log1pf(__expf(-l)) : (-l + log1pf(__expf(l)));
    float h = 0.f;
    for (int step = 0; step < RB; ++step) {
        int pos;
        if (step < CTX) pos = d ? (CTX - 1 - step) : step;
        else { const int s = step - CTX; pos = CTX + (d ? (SEQ - 1 - s) : s); }
        const size_t o = (size_t)pos * D + cidx;
        const float r = sigmoidf_(PA[o] + bav), ig = sigmoidf_(PX[o] + bxv);
        const float la = -8.f * r * sp; const float a = __expf(la); const float mult = sqrtf(-expm1f(2.f * la));
        h = a * h + mult * (ig * XC[o]);
        Hd[o] = h;
    }
}
__global__ void k_lru_out(const float* __restrict__ Hf, const float* __restrict__ Hb, const float* __restrict__ Z2, float* __restrict__ Y) {
    const size_t i = (size_t)blockIdx.x * blockDim.x + threadIdx.x; if (i >= (size_t)SEQ * D) return;
    const int t = (int)(i / D), cidx = (int)(i % D);
    const int p = (t % GW) * GROWS + t / GW; const size_t o = (size_t)(CTX + p) * D + cidx;
    Y[i] = (Hf[o] + Hb[o]) * gelu_tanh(Z2[(size_t)(CTX + t) * 2 * D + cidx]);
}
__global__ void k_copy(const float* __restrict__ a, float* __restrict__ b, size_t n) { const size_t i = (size_t)blockIdx.x * blockDim.x + threadIdx.x; if (i < n) b[i] = a[i]; }


namespace mk {
#define LAS __attribute__((address_space(3)))
typedef unsigned short bf16_t;
typedef short bf16x8 __attribute__((ext_vector_type(8)));
typedef short s16x4 __attribute__((ext_vector_type(4)));
typedef float f32x4 __attribute__((ext_vector_type(4)));
typedef float f32x2 __attribute__((ext_vector_type(2)));
typedef unsigned u32x4 __attribute__((ext_vector_type(4)));
typedef unsigned u32x2 __attribute__((ext_vector_type(2)));

constexpr int NWAVES = 8, NTHR = 512;
constexpr int MT = 16896, ML = 16384, NTM = 66;
constexpr size_t MiB = 1u << 20;
constexpr size_t WS_CTL = 0;
constexpr size_t WS_MOD = 1 * MiB;
constexpr size_t WS_LB = WS_MOD + 160 * 1024;
constexpr size_t WS_CXLAT = 2 * MiB;
constexpr size_t WS_SIDE = 4 * MiB;
constexpr size_t WS_UEDGE = 10 * MiB + 512 * 1024;
constexpr size_t WS_W_HGIN = 14 * MiB, WS_W_HGOUT = 24 * MiB, WS_W_UP = 26 * MiB, WS_W_DN0 = 37 * MiB;
constexpr size_t WS_W_LRUIN = 43 * MiB, WS_W_GATES = 47 * MiB, WS_W_LRUOUT = 49 * MiB, WS_W_DN1 = 51 * MiB;
constexpr size_t WS_ACT = 57 * MiB, ACT_SLOT = 33 * MiB;
constexpr int CW_BAR = 4096;
constexpr int STAGE_BYTES = 131072;
constexpr int EPI_OFF = STAGE_BYTES;
constexpr int MISC_OFF = STAGE_BYTES + 12288;
constexpr int LDS_BYTES = 147456;

#define LDS_WAIT() asm volatile("s_waitcnt lgkmcnt(0)" ::: "memory")
#define VM_WAIT() asm volatile("s_waitcnt vmcnt(0)" ::: "memory")
__device__ __forceinline__ unsigned f2bf(float f) { unsigned u = __builtin_bit_cast(unsigned, f); return (u + 0x7fffu + ((u >> 16) & 1u)) >> 16; }
__device__ __forceinline__ unsigned pk2(float lo, float hi) { return f2bf(lo) | (f2bf(hi) << 16); }
__device__ __forceinline__ float bf2f(unsigned short h) { return __builtin_bit_cast(float, (unsigned)h << 16); }
__device__ __forceinline__ float bflo(unsigned w) { return __builtin_bit_cast(float, w << 16); }
__device__ __forceinline__ float bfhi(unsigned w) { return __builtin_bit_cast(float, w & 0xffff0000u); }
__device__ __forceinline__ float fsigmoid(float x) { return __builtin_amdgcn_rcpf(1.f + __expf(-x)); }
__device__ __forceinline__ float fsilu(float x) { return x * fsigmoid(x); }
__device__ __forceinline__ float fgelu_tanh(float x) { const float u = 0.7978845608028654f * (x + 0.044715f * x * x * x); const float e = __expf(2.f * u); return x * (1.f - __builtin_amdgcn_rcpf(e + 1.f)); }
__device__ __forceinline__ int lane_id_v() { int le; asm volatile("v_mbcnt_lo_u32_b32 %0, -1, 0\n\tv_mbcnt_hi_u32_b32 %0, -1, %0" : "=v"(le)); return le; }
__device__ __forceinline__ float wave_sum(float v) {
#pragma unroll
    for (int o = 1; o < 64; o <<= 1) v += __shfl_xor(v, o);
    return v;
}

#define XB_TMO      128
#define XB_XCNT(j)  (256  + 64 * (j))
#define XB_XSUB(j)  (1280 + 64 * (j))
#define XB_XGEN(j)  (2304 + 64 * (j))
#define XB_TOP      3328
#define XB_TOPGEN   3392
#define XCD_BAR_WORDS 3456
#define XB_SPIN_CAP (1u << 20)
__device__ __forceinline__ unsigned xb_ld(unsigned* p)              { return __hip_atomic_load(p, __ATOMIC_RELAXED, __HIP_MEMORY_SCOPE_AGENT); }
__device__ __forceinline__ unsigned xb_add(unsigned* p, unsigned v) { return __hip_atomic_fetch_add(p, v, __ATOMIC_RELAXED, __HIP_MEMORY_SCOPE_AGENT); }
__device__ __forceinline__ unsigned xb_xcc_id() { return (unsigned)__builtin_amdgcn_s_getreg((3 << 11) | 20) & 0xFu; }
#define XB_SPIN(cond, bar) do { unsigned _sp = 0; while (cond) { __builtin_amdgcn_s_sleep(1); \
    if ((++_sp & 255u) == 0u) { if (xb_ld(&(bar)[XB_TMO])) break; if (_sp > XB_SPIN_CAP) { atomicAdd(&(bar)[XB_TMO], 1u); break; } } } } while (0)
struct XcdBarrier { unsigned* bar; unsigned x; volatile LAS unsigned* st; };
__device__ __forceinline__ XcdBarrier xcd_barrier_post(unsigned* bar, volatile LAS unsigned* st) {
    XcdBarrier b; b.bar = bar; b.x = xb_xcc_id(); b.st = st;
    if (threadIdx.x == 0) (void)xb_add(&bar[XB_XCNT(b.x)], 1u);
    return b;
}
__device__ __forceinline__ void xcd_barrier_complete(unsigned* bar, unsigned x, unsigned& nloc, unsigned& nx) {
    const unsigned G = gridDim.x * gridDim.y * gridDim.z;
    unsigned sum, cnt, mine, sp = 0u;
    for (;;) {
        sum = 0u; cnt = 0u; mine = 0u;
#pragma unroll
        for (unsigned j = 0; j < 16; ++j) { const unsigned c = xb_ld(&bar[XB_XCNT(j)]); sum += c; cnt += (c > 0u) ? 1u : 0u; mine = (j == x) ? c : mine; }
        if (sum == G) break;
        __builtin_amdgcn_s_sleep(1);
        if ((++sp & 255u) == 0u) { if (xb_ld(&bar[XB_TMO])) break; if (sp > XB_SPIN_CAP) { atomicAdd(&bar[XB_TMO], 1u); break; } }
    }
    nloc = mine > 0u ? mine : 1u; nx = cnt > 0u ? cnt : 1u;
}
__device__ __forceinline__ void xcd_barrier(const XcdBarrier& b, int wave_s) {
    asm volatile("s_waitcnt vmcnt(0)" ::: "memory");
    __syncthreads();
    if (wave_s == 0 && lane_id_v() == 0) {
        unsigned* bar = b.bar;
        __builtin_amdgcn_s_waitcnt(0);
        unsigned nloc = b.st[0], nx = b.st[1];
        if (nloc == 0u) { xcd_barrier_complete(bar, b.x, nloc, nx); b.st[0] = nloc; b.st[1] = nx; }
        const unsigned old = xb_add(&bar[XB_XSUB(b.x)], 1u);
        const unsigned gen = old / nloc;
        if (old + 1u == (gen + 1u) * nloc) {
            __builtin_amdgcn_fence(__ATOMIC_RELEASE, "agent");
            asm volatile("s_waitcnt vmcnt(0)" ::: "memory");
            const unsigned og = xb_add(&bar[XB_TOP], 1u);
            const unsigned tg = og / nx;
            if (og + 1u == (tg + 1u) * nx) xb_add(&bar[XB_TOPGEN], 1u);
            else XB_SPIN(xb_ld(&bar[XB_TOPGEN]) == tg, bar);
            __builtin_amdgcn_fence(__ATOMIC_ACQUIRE, "agent");
            xb_add(&bar[XB_XGEN(b.x)], 1u);
            asm volatile("s_waitcnt vmcnt(0)" ::: "memory");
        } else {
            XB_SPIN(xb_ld(&bar[XB_XGEN(b.x)]) == gen, bar);
            __builtin_amdgcn_fence(__ATOMIC_ACQUIRE, "agent");
            asm volatile("s_waitcnt vmcnt(0)" ::: "memory");
        }
    }
    __syncthreads();
}

constexpr int BM = 256, BK = 64, HALF = 128, HTB = HALF * BK * 2, NXCD = 8, WGM = 8;
__host__ __device__ __forceinline__ int lds_byte(int r, int c) { const int st = (r >> 4) * 2 + (c >> 5), rr = r & 15, cc = c & 31, ob = rr * 64 + cc * 2; return st * 1024 + (ob ^ (((ob >> 9) & 1) << 5)); }
__host__ __device__ __forceinline__ void stage_rc(int b, int& R, int& C) { const int st = b / 1024, sb = b % 1024, swz = sb ^ (((sb >> 9) & 1) << 5); R = (st >> 1) * 16 + swz / 64; C = (st & 1) * 32 + (swz % 64) / 2; }
struct Unit { int pm, pn; };
struct Gemm { const bf16_t* A; const bf16_t* Bt; int lda, ldb, K; int acol_shift, acol_step; };
struct StaticOrder {
    int nM, nN, nwg, G, c;
    __device__ __forceinline__ void init(int nM_, int nN_, int G_, int c_) { nM = nM_; nN = nN_; nwg = nM * nN; G = G_; c = c_; }
    __device__ __forceinline__ bool next(int i, Unit& u) const {
        const long L = (long)i * G + c; if (L >= nwg) return false;
        int wgid = (int)L; { const int q = nwg / NXCD, r = nwg % NXCD, xcd = wgid % NXCD, off = wgid / NXCD; wgid = (xcd < r ? xcd * (q + 1) : r * (q + 1) + (xcd - r) * q) + off; }
        const int nig = WGM * nN, gid = wgid / nig, fm = gid * WGM, gsz = (nM - fm) < WGM ? (nM - fm) : WGM;
        u.pm = fm + ((wgid % nig) % gsz); u.pn = (wgid % nig) / gsz; return true;
    }
};
typedef __bf16 bf16x2_t __attribute__((ext_vector_type(2)));
__device__ __forceinline__ unsigned cvt_pk_bf16(float lo, float hi) { f32x2 v = {lo, hi}; bf16x2_t b = __builtin_convertvector(v, bf16x2_t); return __builtin_bit_cast(unsigned, b); }

template <class Epi>
__device__ __forceinline__ void gemm_phase(LAS unsigned char* lds, const Gemm g, const StaticOrder& S, const Epi& E, int wave_s) {
    const int wid = wave_s, lane = lane_id_v(), tid = wid * 64 + lane, wr = wid >> 2, wc = wid & 3, fr = lane & 15, fq = lane >> 4;
    const int K = g.K, nt = K / BK;
    unsigned voffA[2], voffB[2];
#pragma unroll
    for (int i = 0; i < 2; ++i) { int R, C; stage_rc(tid * 16 + i * 8192, R, C); voffA[i] = (unsigned)(R * g.lda + C) * 2u; voffB[i] = (unsigned)(R * g.ldb + C) * 2u; }
    const size_t kstep = (size_t)(BK * 2);
    const size_t hstepA = (size_t)HALF * g.lda * 2, hstepB = (size_t)HALF * g.ldb * 2;
    const size_t tstepA = 2 * hstepA, tstepB = 2 * hstepB;
    const unsigned ldsw = (unsigned)wid * 1024u;
    const int aoff = lds_byte(wr * 64 + fr, fq * 8), boff = lds_byte(wc * 32 + fr, fq * 8);
#define PG8_SA(b, h) (((b) * 2 + (h)) * HTB)
#define PG8_SB(b, h) ((4 + (b) * 2 + (h)) * HTB)
#define PG8_STAGE(bufoff, gbase, voff) do { _Pragma("unroll") for (int _i = 0; _i < 2; ++_i) \
        __builtin_amdgcn_global_load_lds((const unsigned*)((const char*)(gbase) + (voff)[_i]), (LAS unsigned*)(lds + (bufoff) + ldsw + _i * 8192), 16, 0, 0); } while (0)
#define PG8_LDA(dst, b, h) do { _Pragma("unroll") for (int m = 0; m < 4; ++m) _Pragma("unroll") for (int k = 0; k < 2; ++k) dst[m][k] = *(const LAS bf16x8*)(lds + PG8_SA(b, h) + aoff + m * 2048 + k * 1024); } while (0)
#define PG8_LDB(dst, b, h) do { _Pragma("unroll") for (int n = 0; n < 2; ++n) _Pragma("unroll") for (int k = 0; k < 2; ++k) dst[n][k] = *(const LAS bf16x8*)(lds + PG8_SB(b, h) + boff + n * 2048 + k * 1024); } while (0)
#define PG8_MMA(ai, bj, At, Bt) do { __builtin_amdgcn_s_setprio(1); _Pragma("unroll") for (int m = 0; m < 4; ++m) _Pragma("unroll") for (int n = 0; n < 2; ++n) _Pragma("unroll") for (int k = 0; k < 2; ++k) \
        acc[ai][bj][m][n] = __builtin_amdgcn_mfma_f32_16x16x32_bf16(Bt[n][k], At[m][k], acc[ai][bj][m][n], 0, 0, 0); __builtin_amdgcn_s_setprio(0); } while (0)
#define PG8_WAIT_V(n) asm volatile("s_waitcnt vmcnt(" #n ")" ::: "memory")
#define PG8_WAIT_L(n) asm volatile("s_waitcnt lgkmcnt(" #n ")" ::: "memory")
#define PG8_BAR __builtin_amdgcn_s_barrier()
#define PG8_SCHED __builtin_amdgcn_sched_barrier(0)
    Unit cur, nxt; int ui = 0;
    if (!S.next(0, cur)) return;
    f32x4 acc[2][2][4][2];
#pragma unroll
    for (int a = 0; a < 2; ++a)
#pragma unroll
        for (int b = 0; b < 2; ++b)
#pragma unroll
            for (int m = 0; m < 4; ++m)
#pragma unroll
                for (int n = 0; n < 2; ++n) acc[a][b][m][n] = (f32x4){0.f, 0.f, 0.f, 0.f};
    bf16x8 At[4][2], B0[2][2], B1[2][2];
    const char* cA = (const char*)g.A + (size_t)cur.pm * tstepA + (size_t)((cur.pn >> g.acol_shift) * g.acol_step) * 2; const char* cB = (const char*)g.Bt + (size_t)cur.pn * tstepB;
    {
        PG8_STAGE(PG8_SB(0, 0), cB, voffB); PG8_STAGE(PG8_SB(0, 1), cB + hstepB, voffB); PG8_STAGE(PG8_SA(0, 0), cA, voffA); PG8_STAGE(PG8_SA(0, 1), cA + hstepA, voffA);
        if (wr == 1) PG8_BAR;
        PG8_WAIT_V(2); PG8_BAR;
        PG8_STAGE(PG8_SB(1, 0), cB + kstep, voffB); PG8_STAGE(PG8_SA(1, 0), cA + kstep, voffA); PG8_STAGE(PG8_SB(1, 1), cB + hstepB + kstep, voffB);
        PG8_WAIT_V(6); PG8_BAR;
    }
    for (;;) {
        const bool has_next = S.next(ui + 1, nxt);
        const char* nA = has_next ? (const char*)g.A + (size_t)nxt.pm * tstepA + (size_t)((nxt.pn >> g.acol_shift) * g.acol_step) * 2 : cA; const char* nB = has_next ? (const char*)g.Bt + (size_t)nxt.pn * tstepB : cB;
#pragma unroll 1
        for (int t = 0; t < nt; t += 2) {
            const bool last = (t == nt - 2);
            const char* a1 = cA + (size_t)(t + 1) * kstep;
            const char* a2 = last ? nA : cA + (size_t)(t + 2) * kstep; const char* b2 = last ? nB : cB + (size_t)(t + 2) * kstep;
            const char* a3 = a2 + kstep; const char* b3 = b2 + kstep;
            PG8_LDB(B0, 0, 0); PG8_LDB(B1, 0, 1); PG8_SCHED; PG8_LDA(At, 0, 0); PG8_STAGE(PG8_SA(1, 1), a1 + hstepA, voffA);
            PG8_WAIT_V(8); PG8_WAIT_L(0); PG8_BAR; PG8_MMA(0, 0, At, B0); PG8_MMA(0, 1, At, B1); PG8_BAR; PG8_SCHED;
            PG8_LDA(At, 0, 1); PG8_STAGE(PG8_SB(0, 0), b2, voffB); PG8_STAGE(PG8_SB(0, 1), b2 + hstepB, voffB); PG8_STAGE(PG8_SA(0, 0), a2, voffA);
            PG8_WAIT_V(8); PG8_WAIT_L(0); PG8_BAR; PG8_MMA(1, 0, At, B0); PG8_MMA(1, 1, At, B1); PG8_BAR; PG8_SCHED;
            PG8_LDB(B0, 1, 0); PG8_LDB(B1, 1, 1); PG8_SCHED; PG8_LDA(At, 1, 0); PG8_STAGE(PG8_SA(0, 1), a2 + hstepA, voffA);
            PG8_WAIT_V(8); PG8_WAIT_L(0); PG8_BAR; PG8_MMA(0, 0, At, B0); PG8_MMA(0, 1, At, B1); PG8_BAR; PG8_SCHED;
            PG8_LDA(At, 1, 1); PG8_STAGE(PG8_SB(1, 0), b3, voffB); PG8_STAGE(PG8_SB(1, 1), b3 + hstepB, voffB); PG8_STAGE(PG8_SA(1, 0), a3, voffA);
            PG8_WAIT_V(8); PG8_WAIT_L(0); PG8_BAR; PG8_MMA(1, 0, At, B0); PG8_MMA(1, 1, At, B1); PG8_BAR; PG8_SCHED;
        }
        if (wr == 0) PG8_BAR;
        { const int le = lane_id_v();
          E(acc, cur, wr, wc, le & 15, le >> 4, lds + EPI_OFF, wid, le); }
        if (!has_next) break;
#pragma unroll
        for (int a = 0; a < 2; ++a)
#pragma unroll
            for (int b = 0; b < 2; ++b)
#pragma unroll
                for (int m = 0; m < 4; ++m)
#pragma unroll
                    for (int n = 0; n < 2; ++n) acc[a][b][m][n] = (f32x4){0.f, 0.f, 0.f, 0.f};
        cur = nxt; cA = nA; cB = nB; ++ui;
        if (wr == 1) PG8_BAR;
    }
    PG8_WAIT_V(0);
    PG8_BAR;
#undef PG8_SA
#undef PG8_SB
#undef PG8_STAGE
#undef PG8_LDA
#undef PG8_LDB
#undef PG8_MMA
#undef PG8_WAIT_V
#undef PG8_WAIT_L
#undef PG8_SCHED
}
#define MK_BAR __builtin_amdgcn_s_barrier()

__device__ __forceinline__ int mod_variant(int pm) { return pm < 32 ? 0 : (pm < 64 ? 1 : 2); }

struct EpiResid {
    const float* baseL; const float* baseC; float* outL; float* outC; const float* mod; int gate_off;
    __device__ __forceinline__ void operator()(const f32x4 (&acc)[2][2][4][2], const Unit& u, int wr, int wc, int fr, int fq, LAS unsigned char*, int, int) const {
        const int v = mod_variant(u.pm);
        const float* gate = mod + v * 6144 + gate_off;
        const float* base = u.pm < 64 ? baseL + (size_t)u.pm * 256 * 1024 : baseC + (size_t)(u.pm - 64) * 256 * 1024;
        float* out = u.pm < 64 ? outL + (size_t)u.pm * 256 * 1024 : outC + (size_t)(u.pm - 64) * 256 * 1024;
        const int col0 = u.pn * BM + wc * 32 + 4 * fq;
        f32x4 gv[2][2];
#pragma unroll
        for (int bj = 0; bj < 2; ++bj)
#pragma unroll
            for (int n = 0; n < 2; ++n) gv[bj][n] = *(const f32x4*)(gate + col0 + bj * HALF + n * 16);
#pragma unroll
        for (int ai = 0; ai < 2; ++ai)
#pragma unroll
            for (int m = 0; m < 4; ++m) { const size_t off = (size_t)(ai * HALF + wr * 64 + m * 16 + fr) * 1024 + col0;
#pragma unroll
                for (int bj = 0; bj < 2; ++bj)
#pragma unroll
                    for (int n = 0; n < 2; ++n) { const f32x4 bs = *(const f32x4*)(base + off + bj * HALF + n * 16); *(f32x4*)(out + off + bj * HALF + n * 16) = bs + gv[bj][n] * acc[ai][bj][m][n]; } }
    }
};

struct EpiHgIn {
    bf16_t *QmF, *KmF, *QmB, *KmB, *V, *SG; float* side; const float* lb;
    __device__ __forceinline__ void operator()(const f32x4 (&acc)[2][2][4][2], const Unit& u, int wr, int wc, int fr, int fq, LAS unsigned char*, int, int) const {
        const int row0 = u.pm * BM + wr * 64 + fr;
        if (u.pn >= 16) {
            const int col0 = (u.pn - 16) * BM + wc * 32 + 8 * fq;
#pragma unroll
            for (int ai = 0; ai < 2; ++ai)
#pragma unroll
                for (int m = 0; m < 4; ++m) { char* rowp = (char*)SG + (unsigned)(((row0 + ai * HALF + m * 16) * 1024 + col0) * 2);
#pragma unroll
                    for (int bj = 0; bj < 2; ++bj) { f32x4 v0 = acc[ai][bj][m][0], v1 = acc[ai][bj][m][1]; asm volatile("" : "+v"(v0), "+v"(v1)); u32x4 w;
                        w.x = cvt_pk_bf16(fsilu(v0[0]), fsilu(v0[1])); w.y = cvt_pk_bf16(fsilu(v0[2]), fsilu(v0[3])); w.z = cvt_pk_bf16(fsilu(v1[0]), fsilu(v1[1])); w.w = cvt_pk_bf16(fsilu(v1[2]), fsilu(v1[3]));
                        *(u32x4*)(rowp + bj * HALF * 2) = w; }
                    asm volatile("" ::: "memory"); }
            return;
        }
        const int c0 = 64 * u.pn + 16 * wc + 4 * fq;
        const f32x4 lbf = *(const f32x4*)(lb + c0), lbb = *(const f32x4*)(lb + 1024 + c0);
#pragma unroll
        for (int ai = 0; ai < 2; ++ai) {
            const int ck = u.pm * 4 + ai * 2 + wr;
#pragma unroll
            for (int m = 0; m < 4; ++m) { const f32x4 vv = acc[ai][1][m][1]; u32x2 w; w.x = cvt_pk_bf16(vv[0], vv[1]); w.y = cvt_pk_bf16(vv[2], vv[3]);
                *(u32x2*)((char*)V + (unsigned)(((row0 + ai * HALF + m * 16) * 1024 + c0) * 2)) = w; }
#pragma unroll
            for (int d = 0; d < 2; ++d) {
                const f32x4 lbv = d ? lbb : lbf;
                float db[4][4];
                float* sp = (float*)((char*)side + (unsigned)((((ck * 2 + d) * 3) * 1024 + c0) * 4));
#pragma unroll
                for (int j = 0; j < 4; ++j) {
                    float lf[4], bs[4];
#pragma unroll
                    for (int m = 0; m < 4; ++m) { const float z = d ? acc[ai][1][m][0][j] : acc[ai][0][m][1][j]; lf[m] = __logf(lbv[j] + (1.f - lbv[j]) * fsigmoid(z)); }
                    float carry = 0.f;
#pragma unroll
                    for (int m = 0; m < 4; ++m) { float x = lf[m];
#pragma unroll
                        for (int o = 1; o < 16; o <<= 1) { const float y = __shfl_up(x, o, 16); if (fr >= o) x += y; }
                        x += carry; bs[m] = x; carry = __shfl(x, 15, 16); }
                    const float tot = carry; float bmid;
                    if (d == 0) bmid = __shfl(bs[2], 0, 16);
                    else {
#pragma unroll
                        for (int m = 0; m < 4; ++m) bs[m] = tot - bs[m] + lf[m];
                        bmid = __shfl(bs[1], 15, 16); }
#pragma unroll
                    for (int m = 0; m < 4; ++m) db[m][j] = bs[m] - bmid;
                    if (fr == 0) { sp[j] = __expf(bmid); sp[1024 + j] = __expf(tot - bmid); sp[2048 + j] = __expf(tot); }
                }
                bf16_t* Qd = d ? QmB : QmF; bf16_t* Kd = d ? KmB : KmF;
#pragma unroll
                for (int m = 0; m < 4; ++m) { const f32x4 qz = acc[ai][0][m][0]; const f32x4 z = d ? acc[ai][1][m][0] : acc[ai][0][m][1]; float qo[4], ko[4];
#pragma unroll
                    for (int j = 0; j < 4; ++j) { const float kv = (1.f - lbv[j]) * (1.f - fsigmoid(z[j])); qo[j] = fsilu(qz[j]) * __expf(db[m][j]); ko[j] = kv * __expf(-db[m][j]); }
                    const unsigned off = (unsigned)(((row0 + ai * HALF + m * 16) * 1024 + c0) * 2);
                    u32x2 w; w.x = cvt_pk_bf16(qo[0], qo[1]); w.y = cvt_pk_bf16(qo[2], qo[3]); *(u32x2*)((char*)Qd + off) = w;
                    w.x = cvt_pk_bf16(ko[0], ko[1]); w.y = cvt_pk_bf16(ko[2], ko[3]); *(u32x2*)((char*)Kd + off) = w;
                    asm volatile("" ::: "memory"); }
            }
        }
    }
};


__device__ __forceinline__ float dpp_f(float oldv, float src, const int ctrl_sel) {
    const int o = __builtin_bit_cast(int, oldv), x = __builtin_bit_cast(int, src); int r;
    if (ctrl_sel == 0) r = __builtin_amdgcn_update_dpp(o, x, 0x111, 0xF, 0xF, false);
    else if (ctrl_sel == 1) r = __builtin_amdgcn_update_dpp(o, x, 0x101, 0xF, 0xF, false);
    else if (ctrl_sel == 2) r = __builtin_amdgcn_update_dpp(o, x, 0x121, 0xF, 0xF, false);
    else r = __builtin_amdgcn_update_dpp(o, x, 0x12F, 0xF, 0xF, false);
    return __builtin_bit_cast(float, r);
}
struct EpiUpConv {
    bf16_t* G; bf16_t* uedge; const float* cw; const float* cb;
    __device__ __forceinline__ void operator()(const f32x4 (&acc)[2][2][4][2], const Unit& u, int wr, int wc, int fr, int fq, LAS unsigned char* epi, int, int) const {
        LAS float* EX = (LAS float*)epi;
        const int colb = 32 * wc + 4 * fq;
        const int ch0 = 128 * u.pn + 32 * wc + 8 * fq;
#pragma unroll
        for (int ai = 0; ai < 2; ++ai) { const int g = 2 * ai + wr;
#pragma unroll
            for (int bj = 0; bj < 2; ++bj)
#pragma unroll
                for (int n = 0; n < 2; ++n) {
                    if (fr == 0) *(LAS f32x4*)(EX + (g * 2 + 0) * 256 + 128 * bj + 16 * n + colb) = acc[ai][bj][0][n];
                    if (fr == 15) *(LAS f32x4*)(EX + (g * 2 + 1) * 256 + 128 * bj + 16 * n + colb) = acc[ai][bj][3][n];
                } }
        {
            const bool lo = (wr == 0) && (fr < 2), hi = (wr == 1) && (fr >= 14);
            if (lo || hi) { const int slot = lo ? fr : (fr - 12); bf16_t* ue = uedge + ((size_t)u.pm * 4 + slot) * 5632 + ch0;
#pragma unroll
                for (int bj = 0; bj < 2; ++bj)
#pragma unroll
                    for (int n = 0; n < 2; ++n) { const f32x4 x = lo ? acc[0][bj][0][n] : acc[1][bj][3][n]; u32x2 w; w.x = cvt_pk_bf16(x[0], x[1]); w.y = cvt_pk_bf16(x[2], x[3]); *(u32x2*)(ue + bj * 2816 + 4 * n) = w; } }
        }
        LDS_WAIT(); MK_BAR; asm volatile("" ::: "memory");
#pragma unroll
        for (int n = 0; n < 2; ++n) {
            f32x4 wg[4], wv[4];
#pragma unroll
            for (int k = 0; k < 3; ++k) { wg[k] = *(const f32x4*)(cw + k * 5632 + ch0 + 4 * n); wv[k] = *(const f32x4*)(cw + k * 5632 + 2816 + ch0 + 4 * n); }
            wg[3] = *(const f32x4*)(cb + ch0 + 4 * n); wv[3] = *(const f32x4*)(cb + 2816 + ch0 + 4 * n);
#pragma unroll
            for (int ai = 0; ai < 2; ++ai) { const int g = 2 * ai + wr;
                f32x4 pe[2], ne[2];
#pragma unroll
                for (int bj = 0; bj < 2; ++bj) {
                    pe[bj] = (g > 0) ? *(const LAS f32x4*)(EX + ((g - 1) * 2 + 1) * 256 + 128 * bj + 16 * n + colb) : (f32x4){0.f, 0.f, 0.f, 0.f};
                    ne[bj] = (g < 3) ? *(const LAS f32x4*)(EX + ((g + 1) * 2 + 0) * 256 + 128 * bj + 16 * n + colb) : (f32x4){0.f, 0.f, 0.f, 0.f}; }
#pragma unroll
                for (int m = 0; m < 4; ++m) {
                    f32x4 cv2[2];
#pragma unroll
                    for (int bj = 0; bj < 2; ++bj) { const f32x4 x = acc[ai][bj][m][n]; const f32x4* wt = bj ? wv : wg; f32x4 c;
#pragma unroll
                        for (int j = 0; j < 4; ++j) {
                            const float pold = (m > 0) ? dpp_f(0.f, acc[ai][bj][m > 0 ? m - 1 : 0][n][j], 2) : pe[bj][j];
                            const float nold = (m < 3) ? dpp_f(0.f, acc[ai][bj][m < 3 ? m + 1 : 3][n][j], 3) : ne[bj][j];
                            const float pv = dpp_f(pold, x[j], 0), nv = dpp_f(nold, x[j], 1);
                            c[j] = wt[3][j] + wt[0][j] * pv + wt[1][j] * x[j] + wt[2][j] * nv; }
                        cv2[bj] = c; }
                    u32x2 w; w.x = cvt_pk_bf16(fsilu(cv2[0][0]) * cv2[1][0], fsilu(cv2[0][1]) * cv2[1][1]); w.y = cvt_pk_bf16(fsilu(cv2[0][2]) * cv2[1][2], fsilu(cv2[0][3]) * cv2[1][3]);
                    *(u32x2*)((char*)G + (unsigned)(((u.pm * 256 + ai * HALF + wr * 64 + m * 16 + fr) * 2816 + ch0 + 4 * n) * 2)) = w;
                    asm volatile("" ::: "memory");
                }
            }
        }
        LDS_WAIT(); MK_BAR; asm volatile("" ::: "memory");
    }
};
__device__ __forceinline__ void ffn_fix_edges(int tid, int pm, bf16_t* G, const bf16_t* uedge, const float* cw, const float* cb) {
    const bool sstart = (pm == 0) || (pm == 32) || (pm >= 64), send = (pm == 31) || (pm == 63) || (pm >= 64);
    for (int idx = tid; idx < 2 * 2816; idx += NTHR) {
        const int which = idx >= 2816, ch = idx - which * 2816;
        const bf16_t* UE = uedge + (size_t)pm * 4 * 5632;
        float cg = 0.f, cvv = 0.f;
#pragma unroll
        for (int half = 0; half < 2; ++half) { const int col = half * 2816 + ch; float pv, cu, nv;
            if (which == 0) { pv = sstart ? 0.f : bf2f(uedge[((size_t)(pm - 1) * 4 + 3) * 5632 + col]); cu = bf2f(UE[col]); nv = bf2f(UE[5632 + col]); }
            else { pv = bf2f(UE[2 * 5632 + col]); cu = bf2f(UE[3 * 5632 + col]); nv = send ? 0.f : bf2f(uedge[((size_t)(pm + 1) * 4) * 5632 + col]); }
            const float c = cb[col] + cw[col] * pv + cw[5632 + col] * cu + cw[2 * 5632 + col] * nv;
            if (half == 0) cg = c; else cvv = c; }
        G[(size_t)(pm * 256 + (which ? 255 : 0)) * 2816 + ch] = (bf16_t)f2bf(fsilu(cg) * cvv);
    }
}

constexpr int SC_QS = 272, SC_KS = 288;
constexpr int SC_QOFF = 0, SC_KOFF = 64 * SC_QS, SC_VOFF = SC_KOFF + 64 * SC_KS, SC_BUF = SC_VOFF + 64 * SC_KS;
constexpr int SC_POFF = 2 * SC_BUF, SC_PS = 144, SC_SIDE = SC_POFF + 64 * SC_PS;
__device__ __forceinline__ s16x4 ds_tr(const LAS unsigned char* p) { typedef short v4i16_t __attribute__((ext_vector_type(4))); return __builtin_bit_cast(s16x4, __builtin_amdgcn_ds_read_tr16_b64_v4i16((LAS v4i16_t*)p)); }
__device__ __forceinline__ bf16x8 cat8(s16x4 a, s16x4 b) { return (bf16x8){a[0], a[1], a[2], a[3], b[0], b[1], b[2], b[3]}; }

template <bool OUTPUT>
__device__ __forceinline__ void hgrn_segment(LAS unsigned char* lds, bf16_t* Qd, const bf16_t* Kd, const bf16_t* Vt, const float* side, float* sseg, float* dseg,
                                             int chain, int seg, int wave_s) {
    const int b = chain >> 4, h = (chain >> 1) & 7, d = chain & 1;
    const int w = wave_s, lane = lane_id_v(), tid = w * 64 + lane, l15 = lane & 15, G = lane >> 4;
    const int s_begin = seg == 0 ? 0 : 4 + 16 * seg, s_end = 20 + 16 * seg;
#define SC_CHUNK_ROW(s_) (((s_) < 4) ? (ML + b * 256 + 64 * (d ? (3 - (s_)) : (s_))) : (b * 8192 + 64 * (d ? (127 - ((s_) - 4)) : ((s_) - 4))))
    u32x4 sq0, sq1, sk0, sk1, sv0, sv1; f32x4 ssd = (f32x4){0.f, 0.f, 0.f, 0.f};
    const int st_r0 = tid >> 4, st_c = tid & 15, st_r1 = st_r0 + 32;
#define SC_STAGE_LOAD(s_) do { const int rb_ = SC_CHUNK_ROW(s_); \
        const size_t g0_ = (size_t)(rb_ + st_r0) * 1024 + h * 128 + st_c * 8, g1_ = (size_t)(rb_ + st_r1) * 1024 + h * 128 + st_c * 8; \
        if (OUTPUT) { sq0 = *(const u32x4*)(Qd + g0_); sq1 = *(const u32x4*)(Qd + g1_); } \
        sk0 = *(const u32x4*)(Kd + g0_); sv0 = *(const u32x4*)(Vt + g0_); sk1 = *(const u32x4*)(Kd + g1_); sv1 = *(const u32x4*)(Vt + g1_); \
        if (tid < 96) { const int ck_ = rb_ >> 6; ssd = *(const f32x4*)(side + ((size_t)(ck_ * 2 + d) * 3 + (tid >> 5)) * 1024 + h * 128 + (tid & 31) * 4); } } while (0)
#define SC_STAGE_STORE(buf_) do { LAS unsigned char* B_ = lds + (buf_) * SC_BUF; \
        if (OUTPUT) { *(LAS u32x4*)(B_ + SC_QOFF + st_r0 * SC_QS + st_c * 16) = sq0; *(LAS u32x4*)(B_ + SC_QOFF + st_r1 * SC_QS + st_c * 16) = sq1; } \
        *(LAS u32x4*)(B_ + SC_KOFF + st_r0 * SC_KS + st_c * 16) = sk0; *(LAS u32x4*)(B_ + SC_VOFF + st_r0 * SC_KS + st_c * 16) = sv0; \
        *(LAS u32x4*)(B_ + SC_KOFF + st_r1 * SC_KS + st_c * 16) = sk1; *(LAS u32x4*)(B_ + SC_VOFF + st_r1 * SC_KS + st_c * 16) = sv1; \
        if (tid < 96) *(LAS f32x4*)(lds + SC_SIDE + (buf_) * 1536 + tid * 16) = ssd; } while (0)
    SC_STAGE_LOAD(s_begin);
    f32x4 S[8], Dp[8];
#pragma unroll
    for (int i = 0; i < 8; ++i) { S[i] = (f32x4){0.f, 0.f, 0.f, 0.f}; Dp[i] = (f32x4){1.f, 1.f, 1.f, 1.f}; }
    if (OUTPUT) {
        for (int j = 0; j < seg; ++j) { const float* sp = sseg + ((size_t)(chain * 8 + j) * 64 + w * 8) * 256 + lane * 4; const float* dp = dseg + (size_t)(chain * 8 + j) * 128 + 4 * G;
#pragma unroll
            for (int i = 0; i < 8; ++i) { const f32x4 sv = *(const f32x4*)(sp + i * 256), dv = *(const f32x4*)(dp + 16 * i); S[i] = dv * S[i] + sv; } }
    }
    SC_STAGE_STORE(0);
    LDS_WAIT(); __syncthreads();
    const int ti = w >> 1, tj0 = (w & 1) * 2;
    for (int s = s_begin; s < s_end; ++s) {
        const int cur = (s - s_begin) & 1;
        const LAS unsigned char* Bq = lds + cur * SC_BUF + SC_QOFF; const LAS unsigned char* Bk = lds + cur * SC_BUF + SC_KOFF; const LAS unsigned char* Bv = lds + cur * SC_BUF + SC_VOFF;
        const LAS float* sd = (const LAS float*)(lds + SC_SIDE + cur * 1536);
        if (s + 1 < s_end) SC_STAGE_LOAD(s + 1);
        bf16x8 Sp[4];
        if (OUTPUT) {
            f32x4 p0 = (f32x4){0.f, 0.f, 0.f, 0.f}, p1 = p0;
#pragma unroll
            for (int ks = 0; ks < 4; ++ks) {
                const bf16x8 bq = *(const LAS bf16x8*)(Bq + (16 * ti + l15) * SC_QS + (32 * ks + 8 * G) * 2);
                const bf16x8 a0 = *(const LAS bf16x8*)(Bk + (16 * tj0 + l15) * SC_KS + (32 * ks + 8 * G) * 2);
                const bf16x8 a1 = *(const LAS bf16x8*)(Bk + (16 * (tj0 + 1) + l15) * SC_KS + (32 * ks + 8 * G) * 2);
                p0 = __builtin_amdgcn_mfma_f32_16x16x32_bf16(a0, bq, p0, 0, 0, 0);
                p1 = __builtin_amdgcn_mfma_f32_16x16x32_bf16(a1, bq, p1, 0, 0, 0);
            }
            const int i = 16 * ti + l15;
#pragma unroll
            for (int r = 0; r < 4; ++r) { const int j0 = 16 * tj0 + 4 * G + r, j1 = j0 + 16;
                if (d == 0) { if (j0 > i) p0[r] = 0.f; if (j1 > i) p1[r] = 0.f; } else { if (j0 < i) p0[r] = 0.f; if (j1 < i) p1[r] = 0.f; } }
            u32x2 w0, w1; w0.x = cvt_pk_bf16(p0[0], p0[1]); w0.y = cvt_pk_bf16(p0[2], p0[3]); w1.x = cvt_pk_bf16(p1[0], p1[1]); w1.y = cvt_pk_bf16(p1[2], p1[3]);
            *(LAS u32x2*)(lds + SC_POFF + i * SC_PS + (16 * tj0 + 4 * G) * 2) = w0;
            *(LAS u32x2*)(lds + SC_POFF + i * SC_PS + (16 * (tj0 + 1) + 4 * G) * 2) = w1;
#pragma unroll
            for (int s4 = 0; s4 < 4; ++s4) {
                const f32x4 e0 = *(const LAS f32x4*)(sd + 16 * (2 * s4) + 4 * G), e1 = *(const LAS f32x4*)(sd + 16 * (2 * s4 + 1) + 4 * G);
                const f32x4 x0 = S[2 * s4] * e0, x1 = S[2 * s4 + 1] * e1;
                u32x4 t; t.x = cvt_pk_bf16(x0[0], x0[1]); t.y = cvt_pk_bf16(x0[2], x0[3]); t.z = cvt_pk_bf16(x1[0], x1[1]); t.w = cvt_pk_bf16(x1[2], x1[3]);
                Sp[s4] = __builtin_bit_cast(bf16x8, t);
            }
            LDS_WAIT(); __syncthreads();
        }
        bf16x8 vf[2];
        {
            const int q = l15 >> 2, p = l15 & 3;
#pragma unroll
            for (int ks = 0; ks < 2; ++ks) {
                const s16x4 lo = ds_tr(Bv + (32 * ks + 4 * G + q) * SC_KS + (16 * w + 4 * p) * 2);
                const s16x4 hi = ds_tr(Bv + (32 * ks + 16 + 4 * G + q) * SC_KS + (16 * w + 4 * p) * 2);
                vf[ks] = cat8(lo, hi);
            }
        }
        if (OUTPUT) {
            const int rb = SC_CHUNK_ROW(s);
#pragma unroll
            for (int it = 0; it < 4; ++it) {
                f32x4 o = (f32x4){0.f, 0.f, 0.f, 0.f};
                const int tok = 16 * it + l15;
#pragma unroll
                for (int ks = 0; ks < 2; ++ks) {
                    const s16x4 lo = *(const LAS s16x4*)(lds + SC_POFF + tok * SC_PS + (32 * ks + 4 * G) * 2);
                    const s16x4 hi = *(const LAS s16x4*)(lds + SC_POFF + tok * SC_PS + (32 * ks + 16 + 4 * G) * 2);
                    o = __builtin_amdgcn_mfma_f32_16x16x32_bf16(vf[ks], cat8(lo, hi), o, 0, 0, 0);
                }
#pragma unroll
                for (int s4 = 0; s4 < 4; ++s4) {
                    const s16x4 lo = *(const LAS s16x4*)(Bq + tok * SC_QS + (32 * s4 + 4 * G) * 2);
                    const s16x4 hi = *(const LAS s16x4*)(Bq + tok * SC_QS + (32 * s4 + 16 + 4 * G) * 2);
                    o = __builtin_amdgcn_mfma_f32_16x16x32_bf16(Sp[s4], cat8(lo, hi), o, 0, 0, 0);
                }
                u32x2 wv; wv.x = cvt_pk_bf16(o[0], o[1]); wv.y = cvt_pk_bf16(o[2], o[3]);
                *(u32x2*)(Qd + (size_t)(rb + tok) * 1024 + h * 128 + 16 * w + 4 * G) = wv;
            }
        }
        if (OUTPUT ? (s + 1 < s_end || seg < 7) : true) {
            const int q = l15 >> 2, p = l15 & 3;
#pragma unroll
            for (int i = 0; i < 8; ++i) {
                f32x4 U = (f32x4){0.f, 0.f, 0.f, 0.f};
#pragma unroll
                for (int ks = 0; ks < 2; ++ks) {
                    const s16x4 lo = ds_tr(Bk + (32 * ks + 4 * G + q) * SC_KS + (16 * i + 4 * p) * 2);
                    const s16x4 hi = ds_tr(Bk + (32 * ks + 16 + 4 * G + q) * SC_KS + (16 * i + 4 * p) * 2);
                    U = __builtin_amdgcn_mfma_f32_16x16x32_bf16(cat8(lo, hi), vf[ks], U, 0, 0, 0);
                }
                const f32x4 e2 = *(const LAS f32x4*)(sd + 128 + 16 * i + 4 * G), de = *(const LAS f32x4*)(sd + 256 + 16 * i + 4 * G);
                S[i] = de * S[i] + e2 * U;
                if (!OUTPUT) Dp[i] = Dp[i] * de;
            }
        }
        if (s + 1 < s_end) SC_STAGE_STORE(cur ^ 1);
        LDS_WAIT(); __syncthreads();
    }
    if (!OUTPUT) {
        float* sp = sseg + ((size_t)(chain * 8 + seg) * 64 + w * 8) * 256 + lane * 4;
#pragma unroll
        for (int i = 0; i < 8; ++i) *(f32x4*)(sp + i * 256) = S[i];
        if (w == 0 && l15 == 0) { float* dp = dseg + (size_t)(chain * 8 + seg) * 128 + 4 * G;
#pragma unroll
            for (int i = 0; i < 8; ++i) *(f32x4*)(dp + 16 * i) = Dp[i]; }
    }
#undef SC_CHUNK_ROW
#undef SC_STAGE_LOAD
#undef SC_STAGE_STORE
}

struct Frame {
    LAS unsigned char* lds; int wave, G, gw, NGW;
};
enum ConvKind { CV_NAT = 0, CV_PERM8 = 1, CV_HG = 2, CV_UP = 3, CV_GATES = 4 };
struct ConvJob { int kind; const float* W; const float* W2; int K, N, ld; bf16_t* dst; };
__device__ __forceinline__ const float* conv_colptr(const ConvJob& j, int rho) {
    const int pn = rho >> 8, t = rho & 255, bj = t >> 7, wc = (t >> 5) & 3, n = (t >> 4) & 1, fq = (t >> 2) & 3, jj = t & 3;
    switch (j.kind) {
        case CV_NAT: return j.W + rho;
        case CV_PERM8: return j.W + (pn * 256 + bj * 128 + wc * 32 + fq * 8 + n * 4 + jj);
        case CV_HG: if (pn >= 16) return j.W + (pn * 256 + bj * 128 + wc * 32 + fq * 8 + n * 4 + jj);
                    return j.W + ((2 * bj + n) * 1024 + 64 * pn + 16 * wc + 4 * fq + jj);
        case CV_UP: return j.W + (bj * 2816 + 128 * pn + 32 * wc + 8 * fq + 4 * n + jj);
        default: {
            const int blk = pn >> 2, q = pn & 3, grp = 2 * bj + n, dd = grp >> 1, ax = grp & 1; const int jc = 64 * q + 16 * wc + 4 * fq + jj;
            return (ax ? j.W2 : j.W) + (size_t)(dd * 4 + blk) * 65536 + jc; }
    }
}
__device__ __forceinline__ void conv_item(const ConvJob& j, LAS float* scr, int item, int lane) {
    const int nblk = j.N / 32, kb = item / nblk, nb = item % nblk, k0 = 64 * kb, n0 = 32 * nb;
    const float* cp = conv_colptr(j, n0 + (lane & 31));
#pragma unroll 8
    for (int i = 0; i < 32; ++i) { const int kk = 2 * i + (lane >> 5); scr[kk * 33 + (lane & 31)] = cp[(size_t)(k0 + kk) * j.ld]; }
    LDS_WAIT(); asm volatile("" ::: "memory");
    const int c = lane & 7;
#pragma unroll
    for (int jx = 0; jx < 4; ++jx) { const int n = (lane >> 3) + 8 * jx; const LAS float* s = scr + (8 * c) * 33 + n;
        u32x4 o; o.x = pk2(s[0 * 33], s[1 * 33]); o.y = pk2(s[2 * 33], s[3 * 33]); o.z = pk2(s[4 * 33], s[5 * 33]); o.w = pk2(s[6 * 33], s[7 * 33]);
        *(u32x4*)(j.dst + (size_t)(n0 + n) * j.K + k0 + 8 * c) = o; }
    LDS_WAIT(); asm volatile("" ::: "memory");
}
__device__ __forceinline__ void conv_job(const Frame& F, const ConvJob& j, int gw, int ngw) {
    LAS float* scr = (LAS float*)(F.lds + F.wave * 8448);
    const int nitems = (j.K / 64) * (j.N / 32);
    const int lane = lane_id_v();
    for (int it = gw; it < nitems; it += ngw) conv_item(j, scr, it, lane);
}

__device__ __forceinline__ void adaln_phase(const Frame& F, const float* c, const float* cctx, const float* w_ada, const float* b_ada, float* mod) {
    const int tid = F.wave * 64 + lane_id_v();
    LAS float* sc = (LAS float*)(F.lds + 70000);
    LAS float* red = sc + 3 * 1024;
    for (int item = blockIdx.x; item < 192; item += F.G) {
        const int l = item / 96, j0 = (item % 96) * 64;
        for (int i = tid; i < 1024; i += NTHR) { sc[i] = fsilu(c[i]); sc[1024 + i] = fsilu(c[1024 + i]); sc[2048 + i] = fsilu(cctx[i]); }
        __syncthreads();
        const int kp = tid >> 6, jj = tid & 63;
        const float* W = w_ada + (size_t)l * 1024 * 6144 + j0 + jj;
        float a0 = 0.f, a1 = 0.f, a2 = 0.f;
#pragma unroll 8
        for (int k = kp * 128; k < kp * 128 + 128; ++k) { const float wv = W[(size_t)k * 6144]; a0 += sc[k] * wv; a1 += sc[1024 + k] * wv; a2 += sc[2048 + k] * wv; }
        red[(kp * 3 + 0) * 64 + jj] = a0; red[(kp * 3 + 1) * 64 + jj] = a1; red[(kp * 3 + 2) * 64 + jj] = a2;
        __syncthreads();
        if (tid < 192) { const int v = tid >> 6, j2 = tid & 63; float s = 0.f;
#pragma unroll
            for (int p = 0; p < 8; ++p) s += red[(p * 3 + v) * 64 + j2];
            mod[(size_t)(l * 3 + v) * 6144 + j0 + j2] = s + b_ada[(size_t)l * 6144 + j0 + j2]; }
        __syncthreads();
    }
}

__device__ __forceinline__ void norm_phase(const Frame& F, const float* latL, const float* latC, const float* g, const float* mod, int sh_off, int sc_off, bf16_t* H, int nrows) {
    const int lane = lane_id_v();
    for (int row = F.gw; row < nrows; row += F.NGW) {
        const int v = row < 8192 ? 0 : (row < ML ? 1 : 2);
        const float* x = row < ML ? latL + (size_t)row * 1024 : latC + (size_t)(row - ML) * 1024;
        const float* sh = mod + v * 6144 + sh_off; const float* sc = mod + v * 6144 + sc_off;
        f32x4 xv[4]; float ss = 0.f;
#pragma unroll
        for (int j = 0; j < 4; ++j) { xv[j] = *(const f32x4*)(x + (lane + 64 * j) * 4); ss += (xv[j][0] * xv[j][0] + xv[j][1] * xv[j][1]) + (xv[j][2] * xv[j][2] + xv[j][3] * xv[j][3]); }
        const float rstd = rsqrtf(wave_sum(ss) * (1.f / 1024.f) + 1e-6f);
#pragma unroll
        for (int j = 0; j < 4; ++j) { const int cidx = (lane + 64 * j) * 4; const f32x4 gv = *(const f32x4*)(g + cidx), sv = *(const f32x4*)(sc + cidx), hv = *(const f32x4*)(sh + cidx);
            const f32x4 y = xv[j] * rstd * gv * (sv + 1.f) + hv; u32x2 wv; wv.x = pk2(y[0], y[1]); wv.y = pk2(y[2], y[3]);
            *(u32x2*)(H + (size_t)row * 1024 + cidx) = wv; }
    }
}

__device__ __forceinline__ void readout_phase(const Frame& F, const bf16_t* OF, const bf16_t* OB, const bf16_t* SG, const float* gn, bf16_t* R) {
    const int lane = lane_id_v(); const int l31 = lane & 31;
    const f32x4 gv = *(const f32x4*)(gn + l31 * 4);
    for (int row = F.gw; row < MT; row += F.NGW) {
#pragma unroll
        for (int ps = 0; ps < 4; ++ps) {
            const size_t off = (size_t)row * 1024 + (size_t)((lane >> 5) + 2 * ps) * 128 + l31 * 4;
            const u32x2 a = *(const u32x2*)(OF + off), b = *(const u32x2*)(OB + off), sgw = *(const u32x2*)(SG + off);
            float o[4] = {bflo(a.x) + bflo(b.x), bfhi(a.x) + bfhi(b.x), bflo(a.y) + bflo(b.y), bfhi(a.y) + bfhi(b.y)};
            float ss = (o[0] * o[0] + o[1] * o[1]) + (o[2] * o[2] + o[3] * o[3]);
#pragma unroll
            for (int m = 1; m < 32; m <<= 1) ss += __shfl_xor(ss, m);
            const float rstd = rsqrtf(ss * (1.f / 128.f) + 1e-6f);
            u32x2 wv; wv.x = pk2(o[0] * rstd * gv[0] * bflo(sgw.x), o[1] * rstd * gv[1] * bfhi(sgw.x)); wv.y = pk2(o[2] * rstd * gv[2] * bflo(sgw.y), o[3] * rstd * gv[3] * bfhi(sgw.y));
            *(u32x2*)(R + off) = wv;
        }
    }
}


struct EpiLruIn {
    bf16_t* GG; bf16_t* XR;
    __device__ __forceinline__ void operator()(const f32x4 (&acc)[2][2][4][2], const Unit& u, int wr, int wc, int fr, int fq, LAS unsigned char*, int, int) const {
        const bool isx = u.pn >= 4; const int col0 = (u.pn & 3) * 256 + wc * 32 + 8 * fq;
        bf16_t* dst = isx ? XR : GG;
#pragma unroll
        for (int ai = 0; ai < 2; ++ai)
#pragma unroll
            for (int m = 0; m < 4; ++m) { const int row = u.pm * 256 + ai * HALF + wr * 64 + m * 16 + fr; int drow = row;
                if (isx && row < ML) { const int t = row & 8191; drow = (row & ~8191) + (t & 63) * 128 + (t >> 6); }
#pragma unroll
                for (int bj = 0; bj < 2; ++bj) { f32x4 v0 = acc[ai][bj][m][0], v1 = acc[ai][bj][m][1];
                    if (!isx) {
#pragma unroll
                        for (int j = 0; j < 4; ++j) { v0[j] = fgelu_tanh(v0[j]); v1[j] = fgelu_tanh(v1[j]); } }
                    u32x4 w; w.x = cvt_pk_bf16(v0[0], v0[1]); w.y = cvt_pk_bf16(v0[2], v0[3]); w.z = cvt_pk_bf16(v1[0], v1[1]); w.w = cvt_pk_bf16(v1[2], v1[3]);
                    *(u32x4*)((char*)dst + (unsigned)((drow * 1024 + col0 + bj * HALF) * 2)) = w; }
                asm volatile("" ::: "memory"); }
    }
};
__device__ __forceinline__ void lru_conv_phase(const Frame& F, const bf16_t* XR, const float* cw, const float* cb, bf16_t* XC) {
    const int lane = lane_id_v(); const int gt = F.gw * 64 + lane, ngt = F.NGW * 64;
    for (int it = gt; it < MT * 128; it += ngt) {
        const int row = it >> 7, c8 = (it & 127) * 8;
        const int s0 = row < ML ? (row & ~8191) : (ML + ((row - ML) & ~255)), slen = row < ML ? 8192 : 256, p = row - s0;
        float a[8];
#pragma unroll
        for (int j = 0; j < 8; ++j) a[j] = cb[c8 + j];
#pragma unroll
        for (int k = 0; k < 4; ++k) { const int pp = p + k - 2;
            if (pp >= 0 && pp < slen) { const u32x4 xv = *(const u32x4*)(XR + (size_t)(s0 + pp) * 1024 + c8); const f32x4 w0 = *(const f32x4*)(cw + k * 1024 + c8), w1 = *(const f32x4*)(cw + k * 1024 + c8 + 4);
                a[0] += w0[0] * bflo(xv.x); a[1] += w0[1] * bfhi(xv.x); a[2] += w0[2] * bflo(xv.y); a[3] += w0[3] * bfhi(xv.y);
                a[4] += w1[0] * bflo(xv.z); a[5] += w1[1] * bfhi(xv.z); a[6] += w1[2] * bflo(xv.w); a[7] += w1[3] * bfhi(xv.w); } }
        u32x4 o; o.x = pk2(a[0], a[1]); o.y = pk2(a[2], a[3]); o.z = pk2(a[4], a[5]); o.w = pk2(a[6], a[7]);
        *(u32x4*)(XC + (size_t)row * 1024 + c8) = o;
    }
}
#define MK_DPP(oldv, src, ctrl) __builtin_bit_cast(float, __builtin_amdgcn_update_dpp(__builtin_bit_cast(int, (float)(oldv)), __builtin_bit_cast(int, (float)(src)), ctrl, 0xF, 0xF, false))
struct EpiGates {
    const bf16_t* XC; bf16_t *HLf, *Pf, *HLb, *Pb; float* agg; const float* ba; const float* bx; const float* lam;
    __device__ __forceinline__ void operator()(const f32x4 (&acc)[2][2][4][2], const Unit& u, int wr, int wc, int fr, int fq, LAS unsigned char*, int, int) const {
        const int c0 = 256 * (u.pn >> 2) + 64 * (u.pn & 3) + 16 * wc + 4 * fq;
#pragma unroll
        for (int d = 0; d < 2; ++d) {
            const f32x4 bav = *(const f32x4*)(ba + d * 1024 + c0), bxv = *(const f32x4*)(bx + d * 1024 + c0), lmv = *(const f32x4*)(lam + d * 1024 + c0);
            f32x4 spv;
#pragma unroll
            for (int j = 0; j < 4; ++j) { const float l = lmv[j]; spv[j] = (l > 0.f) ? log1pf(__expf(-l)) : (-l + log1pf(__expf(l))); }
            bf16_t* HL = d ? HLb : HLf; bf16_t* PP = d ? Pb : Pf;
#pragma unroll
            for (int ai = 0; ai < 2; ++ai) {
                const int grow0 = u.pm * 256 + ai * HALF + wr * 64, gidx = grow0 >> 6;
                unsigned hlw[4][2], ppw[4][2];
                u32x2 xw[4];
#pragma unroll
                for (int m = 0; m < 4; ++m) xw[m] = *(const u32x2*)((const char*)XC + (unsigned)(((grow0 + m * 16 + fr) * 1024 + c0) * 2));
#pragma unroll
                for (int jp = 0; jp < 2; ++jp) {
                    __builtin_amdgcn_sched_barrier(0);
                    float A[4][2], U[4][2];
#pragma unroll
                    for (int m = 0; m < 4; ++m) { const unsigned xww = jp ? xw[m].y : xw[m].x; const float xc[2] = {bflo(xww), bfhi(xww)};
                        const f32x4 pa = d ? acc[ai][1][m][0] : acc[ai][0][m][0], px = d ? acc[ai][1][m][1] : acc[ai][0][m][1];
#pragma unroll
                        for (int jj = 0; jj < 2; ++jj) { const int j = 2 * jp + jj; const float r = fsigmoid(pa[j] + bav[j]), ig = fsigmoid(px[j] + bxv[j]); const float la = -8.f * r * spv[j];
                            A[m][jj] = __expf(la); U[m][jj] = sqrtf(fmaxf(1.f - __expf(2.f * la), 0.f)) * (ig * xc[jj]); } }
#pragma unroll
                    for (int jj = 0; jj < 2; ++jj) { const int j = 2 * jp + jj;
                        if (d == 0) {
                            float ca = 1.f, cu = 0.f;
#pragma unroll
                            for (int m = 0; m < 4; ++m) { float a = A[m][jj], x = U[m][jj]; float ap, up;
                                ap = MK_DPP(1.f, a, 0x111); up = MK_DPP(0.f, x, 0x111); x = a * up + x; a = a * ap;
                                ap = MK_DPP(1.f, a, 0x112); up = MK_DPP(0.f, x, 0x112); x = a * up + x; a = a * ap;
                                ap = MK_DPP(1.f, a, 0x114); up = MK_DPP(0.f, x, 0x114); x = a * up + x; a = a * ap;
                                ap = MK_DPP(1.f, a, 0x118); up = MK_DPP(0.f, x, 0x118); x = a * up + x; a = a * ap;
                                x = a * cu + x; a = a * ca; A[m][jj] = a; U[m][jj] = x; ca = __shfl(a, 15, 16); cu = __shfl(x, 15, 16); }
                            if (fr == 15) { agg[((size_t)(gidx * 2 + 0) * 2 + 0) * 1024 + c0 + j] = A[3][jj]; agg[((size_t)(gidx * 2 + 0) * 2 + 1) * 1024 + c0 + j] = U[3][jj]; }
                        } else {
                            float ca = 1.f, cu = 0.f;
#pragma unroll
                            for (int mm = 0; mm < 4; ++mm) { const int m = 3 - mm; float a = A[m][jj], x = U[m][jj]; float ap, up;
                                ap = MK_DPP(1.f, a, 0x101); up = MK_DPP(0.f, x, 0x101); x = a * up + x; a = a * ap;
                                ap = MK_DPP(1.f, a, 0x102); up = MK_DPP(0.f, x, 0x102); x = a * up + x; a = a * ap;
                                ap = MK_DPP(1.f, a, 0x104); up = MK_DPP(0.f, x, 0x104); x = a * up + x; a = a * ap;
                                ap = MK_DPP(1.f, a, 0x108); up = MK_DPP(0.f, x, 0x108); x = a * up + x; a = a * ap;
                                x = a * cu + x; a = a * ca; A[m][jj] = a; U[m][jj] = x; ca = __shfl(a, 0, 16); cu = __shfl(x, 0, 16); }
                            if (fr == 0) { agg[((size_t)(gidx * 2 + 1) * 2 + 0) * 1024 + c0 + j] = A[0][jj]; agg[((size_t)(gidx * 2 + 1) * 2 + 1) * 1024 + c0 + j] = U[0][jj]; }
                        }
                    }
#pragma unroll
                    for (int m = 0; m < 4; ++m) { hlw[m][jp] = cvt_pk_bf16(U[m][0], U[m][1]); ppw[m][jp] = cvt_pk_bf16(A[m][0], A[m][1]); }
                }
#pragma unroll
                for (int m = 0; m < 4; ++m) { const unsigned off = (unsigned)(((grow0 + m * 16 + fr) * 1024 + c0) * 2);
                    *(u32x2*)((char*)HL + off) = (u32x2){hlw[m][0], hlw[m][1]}; *(u32x2*)((char*)PP + off) = (u32x2){ppw[m][0], ppw[m][1]}; }
                asm volatile("" ::: "memory");
            }
        }
    }
};
__device__ __forceinline__ void lru_gscan_phase(const Frame& F, const float* agg, float* hin) {
    const int lane = lane_id_v(); const int gt = F.gw * 64 + lane;
    if (gt >= 4096) return;
    const int b = gt >> 11, d = (gt >> 10) & 1, c = gt & 1023;
    float h = 0.f;
#pragma unroll 1
    for (int s0 = 0; s0 < 132; s0 += 12) {
        float pt[12], ht[12];
#pragma unroll
        for (int k = 0; k < 12; ++k) { const int s = s0 + k; const int g = (s < 4) ? (256 + 4 * b + (d ? (3 - s) : s)) : (128 * b + (d ? (127 - (s - 4)) : (s - 4)));
            pt[k] = agg[((size_t)(g * 2 + d) * 2 + 0) * 1024 + c]; ht[k] = agg[((size_t)(g * 2 + d) * 2 + 1) * 1024 + c]; }
#pragma unroll
        for (int k = 0; k < 12; ++k) { const int s = s0 + k; const int g = (s < 4) ? (256 + 4 * b + (d ? (3 - s) : s)) : (128 * b + (d ? (127 - (s - 4)) : (s - 4)));
            hin[(size_t)(g * 2 + d) * 1024 + c] = h; h = pt[k] * h + ht[k]; }
    }
}
__device__ __forceinline__ void lru_final_phase(const Frame& F, const bf16_t* HLf, const bf16_t* Pf, const bf16_t* HLb, const bf16_t* Pb, const float* hin, const bf16_t* GG, bf16_t* Y) {
    const int lane = lane_id_v(); const int gt = F.gw * 64 + lane, ngt = F.NGW * 64;
    for (int it = gt; it < ML * 128; it += ngt) {
        const int row = it >> 7, c8 = (it & 127) * 8; const int t = row & 8191; const int prow = (row & ~8191) + (t & 63) * 128 + (t >> 6), g = prow >> 6;
        const size_t po = (size_t)prow * 1024 + c8;
        const u32x4 hf = *(const u32x4*)(HLf + po), pf = *(const u32x4*)(Pf + po), hb = *(const u32x4*)(HLb + po), pb = *(const u32x4*)(Pb + po), gg = *(const u32x4*)(GG + (size_t)row * 1024 + c8);
        const float* hif = hin + (size_t)(g * 2 + 0) * 1024 + c8; const float* hib = hin + (size_t)(g * 2 + 1) * 1024 + c8;
        const f32x4 f0 = *(const f32x4*)hif, f1 = *(const f32x4*)(hif + 4), b0 = *(const f32x4*)hib, b1 = *(const f32x4*)(hib + 4);
        float y[8];
        y[0] = (bflo(hf.x) + bflo(pf.x) * f0[0] + bflo(hb.x) + bflo(pb.x) * b0[0]) * bflo(gg.x); y[1] = (bfhi(hf.x) + bfhi(pf.x) * f0[1] + bfhi(hb.x) + bfhi(pb.x) * b0[1]) * bfhi(gg.x);
        y[2] = (bflo(hf.y) + bflo(pf.y) * f0[2] + bflo(hb.y) + bflo(pb.y) * b0[2]) * bflo(gg.y); y[3] = (bfhi(hf.y) + bfhi(pf.y) * f0[3] + bfhi(hb.y) + bfhi(pb.y) * b0[3]) * bfhi(gg.y);
        y[4] = (bflo(hf.z) + bflo(pf.z) * f1[0] + bflo(hb.z) + bflo(pb.z) * b1[0]) * bflo(gg.z); y[5] = (bfhi(hf.z) + bfhi(pf.z) * f1[1] + bfhi(hb.z) + bfhi(pb.z) * b1[1]) * bfhi(gg.z);
        y[6] = (bflo(hf.w) + bflo(pf.w) * f1[2] + bflo(hb.w) + bflo(pb.w) * b1[2]) * bflo(gg.w); y[7] = (bfhi(hf.w) + bfhi(pf.w) * f1[3] + bfhi(hb.w) + bfhi(pb.w) * b1[3]) * bfhi(gg.w);
        u32x4 o; o.x = pk2(y[0], y[1]); o.y = pk2(y[2], y[3]); o.z = pk2(y[4], y[5]); o.w = pk2(y[6], y[7]);
        *(u32x4*)(Y + (size_t)row * 1024 + c8) = o;
    }
}
__device__ __forceinline__ void final_norm_phase(const Frame& F, float* lat, const float* g, float dbg_s, float dbg_spike) {
    const int lane = lane_id_v();
    for (int row = F.gw; row < ML; row += F.NGW) {
        float* x = lat + (size_t)row * 1024; f32x4 xv[4]; float ss = 0.f;
#pragma unroll
        for (int j = 0; j < 4; ++j) { xv[j] = *(const f32x4*)(x + (lane + 64 * j) * 4); ss += (xv[j][0] * xv[j][0] + xv[j][1] * xv[j][1]) + (xv[j][2] * xv[j][2] + xv[j][3] * xv[j][3]); }
        const float rstd = rsqrtf(wave_sum(ss) * (1.f / 1024.f) + 1e-6f);
#pragma unroll
        for (int j = 0; j < 4; ++j) { const int cidx = (lane + 64 * j) * 4; f32x4 y = xv[j] * rstd * *(const f32x4*)(g + cidx);
            if (dbg_s != 0.f) { y[0] += dbg_s; y[1] -= dbg_s; y[2] += dbg_s; y[3] -= dbg_s; }
            if (dbg_spike != 0.f && row == 0 && cidx == 0) y[0] += dbg_spike;
            *(f32x4*)(x + cidx) = y; }
    }
}

struct Args { const float* in[25]; float* out; unsigned char* ws; int ph_lo, ph_hi; };
__global__ void __launch_bounds__(NTHR, 2) mega(Args args) {
    extern __shared__ __attribute__((aligned(16))) unsigned char lds_raw[];
    LAS unsigned char* lds = (LAS unsigned char*)lds_raw;
    Frame F; F.lds = lds; F.wave = __builtin_amdgcn_readfirstlane(threadIdx.x >> 6); F.G = gridDim.x;
    F.gw = blockIdx.x * NWAVES + F.wave; F.NGW = F.G * NWAVES;
    volatile LAS unsigned* MISC = (volatile LAS unsigned*)(lds + MISC_OFF);
    if (threadIdx.x < 64) MISC[threadIdx.x] = 0u;
    __syncthreads();
    unsigned char* ws = args.ws;
    XcdBarrier bar = xcd_barrier_post((unsigned*)(ws + WS_CTL) + CW_BAR, MISC + 8);
    const float* x = args.in[0]; const float* cvec = args.in[1]; const float* ctx = args.in[2]; const float* cctx = args.in[3];
    const float* w_ada = args.in[4]; const float* b_ada = args.in[5]; const float* norm_g = args.in[6];
    const float* hg_w_in = args.in[7]; const float* hg_lb = args.in[8]; const float* hg_gn = args.in[9]; const float* hg_w_out = args.in[10];
    float* MOD = (float*)(ws + WS_MOD); float* LB = (float*)(ws + WS_LB); float* CXLAT = (float*)(ws + WS_CXLAT); float* SIDE = (float*)(ws + WS_SIDE);
    bf16_t* W_HGIN = (bf16_t*)(ws + WS_W_HGIN); bf16_t* W_HGOUT = (bf16_t*)(ws + WS_W_HGOUT); bf16_t* W_UP = (bf16_t*)(ws + WS_W_UP); bf16_t* W_DN0 = (bf16_t*)(ws + WS_W_DN0);
    bf16_t* W_LRUIN = (bf16_t*)(ws + WS_W_LRUIN); bf16_t* W_GATES = (bf16_t*)(ws + WS_W_GATES); bf16_t* W_LRUOUT = (bf16_t*)(ws + WS_W_LRUOUT); bf16_t* W_DN1 = (bf16_t*)(ws + WS_W_DN1);
    bf16_t* UEDGE = (bf16_t*)(ws + WS_UEDGE);
    const float* lru_w_in = args.in[11]; const float* lru_cw = args.in[12]; const float* lru_cb = args.in[13]; const float* lru_wa = args.in[14]; const float* lru_ba = args.in[15];
    const float* lru_wx = args.in[16]; const float* lru_bx = args.in[17]; const float* lru_lam = args.in[18]; const float* lru_w_out = args.in[19];
    const float* ffn_up = args.in[20]; const float* ffn_cw = args.in[21]; const float* ffn_cb = args.in[22]; const float* ffn_down = args.in[23]; const float* final_g = args.in[24];
    bf16_t* ACT[6];
#pragma unroll
    for (int i = 0; i < 6; ++i) ACT[i] = (bf16_t*)(ws + WS_ACT + (size_t)i * ACT_SLOT);
    bf16_t* Hd = (bf16_t*)args.out;
    const int lo = args.ph_lo, hi = args.ph_hi;
#define IN(k) (lo <= (k) && (k) < hi)
#ifdef MK_TIMING
    unsigned long long* TS = (unsigned long long*)(ws + WS_CTL + 8192);
#define STAMP(k) do { if (blockIdx.x == 0 && F.wave == 0 && lane_id_v() == 0) TS[(k)] = __builtin_amdgcn_s_memrealtime(); } while (0)
#else
#define STAMP(k) do { } while (0)
#endif
    STAMP(0);
#define SEAM(k) do { if (IN(k) && IN((k) + 1)) xcd_barrier(bar, F.wave); STAMP((k) + 1); } while (0)

    if (IN(0)) {
        adaln_phase(F, cvec, cctx, w_ada, b_ada, MOD);
        if (blockIdx.x == F.G - 1) for (int i = F.wave * 64 + lane_id_v(); i < 2048; i += NTHR) { const float l0 = hg_lb[i], l1 = hg_lb[2048 + i]; const float m = fmaxf(l0, l1), e0 = __expf(l0 - m), e1 = __expf(l1 - m); LB[i] = e0 / (e0 + e1); }
        __syncthreads();
        { ConvJob j{CV_HG, hg_w_in, nullptr, 1024, 5120, 5120, W_HGIN}; conv_job(F, j, F.gw, F.NGW); }
    }
    SEAM(0);
    if (IN(1)) norm_phase(F, x, ctx, norm_g, MOD, 0, 1024, Hd, MT);
    SEAM(1);
    if (IN(2)) {
        Gemm g{Hd, W_HGIN, 1024, 1024, 1024, 0, 0}; StaticOrder S; S.init(NTM, 20, F.G, (int)blockIdx.x);
        EpiHgIn E{ACT[0], ACT[1], ACT[2], ACT[3], ACT[4], ACT[5], SIDE, LB};
        gemm_phase(lds, g, S, E, F.wave);
    }
    SEAM(2);
    float* SSEG = (float*)args.out; float* DSEG = (float*)args.out + (size_t)256 * 16384;
    if (IN(3)) {
        for (int u = blockIdx.x; u < 256; u += F.G) if ((u & 7) != 7) { const int dd = (u >> 3) & 1;
            hgrn_segment<false>(lds, dd ? ACT[2] : ACT[0], dd ? ACT[3] : ACT[1], ACT[4], SIDE, SSEG, DSEG, u >> 3, u & 7, F.wave); }
        { ConvJob j{CV_NAT, hg_w_out, nullptr, 1024, 1024, 1024, W_HGOUT}; conv_job(F, j, F.gw, F.NGW); }
        { ConvJob j{CV_UP, ffn_up, nullptr, 1024, 5632, 5632, W_UP}; conv_job(F, j, F.gw, F.NGW); }
        { ConvJob j{CV_NAT, ffn_down, nullptr, 2816, 1024, 1024, W_DN0}; conv_job(F, j, F.gw, F.NGW); }
        { ConvJob j{CV_PERM8, lru_w_in, nullptr, 1024, 2048, 2048, W_LRUIN}; conv_job(F, j, F.gw, F.NGW); }
        { ConvJob j{CV_GATES, lru_wa, lru_wx, 256, 4096, 256, W_GATES}; conv_job(F, j, F.gw, F.NGW); }
        { ConvJob j{CV_NAT, lru_w_out, nullptr, 1024, 1024, 1024, W_LRUOUT}; conv_job(F, j, F.gw, F.NGW); }
        { ConvJob j{CV_NAT, ffn_down + (size_t)2816 * 1024, nullptr, 2816, 1024, 1024, W_DN1}; conv_job(F, j, F.gw, F.NGW); }
    }
    SEAM(3);
    if (IN(4)) {
        for (int u = blockIdx.x; u < 256; u += F.G) { const int dd = (u >> 3) & 1;
            hgrn_segment<true>(lds, dd ? ACT[2] : ACT[0], dd ? ACT[3] : ACT[1], ACT[4], SIDE, SSEG, DSEG, u >> 3, u & 7, F.wave); }
    }
    SEAM(4);
    if (IN(5)) readout_phase(F, ACT[0], ACT[2], ACT[5], hg_gn, ACT[1]);
    SEAM(5);
    if (IN(6)) {
        Gemm g{ACT[1], W_HGOUT, 1024, 1024, 1024, 0, 0}; StaticOrder S; S.init(NTM, 4, F.G, (int)blockIdx.x);
        EpiResid E{x, ctx, args.out, CXLAT, MOD, 2048};
        gemm_phase(lds, g, S, E, F.wave);
    }
    SEAM(6);
    if (IN(7)) norm_phase(F, args.out, CXLAT, norm_g + 1024, MOD, 3072, 4096, ACT[5], MT);
    SEAM(7);
    if (IN(8)) {
        Gemm g{ACT[5], W_UP, 1024, 1024, 1024, 0, 0}; StaticOrder S; S.init(NTM, 22, F.G, (int)blockIdx.x);
        EpiUpConv E{ACT[0], UEDGE, ffn_cw, ffn_cb};
        gemm_phase(lds, g, S, E, F.wave);
    }
    SEAM(8);
    if (IN(9)) {
        StaticOrder S; S.init(NTM, 4, F.G, (int)blockIdx.x);
        { Unit u; const int tid = F.wave * 64 + lane_id_v(); for (int i = 0; S.next(i, u); ++i) ffn_fix_edges(tid, u.pm, ACT[0], UEDGE, ffn_cw, ffn_cb); }
        VM_WAIT(); __syncthreads();
        Gemm g{ACT[0], W_DN0, 2816, 2816, 2816, 0, 0};
        EpiResid E{args.out, CXLAT, args.out, CXLAT, MOD, 5120};
        gemm_phase(lds, g, S, E, F.wave);
    }
    SEAM(9);
    float* MOD1 = MOD + 3 * 6144; float* AGG = SIDE; float* HIN = (float*)(ws + WS_SIDE + 4 * MiB + 256 * 1024);
    if (IN(10)) {
        norm_phase(F, args.out, CXLAT, norm_g + 2048, MOD1, 0, 1024, ACT[0], MT);
    }
    SEAM(10);
    if (IN(11)) {
        Gemm g{ACT[0], W_LRUIN, 1024, 1024, 1024, 0, 0}; StaticOrder S; S.init(NTM, 8, F.G, (int)blockIdx.x);
        EpiLruIn E{ACT[1], ACT[2]};
        gemm_phase(lds, g, S, E, F.wave);
    }
    SEAM(11);
    if (IN(12)) lru_conv_phase(F, ACT[2], lru_cw, lru_cb, ACT[3]);
    SEAM(12);
    if (IN(13)) {
        Gemm g{ACT[3], W_GATES, 1024, 256, 256, 2, 256}; StaticOrder S; S.init(NTM, 16, F.G, (int)blockIdx.x);
        EpiGates E{ACT[3], ACT[0], ACT[4], ACT[5], ACT[2], AGG, lru_ba, lru_bx, lru_lam};
        gemm_phase(lds, g, S, E, F.wave);
    }
    SEAM(13);
    if (IN(14)) {
        if ((int)blockIdx.x < 8) lru_gscan_phase(F, AGG, HIN);
        else { const int gw2 = ((int)blockIdx.x - 8) * NWAVES + F.wave, ngw2 = (F.G - 8) * NWAVES;
            ConvJob j{CV_UP, ffn_up + (size_t)1024 * 5632, nullptr, 1024, 5632, 5632, W_UP}; conv_job(F, j, gw2, ngw2); }
    }
    SEAM(14);
    if (IN(15)) lru_final_phase(F, ACT[0], ACT[4], ACT[5], ACT[2], HIN, ACT[1], ACT[3]);
    SEAM(15);
    if (IN(16)) {
        Gemm g{ACT[3], W_LRUOUT, 1024, 1024, 1024, 0, 0}; StaticOrder S; S.init(64, 4, F.G, (int)blockIdx.x);
        EpiResid E{args.out, CXLAT, args.out, CXLAT, MOD1, 2048};
        gemm_phase(lds, g, S, E, F.wave);
    }
    SEAM(16);
    if (IN(17)) norm_phase(F, args.out, CXLAT, norm_g + 3072, MOD1, 3072, 4096, ACT[5], ML);
    SEAM(17);
    if (IN(18)) {
        Gemm g{ACT[5], W_UP, 1024, 1024, 1024, 0, 0}; StaticOrder S; S.init(64, 22, F.G, (int)blockIdx.x);
        EpiUpConv E{ACT[0], UEDGE, ffn_cw + 3 * 5632, ffn_cb + 5632};
        gemm_phase(lds, g, S, E, F.wave);
    }
    SEAM(18);
    if (IN(19)) {
        StaticOrder S; S.init(64, 4, F.G, (int)blockIdx.x);
        { Unit u; const int tid = F.wave * 64 + lane_id_v(); for (int i = 0; S.next(i, u); ++i) ffn_fix_edges(tid, u.pm, ACT[0], UEDGE, ffn_cw + 3 * 5632, ffn_cb + 5632); }
        VM_WAIT(); __syncthreads();
        Gemm g{ACT[0], W_DN1, 2816, 2816, 2816, 0, 0};
        EpiResid E{args.out, CXLAT, args.out, CXLAT, MOD1, 5120};
        gemm_phase(lds, g, S, E, F.wave);
    }
    SEAM(19);
#ifdef MK_TIMING
    if (IN(20)) { const float t_a = (float)(TS[MK_T_A1] - TS[MK_T_A0]) * 0.01f, t_b = (float)(TS[MK_T_B1] - TS[MK_T_B0]) * 0.01f;
        final_norm_phase(F, args.out, final_g, sqrtf(t_a * 1e-6f), t_b * (1.f / 500.f)); }
#else
    if (IN(20)) final_norm_phase(F, args.out, final_g, 0.f, 0.f);
#endif
#undef IN
#undef SEAM
}
}
__global__ void __launch_bounds__(128) k_refscan(unsigned short* QF, const unsigned short* KF, unsigned short* QB, const unsigned short* KB, const unsigned short* V, const float* side) {
    const int ch = blockIdx.x, b = ch >> 4, h = (ch >> 1) & 7, d = ch & 1, t = threadIdx.x;
    unsigned short* Qd = d ? QB : QF; const unsigned short* Kd = d ? KB : KF;
    __shared__ float q[64][129], k[64][129], vs[64][128], P[64][65], e1[128], e2[128], dec[128];
    float S[128];
#pragma unroll
    for (int i = 0; i < 128; ++i) S[i] = 0.f;
    for (int s = 0; s < 132; ++s) {
        const int rb = (s < 4) ? (16384 + b * 256 + 64 * (d ? (3 - s) : s)) : (b * 8192 + 64 * (d ? (127 - (s - 4)) : (s - 4)));
        const int ck = rb >> 6;
        for (int idx = t; idx < 8192; idx += 128) { const int r = idx >> 7, c = idx & 127; const size_t g = (size_t)(rb + r) * 1024 + h * 128 + c;
            q[r][c] = mk::bf2f(Qd[g]); k[r][c] = mk::bf2f(Kd[g]); vs[r][c] = mk::bf2f(V[g]); }
        e1[t] = side[((size_t)(ck * 2 + d) * 3 + 0) * 1024 + h * 128 + t]; e2[t] = side[((size_t)(ck * 2 + d) * 3 + 1) * 1024 + h * 128 + t]; dec[t] = side[((size_t)(ck * 2 + d) * 3 + 2) * 1024 + h * 128 + t];
        __syncthreads();
        for (int idx = t; idx < 4096; idx += 128) { const int i = idx >> 6, j = idx & 63; const bool ok = d ? (j >= i) : (j <= i); float p = 0.f;
            if (ok) for (int c = 0; c < 128; ++c) p += q[i][c] * k[j][c];
            P[i][j] = p; }
        __syncthreads();
        for (int i = 0; i < 64; ++i) { float o = 0.f;
#pragma unroll
            for (int c = 0; c < 128; ++c)
#ifdef UNIT_SIDE
                o += q[i][c] * S[c];
#else
                o += q[i][c] * (e1[c] * S[c]);
#endif

            for (int j = 0; j < 64; ++j) o += P[i][j] * vs[j][t];
            Qd[(size_t)(rb + i) * 1024 + h * 128 + t] = (unsigned short)mk::f2bf(o); }
#pragma unroll
        for (int c = 0; c < 128; ++c) { float u = 0.f; for (int j = 0; j < 64; ++j) u += k[j][c] * vs[j][t];
#ifdef ZERO_STATE
            S[c] = 0.f;
#elif defined(UNIT_SIDE)
            S[c] = S[c] + u;
#else
            S[c] = dec[c] * S[c] + e2[c] * u;
#endif
        }
        __syncthreads();
    }
}

#ifndef MK_CUT
#define MK_CUT 1
#endif
#ifndef MK_ONE_LAUNCH
#define MK_ONE_LAUNCH 0
#endif
static void gemm(hipStream_t s, const float* A, int lda, const float* B, int ldb, float* C, int ldc, int M, int N, int K) {
    dim3 g(N / 64, (M + 63) / 64);
    hipLaunchKernelGGL(k_gemm, g, dim3(256), 0, s, A, lda, B, ldb, C, ldc, M, N, K);
}

extern "C" void kernel_launch(void* const* d_in, const int* in_sizes, int n_in, void* d_out, int out_size, void* d_ws, size_t ws_size, hipStream_t stream) {
    const float* norm_g = (const float*)d_in[6];
    const float* lru_w_in = (const float*)d_in[11]; const float* lru_cw = (const float*)d_in[12]; const float* lru_cb = (const float*)d_in[13];
    const float* lru_wa = (const float*)d_in[14]; const float* lru_ba = (const float*)d_in[15]; const float* lru_wx = (const float*)d_in[16]; const float* lru_bx = (const float*)d_in[17];
    const float* lru_lam = (const float*)d_in[18]; const float* lru_w_out = (const float*)d_in[19];
    const float* ffn_up = (const float*)d_in[20]; const float* ffn_cw = (const float*)d_in[21]; const float* ffn_cb = (const float*)d_in[22]; const float* ffn_down = (const float*)d_in[23];
    const float* final_g = (const float*)d_in[24];
    float* out = (float*)d_out;
    char* ws = (char*)d_ws;
    static int grid = 0;
    if (grid == 0) {
        int dev = 0, cus = 0, per_cu = 0;
        hipGetDevice(&dev); hipDeviceGetAttribute(&cus, hipDeviceAttributeMultiprocessorCount, dev);
        hipFuncSetAttribute((const void*)mk::mega, hipFuncAttributeMaxDynamicSharedMemorySize, mk::LDS_BYTES);
        hipOccupancyMaxActiveBlocksPerMultiprocessor(&per_cu, (const void*)mk::mega, mk::NTHR, mk::LDS_BYTES);
        (void)hipGetLastError();
        if (per_cu < 1) fprintf(stderr, "kernel_launch: occupancy query says %d blocks/CU\n", per_cu);
        grid = cus > 0 ? cus : 256;
    }
    hipMemsetAsync(ws + mk::WS_CTL, 0, 1u << 20, stream);
    mk::Args a{};
    for (int i = 0; i < 25; ++i) a.in[i] = (const float*)d_in[i];
    a.out = out; a.ws = (unsigned char*)d_ws;
    const int nph = (MK_CUT == 1) ? 6 : (MK_CUT == 2) ? 9 : (MK_CUT == 3) ? 17 : 21;
#if MK_ONE_LAUNCH
    a.ph_lo = 0; a.ph_hi = nph;
    hipLaunchKernelGGL(mk::mega, dim3(grid), dim3(mk::NTHR), mk::LDS_BYTES, stream, a);
#else
    for (int p = 0; p < nph; ++p) { a.ph_lo = p; a.ph_hi = p + 1;
#ifdef CMP_SCAN
        if (p == 3) { unsigned short* A0 = (unsigned short*)(ws + mk::WS_ACT); const size_t SL = mk::ACT_SLOT / 2; int* flag = (int*)(ws + 255 * (1u << 20));
            hipMemcpyAsync(d_out, A0, mk::ACT_SLOT, hipMemcpyDeviceToDevice, stream);
            hipLaunchKernelGGL(k_refscan, dim3(32), dim3(128), 0, stream, (unsigned short*)d_out, A0 + SL, A0 + 2 * SL, A0 + 3 * SL, A0 + 4 * SL, (const float*)(ws + mk::WS_SIDE));
            hipMemcpyAsync(A0 + 2 * SL, A0 + 2 * SL, 0, hipMemcpyDeviceToDevice, stream);
            hipLaunchKernelGGL(mk::mega, dim3(grid), dim3(mk::NTHR), mk::LDS_BYTES, stream, a);
            hipLaunchKernelGGL(k_flag1000, dim3(1), dim3(64), 0, stream, flag);
            hipLaunchKernelGGL(k_cmpscan, dim3(132, 16), dim3(256), 0, stream, A0, (const unsigned short*)d_out, flag);
            { const size_t n = (size_t)16384 * 1024; hipLaunchKernelGGL(k_diagout2, dim3((n + 255) / 256), dim3(256), 0, stream, (float*)d_out, n, flag); }
            return; }
#endif
#ifdef USE_REFSCAN
        if (p == 3) { unsigned short* A0 = (unsigned short*)(ws + mk::WS_ACT); const size_t SL = mk::ACT_SLOT / 2;
            hipLaunchKernelGGL(k_refscan, dim3(32), dim3(128), 0, stream, A0, A0 + SL, A0 + 2 * SL, A0 + 3 * SL, A0 + 4 * SL, (const float*)(ws + mk::WS_SIDE)); continue; }
#endif
        hipLaunchKernelGGL(mk::mega, dim3(grid), dim3(mk::NTHR), mk::LDS_BYTES, stream, a); }
#endif
    const size_t MB = 1u << 20;
    float* CXLAT = (float*)(ws + mk::WS_CXLAT);
    float* MOD = (float*)(ws + mk::WS_MOD);
    char* arena = ws + 14 * MB;
    const size_t RBD = (size_t)RB * D * 4;
    float* BUF_H = (float*)(arena);
    float* BUF_O = (float*)(arena + RBD);
    float* BUF_Z = (float*)(arena + 2 * RBD);
    auto ffn = [&](int l, float* lat_seq, int seq_len, const float* modv) {
        const float* sh2 = modv + 3 * D; const float* sc2 = modv + 4 * D; const float* g2 = modv + 5 * D;
        const float* Wup = ffn_up + (size_t)l * D * 2 * DFF; const float* Wdn = ffn_down + (size_t)l * DFF * D;
        const float* cw = ffn_cw + (size_t)l * 3 * 2 * DFF; const float* cb = ffn_cb + (size_t)l * 2 * DFF;
        float* Hn = BUF_H;
        hipLaunchKernelGGL(k_norm_mod, dim3(seq_len), dim3(256), 0, stream, lat_seq, Hn, norm_g + (size_t)(l * 2 + 1) * D, sh2, sc2, seq_len);
        const int CH = 2048;
        float* U = BUF_Z; float* G = BUF_Z + (size_t)(CH + 2) * 2 * DFF; float* Y = G + (size_t)CH * DFF;
        for (int r0 = 0; r0 < seq_len; r0 += CH) {
            const int r1 = (r0 + CH < seq_len) ? r0 + CH : seq_len;
            const int u0 = r0 > 0 ? r0 - 1 : 0, u1 = r1 < seq_len ? r1 + 1 : seq_len;
            gemm(stream, Hn + (size_t)u0 * D, D, Wup, 2 * DFF, U, 2 * DFF, u1 - u0, 2 * DFF, D);
            const size_t n = (size_t)(r1 - r0) * DFF;
            hipLaunchKernelGGL(k_ffn_conv, dim3((n + 255) / 256), dim3(256), 0, stream, U, u0, cw, cb, G, r0, r1, seq_len);
            gemm(stream, G, DFF, Wdn, D, Y, D, r1 - r0, D, DFF);
            const size_t n2 = (size_t)(r1 - r0) * D;
            hipLaunchKernelGGL(k_resid, dim3((n2 + 255) / 256), dim3(256), 0, stream, lat_seq + (size_t)r0 * D, Y, g2, lat_seq + (size_t)r0 * D, n2);
        }
    };
    for (int b = 0; b < BATCH; ++b) {
        float* latL = out + (size_t)b * SEQ * D; float* latC = CXLAT + (size_t)b * CTX * D;
        if (MK_CUT < 2) {
            const float* modL = MOD + (size_t)b * 6 * D; const float* modC = MOD + (size_t)2 * 6 * D;
            ffn(0, latL, SEQ, modL);
            ffn(0, latC, CTX, modC);
        }
        if (MK_CUT < 3) {
            const float* modL = MOD + (size_t)18 * D + (size_t)b * 6 * D; const float* modC = MOD + (size_t)18 * D + (size_t)2 * 6 * D;
            const float* ng = norm_g + (size_t)2 * D;
            hipLaunchKernelGGL(k_norm_mod, dim3(CTX), dim3(256), 0, stream, latC, BUF_H, ng, modC, modC + D, CTX);
            hipLaunchKernelGGL(k_norm_mod, dim3(SEQ), dim3(256), 0, stream, latL, BUF_H + (size_t)CTX * D, ng, modL, modL + D, SEQ);
            float* Z2 = BUF_Z; float* XC = BUF_Z + (size_t)RB * 2 * D; float* PA = XC + (size_t)RB * D; float* PX = PA + (size_t)RB * D;
            float* Hf = BUF_H; float* Hb = BUF_O;
            gemm(stream, BUF_H, D, lru_w_in, 2 * D, Z2, 2 * D, RB, 2 * D, D);
            { const size_t n = (size_t)RB * D; hipLaunchKernelGGL(k_lru_conv, dim3((n + 255) / 256), dim3(256), 0, stream, Z2, lru_cw, lru_cb, XC); }
            for (int d = 0; d < 2; ++d) {
                for (int nb = 0; nb < 4; ++nb) {
                    gemm(stream, XC + nb * 256, D, lru_wa + (size_t)(d * 4 + nb) * 256 * 256, 256, PA + nb * 256, D, RB, 256, 256);
                    gemm(stream, XC + nb * 256, D, lru_wx + (size_t)(d * 4 + nb) * 256 * 256, 256, PX + nb * 256, D, RB, 256, 256);
                }
                hipLaunchKernelGGL(k_lru_scan, dim3(D / 64), dim3(64), 0, stream, XC, PA, PX, lru_ba, lru_bx, lru_lam, d ? Hb : Hf, d);
            }
            float* Y = PA;
            { const size_t n = (size_t)SEQ * D; hipLaunchKernelGGL(k_lru_out, dim3((n + 255) / 256), dim3(256), 0, stream, Hf, Hb, Z2, Y); }
            float* Y2 = PX;
            gemm(stream, Y, D, lru_w_out, D, Y2, D, SEQ, D, D);
            { const size_t n = (size_t)SEQ * D; hipLaunchKernelGGL(k_resid, dim3((n + 255) / 256), dim3(256), 0, stream, latL, Y2, modL + 2 * D, latL, n); }
        }
        if (MK_CUT < 4) {
            const float* modL = MOD + (size_t)18 * D + (size_t)b * 6 * D;
            ffn(1, latL, SEQ, modL);
            hipLaunchKernelGGL(k_norm_mod, dim3(SEQ), dim3(256), 0, stream, latL, latL, final_g, (const float*)nullptr, (const float*)nullptr, SEQ);
        }
    }
}
```

```cpp
#define MK_CUT 4
#define MK_ONE_LAUNCH 1
#include <hip/hip_runtime.h>
#include <cstdint>
#include <cstdio>

constexpr int D = 1024, BATCH = 2, SEQ = 8192, CTX = 256, GW = 64, GROWS = SEQ / GW;
constexpr int NH = 8, DK = 128, DV = 128, DFF = 2816;
constexpr int RB = CTX + SEQ;
constexpr float EPS = 1e-6f;

__device__ __forceinline__ float sigmoidf_(float x) { return 1.f / (1.f + __expf(-x)); }
__device__ __forceinline__ float siluf_(float x) { return x * sigmoidf_(x); }
__device__ __forceinline__ float gelu_tanh(float x) { const float k = 0.7978845608028654f; return 0.5f * x * (1.f + tanhf(k * (x + 0.044715f * x * x * x))); }

__global__ void k_adaln(const float* __restrict__ c, const float* __restrict__ cctx, const float* __restrict__ W, const float* __restrict__ bias, float* __restrict__ mod) {
    __shared__ float s[3][D];
    for (int i = threadIdx.x; i < D; i += blockDim.x) { s[0][i] = siluf_(c[i]); s[1][i] = siluf_(c[D + i]); s[2][i] = siluf_(cctx[i]); }
    __syncthreads();
    const int j = blockIdx.x * blockDim.x + threadIdx.x;
    if (j >= 6 * D) return;
    float a0 = 0.f, a1 = 0.f, a2 = 0.f;
    for (int k = 0; k < D; ++k) { const float w = W[(size_t)k * 6 * D + j]; a0 += s[0][k] * w; a1 += s[1][k] * w; a2 += s[2][k] * w; }
    const float bb = bias[j];
    mod[j] = a0 + bb; mod[6 * D + j] = a1 + bb; mod[12 * D + j] = a2 + bb;
}

__global__ void k_lb(const float* __restrict__ logits, float* __restrict__ lb) {
    const int i = blockIdx.x * blockDim.x + threadIdx.x;
    if (i >= 2 * D) return;
    const float l0 = logits[i], l1 = logits[2 * D + i];
    const float m = fmaxf(l0, l1), e0 = __expf(l0 - m), e1 = __expf(l1 - m);
    lb[i] = e0 / (e0 + e1);
}

__global__ void k_norm_mod(const float* in, float* out, const float* __restrict__ g, const float* __restrict__ sh, const float* __restrict__ sc, int rows) {
    const int r = blockIdx.x; if (r >= rows) return;
    const float* x = in + (size_t)r * D; float* o = out + (size_t)r * D;
    float v[4]; float ss = 0.f;
    for (int i = 0; i < 4; ++i) { v[i] = x[threadIdx.x + 256 * i]; ss += v[i] * v[i]; }
    __shared__ float red[256];
    red[threadIdx.x] = ss; __syncthreads();
    for (int s = 128; s > 0; s >>= 1) { if (threadIdx.x < s) red[threadIdx.x] += red[threadIdx.x + s]; __syncthreads(); }
    const float rstd = rsqrtf(red[0] / D + EPS);
    for (int i = 0; i < 4; ++i) { const int cidx = threadIdx.x + 256 * i; float y = v[i] * rstd * g[cidx]; if (sc) y = y * (1.f + sc[cidx]) + sh[cidx]; o[cidx] = y; }
}

__global__ void __launch_bounds__(256) k_gemm(const float* __restrict__ A, int lda, const float* __restrict__ B, int ldb, float* __restrict__ C, int ldc, int M, int N, int K) {
    __shared__ float As[16][64 + 4], Bs[16][64 + 4];
    const int tx = threadIdx.x % 16, ty = threadIdx.x / 16;
    const int m0 = blockIdx.y * 64, n0 = blockIdx.x * 64;
    float acc[4][4] = {};
    for (int k0 = 0; k0 < K; k0 += 16) {
        for (int i = threadIdx.x; i < 64 * 16; i += 256) { const int r = i / 16, kk = i % 16; As[kk][r] = (m0 + r < M) ? A[(size_t)(m0 + r) * lda + k0 + kk] : 0.f; }
        for (int i = threadIdx.x; i < 64 * 16; i += 256) { const int kk = i / 64, cc = i % 64; Bs[kk][cc] = B[(size_t)(k0 + kk) * ldb + n0 + cc]; }
        __syncthreads();
#pragma unroll
        for (int kk = 0; kk < 16; ++kk) {
            float a[4], b[4];
#pragma unroll
            for (int i = 0; i < 4; ++i) { a[i] = As[kk][ty * 4 + i]; b[i] = Bs[kk][tx * 4 + i]; }
#pragma unroll
            for (int i = 0; i < 4; ++i)
#pragma unroll
                for (int j = 0; j < 4; ++j) acc[i][j] += a[i] * b[j];
        }
        __syncthreads();
    }
    for (int i = 0; i < 4; ++i) { const int r = m0 + ty * 4 + i; if (r < M) for (int j = 0; j < 4; ++j) C[(size_t)r * ldc + n0 + tx * 4 + j] = acc[i][j]; }
}

__global__ void __launch_bounds__(128) k_hgrn_scan(const float* __restrict__ Z, const float* __restrict__ lb, float* __restrict__ Of, float* __restrict__ Ob) {
    const int h = blockIdx.x, d = blockIdx.y, t = threadIdx.x;
    float* O = d ? Ob : Of;
    __shared__ float sq[DK], sf[DK], sk[DK];
    float S[DK];
#pragma unroll
    for (int i = 0; i < DK; ++i) S[i] = 0.f;
    const float lbv = lb[d * D + h * DK + t];
    for (int step = 0; step < RB; ++step) {
        int row;
        if (step < CTX) row = d ? (CTX - 1 - step) : step;
        else { const int s = step - CTX; row = CTX + (d ? (SEQ - 1 - s) : s); }
        const float* z = Z + (size_t)row * 5 * D;
        const float qv = siluf_(z[h * DK + t]);
        const float f = lbv + (1.f - lbv) * sigmoidf_(z[(1 + d) * D + h * DK + t]);
        sq[t] = qv; sf[t] = f; sk[t] = 1.f - f;
        const float v = z[3 * D + h * DV + t];
        __syncthreads();
        float o = 0.f;
#pragma unroll
        for (int i = 0; i < DK; ++i) { S[i] = sf[i] * S[i] + sk[i] * v; o += sq[i] * S[i]; }
        O[(size_t)row * D + h * DV + t] = o;
        __syncthreads();
    }
}

__global__ void __launch_bounds__(128) k_hgrn_readout(const float* Of, const float* Ob, const float* __restrict__ Z, const float* __restrict__ gn, float* R, int rows) {
    const int r = blockIdx.x; if (r >= rows) return;
    __shared__ float red[128];
    for (int h = 0; h < NH; ++h) {
        const int cidx = h * DV + threadIdx.x;
        const float o = Of[(size_t)r * D + cidx] + Ob[(size_t)r * D + cidx];
        red[threadIdx.x] = o * o; __syncthreads();
        for (int s = 64; s > 0; s >>= 1) { if (threadIdx.x < s) red[threadIdx.x] += red[threadIdx.x + s]; __syncthreads(); }
        const float rstd = rsqrtf(red[0] / DV + EPS);
        __syncthreads();
        const float gte = siluf_(Z[(size_t)r * 5 * D + 4 * D + cidx]);
        R[(size_t)r * D + cidx] = o * rstd * gn[threadIdx.x] * gte;
    }
}

__global__ void k_resid(const float* base, const float* Y, const float* __restrict__ gate, float* out, size_t n) {
    const size_t i = (size_t)blockIdx.x * blockDim.x + threadIdx.x; if (i >= n) return;
    out[i] = base[i] + gate[i % D] * Y[i];
}

__global__ void k_ffn_conv(const float* __restrict__ U, int urow0, const float* __restrict__ cw, const float* __restrict__ cb, float* __restrict__ G, int r0, int r1, int seq_len) {
    const size_t i = (size_t)blockIdx.x * blockDim.x + threadIdx.x;
    const size_t n = (size_t)(r1 - r0) * DFF; if (i >= n) return;
    const int r = r0 + (int)(i / DFF), cidx = (int)(i % DFF);
    float u[2];
    for (int half = 0; half < 2; ++half) {
        const int cc = cidx + half * DFF; float a = cb[cc];
        for (int k = 0; k < 3; ++k) { const int rr = r + k - 1; if (rr >= 0 && rr < seq_len) a += cw[k * 2 * DFF + cc] * U[(size_t)(rr - urow0) * 2 * DFF + cc]; }
        u[half] = a;
    }
    G[i] = siluf_(u[0]) * u[1];
}

__device__ __forceinline__ int lat_row_of_cm(int p) { return CTX + (p % GROWS) * GW + p / GROWS; }
__global__ void k_lru_conv(const float* __restrict__ Z2, const float* __restrict__ cw, const float* __restrict__ cb, float* __restrict__ XC) {
    const size_t i = (size_t)blockIdx.x * blockDim.x + threadIdx.x; if (i >= (size_t)RB * D) return;
    const int pos = (int)(i / D), cidx = (int)(i % D);
    float a = cb[cidx];
    if (pos < CTX) { for (int k = 0; k < 4; ++k) { const int pp = pos + k - 2; if (pp >= 0 && pp < CTX) a += cw[k * D + cidx] * Z2[(size_t)pp * 2 * D + D + cidx]; } }
    else { const int p = pos - CTX; for (int k = 0; k < 4; ++k) { const int pp = p + k - 2; if (pp >= 0 && pp < SEQ) a += cw[k * D + cidx] * Z2[(size_t)lat_row_of_cm(pp) * 2 * D + D + cidx]; } }
    XC[i] = a;
}
__global__ void k_lru_scan(const float* __restrict__ XC, const float* __restrict__ PA, const float* __restrict__ PX, const float* __restrict__ ba, const float* __restrict__ bx, const float* __restrict__ lam, float* __restrict__ Hd, int d) {
    const int cidx = blockIdx.x * blockDim.x + threadIdx.x; if (cidx >= D) return;
    const float bav = ba[d * D + cidx], bxv = bx[d * D + cidx];
    const float l = lam[d * D + cidx]; const float sp = (l > 0.f) ? log1pf(__expf(-l)) : (-l + log1pf(__expf(l)));
    float h = 0.f;
    for (int step = 0; step < RB; ++step) {
        int pos;
        if (step < CTX) pos = d ? (CTX - 1 - step) : step;
        else { const int s = step - CTX; pos = CTX + (d ? (SEQ - 1 - s) : s); }
        const size_t o = (size_t)pos * D + cidx;
        const float r = sigmoidf_(PA[o] + bav), ig = sigmoidf_(PX[o] + bxv);
        const float la = -8.f * r * sp; const float a = __expf(la); const float mult = sqrtf(-expm1f(2.f * la));
        h = a * h + mult * (ig * XC[o]);
        Hd[o] = h;
    }
}
__global__ void k_lru_out(const float* __restrict__ Hf, const float* __restrict__ Hb, const float* __restrict__ Z2, float* __restrict__ Y) {
    const size_t i = (size_t)blockIdx.x * blockDim.x + threadIdx.x; if (i >= (size_t)SEQ * D) return;
    const int t = (int)(i / D), cidx = (int)(i % D);
    const int p = (t % GW) * GROWS + t / GW; const size_t o = (size_t)(CTX + p) * D + cidx;
    Y[i] = (Hf[o] + Hb[o]) * gelu_tanh(Z2[(size_t)(CTX + t) * 2 * D + cidx]);
}
__global__ void k_copy(const float* __restrict__ a, float* __restrict__ b, size_t n) { const size_t i = (size_t)blockIdx.x * blockDim.x + threadIdx.x; if (i < n) b[i] = a[i]; }


namespace mk {
#define LAS __attribute__((address_space(3)))
typedef unsigned short bf16_t;
typedef short bf16x8 __attribute__((ext_vector_type(8)));
typedef short s16x4 __attribute__((ext_vector_type(4)));
typedef float f32x4 __attribute__((ext_vector_type(4)));
typedef float f32x2 __attribute__((ext_vector_type(2)));
typedef unsigned u32x4 __attribute__((ext_vector_type(4)));
typedef unsigned u32x2 __attribute__((ext_vector_type(2)));

constexpr int NWAVES = 8, NTHR = 512;
constexpr int MT = 16896, ML = 16384, NTM = 66;
constexpr size_t MiB = 1u << 20;
constexpr size_t WS_CTL = 0;
constexpr size_t WS_MOD = 1 * MiB;
constexpr size_t WS_LB = WS_MOD + 160 * 1024;
constexpr size_t WS_CXLAT = 2 * MiB;
constexpr size_t WS_SIDE = 4 * MiB;
constexpr size_t WS_UEDGE = 10 * MiB + 512 * 1024;
constexpr size_t WS_W_HGIN = 14 * MiB, WS_W_HGOUT = 24 * MiB, WS_W_UP = 26 * MiB, WS_W_DN0 = 37 * MiB;
constexpr size_t WS_W_LRUIN = 43 * MiB, WS_W_GATES = 47 * MiB, WS_W_LRUOUT = 49 * MiB, WS_W_DN1 = 51 * MiB;
constexpr size_t WS_ACT = 57 * MiB, ACT_SLOT = 33 * MiB;
constexpr int CW_BAR = 4096;
constexpr int STAGE_BYTES = 131072;
constexpr int EPI_OFF = STAGE_BYTES;
constexpr int MISC_OFF = STAGE_BYTES + 12288;
constexpr int LDS_BYTES = 147456;

#define LDS_WAIT() asm volatile("s_waitcnt lgkmcnt(0)" ::: "memory")
#define VM_WAIT() asm volatile("s_waitcnt vmcnt(0)" ::: "memory")
__device__ __forceinline__ unsigned f2bf(float f) { unsigned u = __builtin_bit_cast(unsigned, f); return (u + 0x7fffu + ((u >> 16) & 1u)) >> 16; }
__device__ __forceinline__ unsigned pk2(float lo, float hi) { return f2bf(lo) | (f2bf(hi) << 16); }
__device__ __forceinline__ float bf2f(unsigned short h) { return __builtin_bit_cast(float, (unsigned)h << 16); }
__device__ __forceinline__ float bflo(unsigned w) { return __builtin_bit_cast(float, w << 16); }
__device__ __forceinline__ float bfhi(unsigned w) { return __builtin_bit_cast(float, w & 0xffff0000u); }
__device__ __forceinline__ float fsigmoid(float x) { return __builtin_amdgcn_rcpf(1.f + __expf(-x)); }
__device__ __forceinline__ float fsilu(float x) { return x * fsigmoid(x); }
__device__ __forceinline__ float fgelu_tanh(float x) { const float u = 0.7978845608028654f * (x + 0.044715f * x * x * x); const float e = __expf(2.f * u); return x * (1.f - __builtin_amdgcn_rcpf(e + 1.f)); }
__device__ __forceinline__ int lane_id_v() { int le; asm volatile("v_mbcnt_lo_u32_b32 %0, -1, 0\n\tv_mbcnt_hi_u32_b32 %0, -1, %0" : "=v"(le)); return le; }
__device__ __forceinline__ float wave_sum(float v) {
#pragma unroll
    for (int o = 1; o < 64; o <<= 1) v += __shfl_xor(v, o);
    return v;
}

#define XB_TMO      128
#define XB_XCNT(j)  (256  + 64 * (j))
#define XB_XSUB(j)  (1280 + 64 * (j))
#define XB_XGEN(j)  (2304 + 64 * (j))
#define XB_TOP      3328
#define XB_TOPGEN   3392
#define XCD_BAR_WORDS 3456
#define XB_SPIN_CAP (1u << 20)
__device__ __forceinline__ unsigned xb_ld(unsigned* p)              { return __hip_atomic_load(p, __ATOMIC_RELAXED, __HIP_MEMORY_SCOPE_AGENT); }
__device__ __forceinline__ unsigned xb_add(unsigned* p, unsigned v) { return __hip_atomic_fetch_add(p, v, __ATOMIC_RELAXED, __HIP_MEMORY_SCOPE_AGENT); }
__device__ __forceinline__ unsigned xb_xcc_id() { return (unsigned)__builtin_amdgcn_s_getreg((3 << 11) | 20) & 0xFu; }
#define XB_SPIN(cond, bar) do { unsigned _sp = 0; while (cond) { __builtin_amdgcn_s_sleep(1); \
    if ((++_sp & 255u) == 0u) { if (xb_ld(&(bar)[XB_TMO])) break; if (_sp > XB_SPIN_CAP) { atomicAdd(&(bar)[XB_TMO], 1u); break; } } } } while (0)
struct XcdBarrier { unsigned* bar; unsigned x; volatile LAS unsigned* st; };
__device__ __forceinline__ XcdBarrier xcd_barrier_post(unsigned* bar, volatile LAS unsigned* st) {
    XcdBarrier b; b.bar = bar; b.x = xb_xcc_id(); b.st = st;
    if (threadIdx.x == 0) (void)xb_add(&bar[XB_XCNT(b.x)], 1u);
    return b;
}
__device__ __forceinline__ void xcd_barrier_complete(unsigned* bar, unsigned x, unsigned& nloc, unsigned& nx) {
    const unsigned G = gridDim.x * gridDim.y * gridDim.z;
    unsigned sum, cnt, mine, sp = 0u;
    for (;;) {
        sum = 0u; cnt = 0u; mine = 0u;
#pragma unroll
        for (unsigned j = 0; j < 16; ++j) { const unsigned c = xb_ld(&bar[XB_XCNT(j)]); sum += c; cnt += (c > 0u) ? 1u : 0u; mine = (j == x) ? c : mine; }
        if (sum == G) break;
        __builtin_amdgcn_s_sleep(1);
        if ((++sp & 255u) == 0u) { if (xb_ld(&bar[XB_TMO])) break; if (sp > XB_SPIN_CAP) { atomicAdd(&bar[XB_TMO], 1u); break; } }
    }
    nloc = mine > 0u ? mine : 1u; nx = cnt > 0u ? cnt : 1u;
}
__device__ __forceinline__ void xcd_barrier(const XcdBarrier& b, int wave_s) {
    asm volatile("s_waitcnt vmcnt(0)" ::: "memory");
    __syncthreads();
    if (wave_s == 0 && lane_id_v() == 0) {
        unsigned* bar = b.bar;
        __builtin_amdgcn_s_waitcnt(0);
        unsigned nloc = b.st[0], nx = b.st[1];
        if (nloc == 0u) { xcd_barrier_complete(bar, b.x, nloc, nx); b.st[0] = nloc; b.st[1] = nx; }
        const unsigned old = xb_add(&bar[XB_XSUB(b.x)], 1u);
        const unsigned gen = old / nloc;
        if (old + 1u == (gen + 1u) * nloc) {
            __builtin_amdgcn_fence(__ATOMIC_RELEASE, "agent");
            asm volatile("s_waitcnt vmcnt(0)" ::: "memory");
            const unsigned og = xb_add(&bar[XB_TOP], 1u);
            const unsigned tg = og / nx;
            if (og + 1u == (tg + 1u) * nx) xb_add(&bar[XB_TOPGEN], 1u);
            else XB_SPIN(xb_ld(&bar[XB_TOPGEN]) == tg, bar);
            __builtin_amdgcn_fence(__ATOMIC_ACQUIRE, "agent");
            xb_add(&bar[XB_XGEN(b.x)], 1u);
            asm volatile("s_waitcnt vmcnt(0)" ::: "memory");
        } else {
            XB_SPIN(xb_ld(&bar[XB_XGEN(b.x)]) == gen, bar);
            __builtin_amdgcn_fence(__ATOMIC_ACQUIRE, "agent");
            asm volatile("s_waitcnt vmcnt(0)" ::: "memory");
        }
    }
    __syncthreads();
}

constexpr int BM = 256, BK = 64, HALF = 128, HTB = HALF * BK * 2, NXCD = 8, WGM = 8;
__host__ __device__ __forceinline__ int lds_byte(int r, int c) { const int st = (r >> 4) * 2 + (c >> 5), rr = r & 15, cc = c & 31, ob = rr * 64 + cc * 2; return st * 1024 + (ob ^ (((ob >> 9) & 1) << 5)); }
__host__ __device__ __forceinline__ void stage_rc(int b, int& R, int& C) { const int st = b / 1024, sb = b % 1024, swz = sb ^ (((sb >> 9) & 1) << 5); R = (st >> 1) * 16 + swz / 64; C = (st & 1) * 32 + (swz % 64) / 2; }
struct Unit { int pm, pn; };
struct Gemm { const bf16_t* A; const bf16_t* Bt; int lda, ldb, K; int acol_shift, acol_step; int ksplit; };
struct StaticOrder {
    int nM, nN, nwg, G, c, pm_off;
    __device__ __forceinline__ void init(int nM_, int nN_, int G_, int c_, int pm_off_ = 0) { nM = nM_; nN = nN_; nwg = nM * nN; G = G_; c = c_; pm_off = pm_off_; }
    __device__ __forceinline__ bool next(int i, Unit& u) const {
        const long L = (long)i * G + c; if (L >= nwg) return false;
        int wgid = (int)L; { const int q = nwg / NXCD, r = nwg % NXCD, xcd = wgid % NXCD, off = wgid / NXCD; wgid = (xcd < r ? xcd * (q + 1) : r * (q + 1) + (xcd - r) * q) + off; }
        const int nig = WGM * nN, gid = wgid / nig, fm = gid * WGM, gsz = (nM - fm) < WGM ? (nM - fm) : WGM;
        u.pm = pm_off + fm + ((wgid % nig) % gsz); u.pn = (wgid % nig) / gsz; return true;
    }
};
typedef __bf16 bf16x2_t __attribute__((ext_vector_type(2)));
__device__ __forceinline__ unsigned cvt_pk_bf16(float lo, float hi) { f32x2 v = {lo, hi}; bf16x2_t b = __builtin_convertvector(v, bf16x2_t); return __builtin_bit_cast(unsigned, b); }

template <class Epi>
__device__ __forceinline__ void gemm_phase(LAS unsigned char* lds, const Gemm g, const StaticOrder& S, const Epi& E, int wave_s) {
    const int wid = wave_s, lane = lane_id_v(), tid = wid * 64 + lane, wr = wid >> 2, wc = wid & 3, fr = lane & 15, fq = lane >> 4;
    const int K = g.K, nt = K / BK;
    unsigned voffA[2], voffB[2];
#pragma unroll
    for (int i = 0; i < 2; ++i) { int R, C; stage_rc(tid * 16 + i * 8192, R, C); voffA[i] = (unsigned)(R * g.lda + C) * 2u; voffB[i] = (unsigned)(R * g.ldb + C) * 2u; }
    const size_t kstep = (size_t)(BK * 2);
    const size_t hstepA = (size_t)HALF * g.lda * 2, hstepB = (size_t)HALF * g.ldb * 2;
    const size_t tstepA = 2 * hstepA, tstepB = 2 * hstepB;
    const unsigned ldsw = (unsigned)wid * 1024u;
    const int aoff = lds_byte(wr * 64 + fr, fq * 8), boff = lds_byte(wc * 32 + fr, fq * 8);
#define PG8_SA(b, h) (((b) * 2 + (h)) * HTB)
#define PG8_SB(b, h) ((4 + (b) * 2 + (h)) * HTB)
#define PG8_STAGE(bufoff, gbase, voff) do { _Pragma("unroll") for (int _i = 0; _i < 2; ++_i) \
        __builtin_amdgcn_global_load_lds((const unsigned*)((const char*)(gbase) + (voff)[_i]), (LAS unsigned*)(lds + (bufoff) + ldsw + _i * 8192), 16, 0, 0); } while (0)
#define PG8_LDA(dst, b, h) do { _Pragma("unroll") for (int m = 0; m < 4; ++m) _Pragma("unroll") for (int k = 0; k < 2; ++k) dst[m][k] = *(const LAS bf16x8*)(lds + PG8_SA(b, h) + aoff + m * 2048 + k * 1024); } while (0)
#define PG8_LDB(dst, b, h) do { _Pragma("unroll") for (int n = 0; n < 2; ++n) _Pragma("unroll") for (int k = 0; k < 2; ++k) dst[n][k] = *(const LAS bf16x8*)(lds + PG8_SB(b, h) + boff + n * 2048 + k * 1024); } while (0)
#define PG8_MMA(ai, bj, At, Bt) do { __builtin_amdgcn_s_setprio(1); _Pragma("unroll") for (int m = 0; m < 4; ++m) _Pragma("unroll") for (int n = 0; n < 2; ++n) _Pragma("unroll") for (int k = 0; k < 2; ++k) \
        acc[ai][bj][m][n] = __builtin_amdgcn_mfma_f32_16x16x32_bf16(Bt[n][k], At[m][k], acc[ai][bj][m][n], 0, 0, 0); __builtin_amdgcn_s_setprio(0); } while (0)
#define PG8_WAIT_V(n) asm volatile("s_waitcnt vmcnt(" #n ")" ::: "memory")
#define PG8_WAIT_L(n) asm volatile("s_waitcnt lgkmcnt(" #n ")" ::: "memory")
#define PG8_BAR __builtin_amdgcn_s_barrier()
#define PG8_SCHED __builtin_amdgcn_sched_barrier(0)
    Unit cur, nxt; int ui = 0;
    if (!S.next(0, cur)) return;
    f32x4 acc[2][2][4][2];
#pragma unroll
    for (int a = 0; a < 2; ++a)
#pragma unroll
        for (int b = 0; b < 2; ++b)
#pragma unroll
            for (int m = 0; m < 4; ++m)
#pragma unroll
                for (int n = 0; n < 2; ++n) acc[a][b][m][n] = (f32x4){0.f, 0.f, 0.f, 0.f};
    bf16x8 At[4][2], B0[2][2], B1[2][2];
#define PG8_UA(u_) ((const char*)g.A + (size_t)(u_).pm * tstepA + (size_t)(((u_).pn >> g.acol_shift) * g.acol_step + ((u_).pn % g.ksplit) * (g.ksplit > 1 ? g.K : 0)) * 2)
#define PG8_UB(u_) ((const char*)g.Bt + (size_t)((u_).pn / g.ksplit) * tstepB + (size_t)(((u_).pn % g.ksplit) * (g.ksplit > 1 ? g.K : 0)) * 2)
    const char* cA = PG8_UA(cur); const char* cB = PG8_UB(cur);
    {
        PG8_STAGE(PG8_SB(0, 0), cB, voffB); PG8_STAGE(PG8_SB(0, 1), cB + hstepB, voffB); PG8_STAGE(PG8_SA(0, 0), cA, voffA); PG8_STAGE(PG8_SA(0, 1), cA + hstepA, voffA);
        if (wr == 1) PG8_BAR;
        PG8_WAIT_V(2); PG8_BAR;
        PG8_STAGE(PG8_SB(1, 0), cB + kstep, voffB); PG8_STAGE(PG8_SA(1, 0), cA + kstep, voffA); PG8_STAGE(PG8_SB(1, 1), cB + hstepB + kstep, voffB);
        PG8_WAIT_V(6); PG8_BAR;
    }
    for (;;) {
        const bool has_next = S.next(ui + 1, nxt);
        const char* nA = has_next ? PG8_UA(nxt) : cA; const char* nB = has_next ? PG8_UB(nxt) : cB;
#pragma unroll 1
        for (int t = 0; t < nt; t += 2) {
            const bool last = (t == nt - 2);
            const char* a1 = cA + (size_t)(t + 1) * kstep;
            const char* a2 = last ? nA : cA + (size_t)(t + 2) * kstep; const char* b2 = last ? nB : cB + (size_t)(t + 2) * kstep;
            const char* a3 = a2 + kstep; const char* b3 = b2 + kstep;
            PG8_LDB(B0, 0, 0); PG8_LDB(B1, 0, 1); PG8_SCHED; PG8_LDA(At, 0, 0); PG8_STAGE(PG8_SA(1, 1), a1 + hstepA, voffA);
            PG8_WAIT_V(8); PG8_WAIT_L(0); PG8_BAR; PG8_MMA(0, 0, At, B0); PG8_MMA(0, 1, At, B1); PG8_BAR; PG8_SCHED;
            PG8_LDA(At, 0, 1); PG8_STAGE(PG8_SB(0, 0), b2, voffB); PG8_STAGE(PG8_SB(0, 1), b2 + hstepB, voffB); PG8_STAGE(PG8_SA(0, 0), a2, voffA);
            PG8_WAIT_V(8); PG8_WAIT_L(0); PG8_BAR; PG8_MMA(1, 0, At, B0); PG8_MMA(1, 1, At, B1); PG8_BAR; PG8_SCHED;
            PG8_LDB(B0, 1, 0); PG8_LDB(B1, 1, 1); PG8_SCHED; PG8_LDA(At, 1, 0); PG8_STAGE(PG8_SA(0, 1), a2 + hstepA, voffA);
            PG8_WAIT_V(8); PG8_WAIT_L(0); PG8_BAR; PG8_MMA(0, 0, At, B0); PG8_MMA(0, 1, At, B1); PG8_BAR; PG8_SCHED;
            PG8_LDA(At, 1, 1); PG8_STAGE(PG8_SB(1, 0), b3, voffB); PG8_STAGE(PG8_SB(1, 1), b3 + hstepB, voffB); PG8_STAGE(PG8_SA(1, 0), a3, voffA);
            PG8_WAIT_V(8); PG8_WAIT_L(0); PG8_BAR; PG8_MMA(1, 0, At, B0); PG8_MMA(1, 1, At, B1); PG8_BAR; PG8_SCHED;
        }
        if (wr == 0) PG8_BAR;
        { const int le = lane_id_v();
          E(acc, cur, wr, wc, le & 15, le >> 4, lds + EPI_OFF, wid, le); }
        if (!has_next) break;
#pragma unroll
        for (int a = 0; a < 2; ++a)
#pragma unroll
            for (int b = 0; b < 2; ++b)
#pragma unroll
                for (int m = 0; m < 4; ++m)
#pragma unroll
                    for (int n = 0; n < 2; ++n) acc[a][b][m][n] = (f32x4){0.f, 0.f, 0.f, 0.f};
        cur = nxt; cA = nA; cB = nB; ++ui;
        if (wr == 1) PG8_BAR;
    }
    PG8_WAIT_V(0);
    PG8_BAR;
#undef PG8_UA
#undef PG8_UB
#undef PG8_SA
#undef PG8_SB
#undef PG8_STAGE
#undef PG8_LDA
#undef PG8_LDB
#undef PG8_MMA
#undef PG8_WAIT_V
#undef PG8_WAIT_L
#undef PG8_SCHED
}
#define MK_BAR __builtin_amdgcn_s_barrier()
#define MK_DPP(oldv, src, ctrl) __builtin_bit_cast(float, __builtin_amdgcn_update_dpp(__builtin_bit_cast(int, (float)(oldv)), __builtin_bit_cast(int, (float)(src)), ctrl, 0xF, 0xF, false))

__device__ __forceinline__ int mod_variant(int pm) { return pm < 32 ? 0 : (pm < 64 ? 1 : 2); }

struct EpiResid {
    const float* baseL; const float* baseC; float* outL; float* outC; const float* mod; int gate_off;
    __device__ __forceinline__ void operator()(const f32x4 (&acc)[2][2][4][2], const Unit& u, int wr, int wc, int fr, int fq, LAS unsigned char*, int, int) const {
        const int v = mod_variant(u.pm);
        const float* gate = mod + v * 6144 + gate_off;
        const float* base = u.pm < 64 ? baseL + (size_t)u.pm * 256 * 1024 : baseC + (size_t)(u.pm - 64) * 256 * 1024;
        float* out = u.pm < 64 ? outL + (size_t)u.pm * 256 * 1024 : outC + (size_t)(u.pm - 64) * 256 * 1024;
        const int col0 = u.pn * BM + wc * 32 + 4 * fq;
        f32x4 gv[2][2];
#pragma unroll
        for (int bj = 0; bj < 2; ++bj)
#pragma unroll
            for (int n = 0; n < 2; ++n) gv[bj][n] = *(const f32x4*)(gate + col0 + bj * HALF + n * 16);
#pragma unroll
        for (int ai = 0; ai < 2; ++ai)
#pragma unroll
            for (int m = 0; m < 4; ++m) { const size_t off = (size_t)(ai * HALF + wr * 64 + m * 16 + fr) * 1024 + col0;
#pragma unroll
                for (int bj = 0; bj < 2; ++bj)
#pragma unroll
                    for (int n = 0; n < 2; ++n) { const f32x4 bs = *(const f32x4*)(base + off + bj * HALF + n * 16); *(f32x4*)(out + off + bj * HALF + n * 16) = bs + gv[bj][n] * acc[ai][bj][m][n]; } }
    }
};


struct EpiSlab {
    float* slab; const float* mod; int gate_off; int ksplit;
    __device__ __forceinline__ void operator()(const f32x4 (&acc)[2][2][4][2], const Unit& u, int wr, int wc, int fr, int fq, LAS unsigned char*, int, int) const {
        const float* gate = mod + 2 * 6144 + gate_off;
        float* out = slab + ((size_t)(u.pn % ksplit) * 512 + (size_t)(u.pm - 64) * 256) * 1024;
        const int col0 = (u.pn / ksplit) * BM + wc * 32 + 4 * fq;
#pragma unroll
        for (int bj = 0; bj < 2; ++bj)
#pragma unroll
            for (int n = 0; n < 2; ++n) { const f32x4 gv = *(const f32x4*)(gate + col0 + bj * HALF + n * 16);
#pragma unroll
                for (int ai = 0; ai < 2; ++ai)
#pragma unroll
                    for (int m = 0; m < 4; ++m) *(f32x4*)(out + (size_t)(ai * HALF + wr * 64 + m * 16 + fr) * 1024 + col0 + bj * HALF + n * 16) = gv * acc[ai][bj][m][n]; }
    }
};

struct EpiHgIn {
    bf16_t *QmF, *KmF, *QmB, *KmB, *V, *SG; float* side; const float* lb;
    __device__ __forceinline__ void operator()(const f32x4 (&acc)[2][2][4][2], const Unit& u, int wr, int wc, int fr, int fq, LAS unsigned char*, int, int) const {
        const int row0 = u.pm * BM + wr * 64 + fr;
        if (u.pn >= 16) {
            const int col0 = (u.pn - 16) * BM + wc * 32 + 8 * fq;
#pragma unroll
            for (int ai = 0; ai < 2; ++ai)
#pragma unroll
                for (int m = 0; m < 4; ++m) { char* rowp = (char*)SG + (unsigned)(((row0 + ai * HALF + m * 16) * 1024 + col0) * 2);
#pragma unroll
                    for (int bj = 0; bj < 2; ++bj) { f32x4 v0 = acc[ai][bj][m][0], v1 = acc[ai][bj][m][1]; asm volatile("" : "+v"(v0), "+v"(v1)); u32x4 w;
                        w.x = cvt_pk_bf16(fsilu(v0[0]), fsilu(v0[1])); w.y = cvt_pk_bf16(fsilu(v0[2]), fsilu(v0[3])); w.z = cvt_pk_bf16(fsilu(v1[0]), fsilu(v1[1])); w.w = cvt_pk_bf16(fsilu(v1[2]), fsilu(v1[3]));
                        *(u32x4*)(rowp + bj * HALF * 2) = w; }
                    asm volatile("" ::: "memory"); }
            return;
        }
        const int c0 = 64 * u.pn + 16 * wc + 4 * fq;
        const f32x4 lbf = *(const f32x4*)(lb + c0), lbb = *(const f32x4*)(lb + 1024 + c0);
#pragma unroll
        for (int ai = 0; ai < 2; ++ai) {
            const int ck = u.pm * 4 + ai * 2 + wr;
#pragma unroll
            for (int m = 0; m < 4; ++m) { const f32x4 vv = acc[ai][1][m][1]; u32x2 w; w.x = cvt_pk_bf16(vv[0], vv[1]); w.y = cvt_pk_bf16(vv[2], vv[3]);
                *(u32x2*)((char*)V + (unsigned)(((row0 + ai * HALF + m * 16) * 1024 + c0) * 2)) = w; }
#pragma unroll
            for (int d = 0; d < 2; ++d) {
                const f32x4 lbv = d ? lbb : lbf;
                float db[4][4];
                float* sp = (float*)((char*)side + (unsigned)((((ck * 2 + d) * 3) * 1024 + c0) * 4));
#pragma unroll
                for (int j = 0; j < 4; ++j) {
                    float lf[4], bs[4];
#pragma unroll
                    for (int m = 0; m < 4; ++m) { const float z = d ? acc[ai][1][m][0][j] : acc[ai][0][m][1][j]; lf[m] = __logf(lbv[j] + (1.f - lbv[j]) * fsigmoid(z)); }
                    float tot0, bmid;
                    if (d == 0) {
#pragma unroll
                        for (int m = 0; m < 4; ++m) { float x = lf[m];
                            if (m > 0) { const float c = MK_DPP(0.f, bs[m - 1], 0x121); if (fr == 0) x += c; }
                            x += MK_DPP(0.f, x, 0x111); x += MK_DPP(0.f, x, 0x112); x += MK_DPP(0.f, x, 0x114); x += MK_DPP(0.f, x, 0x118); bs[m] = x; }
                        tot0 = MK_DPP(0.f, bs[3], 0x121);
                        bmid = __shfl(bs[2], 0, 16);
                    } else {
#pragma unroll
                        for (int mm = 0; mm < 4; ++mm) { const int m = 3 - mm; float x = lf[m];
                            if (m < 3) { const float c = MK_DPP(0.f, bs[m + 1], 0x12F); if (fr == 15) x += c; }
                            x += MK_DPP(0.f, x, 0x101); x += MK_DPP(0.f, x, 0x102); x += MK_DPP(0.f, x, 0x104); x += MK_DPP(0.f, x, 0x108); bs[m] = x; }
                        tot0 = bs[0];
                        bmid = __shfl(bs[1], 15, 16); }
#pragma unroll
                    for (int m = 0; m < 4; ++m) db[m][j] = bs[m] - bmid;
                    if (fr == 0) { sp[j] = __expf(bmid); sp[1024 + j] = __expf(tot0 - bmid); sp[2048 + j] = __expf(tot0); }
                }
                bf16_t* Qd = d ? QmB : QmF; bf16_t* Kd = d ? KmB : KmF;
#pragma unroll
                for (int m = 0; m < 4; ++m) { const f32x4 qz = acc[ai][0][m][0]; const f32x4 z = d ? acc[ai][1][m][0] : acc[ai][0][m][1]; float qo[4], ko[4];
#pragma unroll
                    for (int j = 0; j < 4; ++j) { const float kv = (1.f - lbv[j]) * (1.f - fsigmoid(z[j])); qo[j] = fsilu(qz[j]) * __expf(db[m][j]); ko[j] = kv * __expf(-db[m][j]); }
                    const unsigned off = (unsigned)(((row0 + ai * HALF + m * 16) * 1024 + c0) * 2);
                    u32x2 w; w.x = cvt_pk_bf16(qo[0], qo[1]); w.y = cvt_pk_bf16(qo[2], qo[3]); *(u32x2*)((char*)Qd + off) = w;
                    w.x = cvt_pk_bf16(ko[0], ko[1]); w.y = cvt_pk_bf16(ko[2], ko[3]); *(u32x2*)((char*)Kd + off) = w;
                    asm volatile("" ::: "memory"); }
            }
        }
    }
};


__device__ __forceinline__ float dpp_f(float oldv, float src, const int ctrl_sel) {
    const int o = __builtin_bit_cast(int, oldv), x = __builtin_bit_cast(int, src); int r;
    if (ctrl_sel == 0) r = __builtin_amdgcn_update_dpp(o, x, 0x111, 0xF, 0xF, false);
    else if (ctrl_sel == 1) r = __builtin_amdgcn_update_dpp(o, x, 0x101, 0xF, 0xF, false);
    else if (ctrl_sel == 2) r = __builtin_amdgcn_update_dpp(o, x, 0x121, 0xF, 0xF, false);
    else r = __builtin_amdgcn_update_dpp(o, x, 0x12F, 0xF, 0xF, false);
    return __builtin_bit_cast(float, r);
}
struct EpiUpConv {
    bf16_t* G; bf16_t* uedge; const float* cw; const float* cb;
    __device__ __forceinline__ void operator()(const f32x4 (&acc)[2][2][4][2], const Unit& u, int wr, int wc, int fr, int fq, LAS unsigned char* epi, int, int) const {
        LAS float* EX = (LAS float*)epi;
        const int colb = 32 * wc + 4 * fq;
        const int ch0 = 128 * u.pn + 32 * wc + 8 * fq;
#pragma unroll
        for (int ai = 0; ai < 2; ++ai) { const int g = 2 * ai + wr;
#pragma unroll
            for (int bj = 0; bj < 2; ++bj)
#pragma unroll
                for (int n = 0; n < 2; ++n) {
                    if (fr == 0) *(LAS f32x4*)(EX + (g * 2 + 0) * 256 + 128 * bj + 16 * n + colb) = acc[ai][bj][0][n];
                    if (fr == 15) *(LAS f32x4*)(EX + (g * 2 + 1) * 256 + 128 * bj + 16 * n + colb) = acc[ai][bj][3][n];
                } }
        {
            const bool lo = (wr == 0) && (fr < 2), hi = (wr == 1) && (fr >= 14);
            if (lo || hi) { const int slot = lo ? fr : (fr - 12); bf16_t* ue = uedge + ((size_t)u.pm * 4 + slot) * 5632 + ch0;
#pragma unroll
                for (int bj = 0; bj < 2; ++bj)
#pragma unroll
                    for (int n = 0; n < 2; ++n) { const f32x4 x = lo ? acc[0][bj][0][n] : acc[1][bj][3][n]; u32x2 w; w.x = cvt_pk_bf16(x[0], x[1]); w.y = cvt_pk_bf16(x[2], x[3]); *(u32x2*)(ue + bj * 2816 + 4 * n) = w; } }
        }
        LDS_WAIT(); MK_BAR; asm volatile("" ::: "memory");
#pragma unroll
        for (int n = 0; n < 2; ++n) {
            f32x4 wg[4], wv[4];
#pragma unroll
            for (int k = 0; k < 3; ++k) { wg[k] = *(const f32x4*)(cw + k * 5632 + ch0 + 4 * n); wv[k] = *(const f32x4*)(cw + k * 5632 + 2816 + ch0 + 4 * n); }
            wg[3] = *(const f32x4*)(cb + ch0 + 4 * n); wv[3] = *(const f32x4*)(cb + 2816 + ch0 + 4 * n);
#pragma unroll
            for (int ai = 0; ai < 2; ++ai) { const int g = 2 * ai + wr;
                f32x4 pe[2], ne[2];
#pragma unroll
                for (int bj = 0; bj < 2; ++bj) {
                    pe[bj] = (g > 0) ? *(const LAS f32x4*)(EX + ((g - 1) * 2 + 1) * 256 + 128 * bj + 16 * n + colb) : (f32x4){0.f, 0.f, 0.f, 0.f};
                    ne[bj] = (g < 3) ? *(const LAS f32x4*)(EX + ((g + 1) * 2 + 0) * 256 + 128 * bj + 16 * n + colb) : (f32x4){0.f, 0.f, 0.f, 0.f}; }
#pragma unroll
                for (int m = 0; m < 4; ++m) {
                    f32x4 cv2[2];
#pragma unroll
                    for (int bj = 0; bj < 2; ++bj) { const f32x4 x = acc[ai][bj][m][n]; const f32x4* wt = bj ? wv : wg; f32x4 c;
#pragma unroll
                        for (int j = 0; j < 4; ++j) {
                            const float pold = (m > 0) ? dpp_f(0.f, acc[ai][bj][m > 0 ? m - 1 : 0][n][j], 2) : pe[bj][j];
                            const float nold = (m < 3) ? dpp_f(0.f, acc[ai][bj][m < 3 ? m + 1 : 3][n][j], 3) : ne[bj][j];
                            const float pv = dpp_f(pold, x[j], 0), nv = dpp_f(nold, x[j], 1);
                            c[j] = wt[3][j] + wt[0][j] * pv + wt[1][j] * x[j] + wt[2][j] * nv; }
                        cv2[bj] = c; }
                    u32x2 w; w.x = cvt_pk_bf16(fsilu(cv2[0][0]) * cv2[1][0], fsilu(cv2[0][1]) * cv2[1][1]); w.y = cvt_pk_bf16(fsilu(cv2[0][2]) * cv2[1][2], fsilu(cv2[0][3]) * cv2[1][3]);
                    *(u32x2*)((char*)G + (unsigned)(((u.pm * 256 + ai * HALF + wr * 64 + m * 16 + fr) * 2816 + ch0 + 4 * n) * 2)) = w;
                    asm volatile("" ::: "memory");
                }
            }
        }
        LDS_WAIT(); MK_BAR; asm volatile("" ::: "memory");
    }
};
__device__ __forceinline__ void ffn_fix_edges(int tid, int pm, bf16_t* G, const bf16_t* uedge, const float* cw, const float* cb) {
    const bool sstart = (pm == 0) || (pm == 32) || (pm >= 64), send = (pm == 31) || (pm == 63) || (pm >= 64);
    for (int idx = tid; idx < 2 * 2816; idx += NTHR) {
        const int which = idx >= 2816, ch = idx - which * 2816;
        const bf16_t* UE = uedge + (size_t)pm * 4 * 5632;
        float cg = 0.f, cvv = 0.f;
#pragma unroll
        for (int half = 0; half < 2; ++half) { const int col = half * 2816 + ch; float pv, cu, nv;
            if (which == 0) { pv = sstart ? 0.f : bf2f(uedge[((size_t)(pm - 1) * 4 + 3) * 5632 + col]); cu = bf2f(UE[col]); nv = bf2f(UE[5632 + col]); }
            else { pv = bf2f(UE[2 * 5632 + col]); cu = bf2f(UE[3 * 5632 + col]); nv = send ? 0.f : bf2f(uedge[((size_t)(pm + 1) * 4) * 5632 + col]); }
            const float c = cb[col] + cw[col] * pv + cw[5632 + col] * cu + cw[2 * 5632 + col] * nv;
            if (half == 0) cg = c; else cvv = c; }
        G[(size_t)(pm * 256 + (which ? 255 : 0)) * 2816 + ch] = (bf16_t)f2bf(fsilu(cg) * cvv);
    }
}

constexpr int SC_QS = 272, SC_KS = 288;
constexpr int SC_QOFF = 0, SC_KOFF = 64 * SC_QS, SC_VOFF = SC_KOFF + 64 * SC_KS, SC_BUF = SC_VOFF + 64 * SC_KS;
constexpr int SC_POFF = 2 * SC_BUF, SC_PS = 144, SC_SIDE = SC_POFF + 64 * SC_PS;
__device__ __forceinline__ s16x4 ds_tr(const LAS unsigned char* p) { typedef short v4i16_t __attribute__((ext_vector_type(4))); return __builtin_bit_cast(s16x4, __builtin_amdgcn_ds_read_tr16_b64_v4i16((LAS v4i16_t*)p)); }
__device__ __forceinline__ bf16x8 cat8(s16x4 a, s16x4 b) { return (bf16x8){a[0], a[1], a[2], a[3], b[0], b[1], b[2], b[3]}; }

template <bool OUTPUT>
__device__ __forceinline__ void hgrn_segment(LAS unsigned char* lds, bf16_t* Qd, const bf16_t* Kd, const bf16_t* Vt, const float* side, float* sseg, float* dseg,
                                             int chain, int seg, int wave_s) {
    const int b = chain >> 4, h = (chain >> 1) & 7, d = chain & 1;
    const int w = wave_s, lane = lane_id_v(), tid = w * 64 + lane, l15 = lane & 15, G = lane >> 4;
    const int s_begin = seg == 0 ? 0 : 4 + 16 * seg, s_end = 20 + 16 * seg;
#define SC_CHUNK_ROW(s_) (((s_) < 4) ? (ML + b * 256 + 64 * (d ? (3 - (s_)) : (s_))) : (b * 8192 + 64 * (d ? (127 - ((s_) - 4)) : ((s_) - 4))))
    u32x4 sq0, sq1, sk0, sk1, sv0, sv1; f32x4 ssd = (f32x4){0.f, 0.f, 0.f, 0.f};
    const int st_r0 = tid >> 4, st_c = tid & 15, st_r1 = st_r0 + 32;
#define SC_STAGE_LOAD(s_) do { const int rb_ = SC_CHUNK_ROW(s_); \
        const size_t g0_ = (size_t)(rb_ + st_r0) * 1024 + h * 128 + st_c * 8, g1_ = (size_t)(rb_ + st_r1) * 1024 + h * 128 + st_c * 8; \
        if (OUTPUT) { sq0 = *(const u32x4*)(Qd + g0_); sq1 = *(const u32x4*)(Qd + g1_); } \
        sk0 = *(const u32x4*)(Kd + g0_); sv0 = *(const u32x4*)(Vt + g0_); sk1 = *(const u32x4*)(Kd + g1_); sv1 = *(const u32x4*)(Vt + g1_); \
        if (tid < 96) { const int ck_ = rb_ >> 6; ssd = *(const f32x4*)(side + ((size_t)(ck_ * 2 + d) * 3 + (tid >> 5)) * 1024 + h * 128 + (tid & 31) * 4); } } while (0)
#define SC_STAGE_STORE(buf_) do { LAS unsigned char* B_ = lds + (buf_) * SC_BUF; \
        if (OUTPUT) { *(LAS u32x4*)(B_ + SC_QOFF + st_r0 * SC_QS + st_c * 16) = sq0; *(LAS u32x4*)(B_ + SC_QOFF + st_r1 * SC_QS + st_c * 16) = sq1; } \
        *(LAS u32x4*)(B_ + SC_KOFF + st_r0 * SC_KS + st_c * 16) = sk0; *(LAS u32x4*)(B_ + SC_VOFF + st_r0 * SC_KS + st_c * 16) = sv0; \
        *(LAS u32x4*)(B_ + SC_KOFF + st_r1 * SC_KS + st_c * 16) = sk1; *(LAS u32x4*)(B_ + SC_VOFF + st_r1 * SC_KS + st_c * 16) = sv1; \
        if (tid < 96) *(LAS f32x4*)(lds + SC_SIDE + (buf_) * 1536 + tid * 16) = ssd; } while (0)
    SC_STAGE_LOAD(s_begin);
    f32x4 S[8], Dp[8];
#pragma unroll
    for (int i = 0; i < 8; ++i) { S[i] = (f32x4){0.f, 0.f, 0.f, 0.f}; Dp[i] = (f32x4){1.f, 1.f, 1.f, 1.f}; }
    if (OUTPUT) {
        for (int j = 0; j < seg; ++j) { const float* sp = sseg + ((size_t)(chain * 8 + j) * 64 + w * 8) * 256 + lane * 4; const float* dp = dseg + (size_t)(chain * 8 + j) * 128 + 4 * G;
#pragma unroll
            for (int i = 0; i < 8; ++i) { const f32x4 sv = *(const f32x4*)(sp + i * 256), dv = *(const f32x4*)(dp + 16 * i); S[i] = dv * S[i] + sv; } }
    }
    SC_STAGE_STORE(0);
    LDS_WAIT(); __syncthreads();
    const int ti = w >> 1, tj0 = (w & 1) * 2;
    for (int s = s_begin; s < s_end; ++s) {
        const int cur = (s - s_begin) & 1;
        const LAS unsigned char* Bq = lds + cur * SC_BUF + SC_QOFF; const LAS unsigned char* Bk = lds + cur * SC_BUF + SC_KOFF; const LAS unsigned char* Bv = lds + cur * SC_BUF + SC_VOFF;
        const LAS float* sd = (const LAS float*)(lds + SC_SIDE + cur * 1536);
        if (s + 1 < s_end) SC_STAGE_LOAD(s + 1);
        bf16x8 Sp[4];
        if (OUTPUT) {
            f32x4 p0 = (f32x4){0.f, 0.f, 0.f, 0.f}, p1 = p0;
#pragma unroll
            for (int ks = 0; ks < 4; ++ks) {
                const bf16x8 bq = *(const LAS bf16x8*)(Bq + (16 * ti + l15) * SC_QS + (32 * ks + 8 * G) * 2);
                const bf16x8 a0 = *(const LAS bf16x8*)(Bk + (16 * tj0 + l15) * SC_KS + (32 * ks + 8 * G) * 2);
                const bf16x8 a1 = *(const LAS bf16x8*)(Bk + (16 * (tj0 + 1) + l15) * SC_KS + (32 * ks + 8 * G) * 2);
                p0 = __builtin_amdgcn_mfma_f32_16x16x32_bf16(a0, bq, p0, 0, 0, 0);
                p1 = __builtin_amdgcn_mfma_f32_16x16x32_bf16(a1, bq, p1, 0, 0, 0);
            }
            const int i = 16 * ti + l15;
#pragma unroll
            for (int r = 0; r < 4; ++r) { const int j0 = 16 * tj0 + 4 * G + r, j1 = j0 + 16;
                if (d == 0) { if (j0 > i) p0[r] = 0.f; if (j1 > i) p1[r] = 0.f; } else { if (j0 < i) p0[r] = 0.f; if (j1 < i) p1[r] = 0.f; } }
            u32x2 w0, w1; w0.x = cvt_pk_bf16(p0[0], p0[1]); w0.y = cvt_pk_bf16(p0[2], p0[3]); w1.x = cvt_pk_bf16(p1[0], p1[1]); w1.y = cvt_pk_bf16(p1[2], p1[3]);
            *(LAS u32x2*)(lds + SC_POFF + i * SC_PS + (16 * tj0 + 4 * G) * 2) = w0;
            *(LAS u32x2*)(lds + SC_POFF + i * SC_PS + (16 * (tj0 + 1) + 4 * G) * 2) = w1;
#pragma unroll
            for (int s4 = 0; s4 < 4; ++s4) {
                const f32x4 e0 = *(const LAS f32x4*)(sd + 16 * (2 * s4) + 4 * G), e1 = *(const LAS f32x4*)(sd + 16 * (2 * s4 + 1) + 4 * G);
                const f32x4 x0 = S[2 * s4] * e0, x1 = S[2 * s4 + 1] * e1;
                u32x4 t; t.x = cvt_pk_bf16(x0[0], x0[1]); t.y = cvt_pk_bf16(x0[2], x0[3]); t.z = cvt_pk_bf16(x1[0], x1[1]); t.w = cvt_pk_bf16(x1[2], x1[3]);
                Sp[s4] = __builtin_bit_cast(bf16x8, t);
            }
            LDS_WAIT(); __syncthreads();
        }
        bf16x8 vf[2];
        {
            const int q = l15 >> 2, p = l15 & 3;
#pragma unroll
            for (int ks = 0; ks < 2; ++ks) {
                const s16x4 lo = ds_tr(Bv + (32 * ks + 4 * G + q) * SC_KS + (16 * w + 4 * p) * 2);
                const s16x4 hi = ds_tr(Bv + (32 * ks + 16 + 4 * G + q) * SC_KS + (16 * w + 4 * p) * 2);
                vf[ks] = cat8(lo, hi);
            }
        }
        if (OUTPUT) {
            const int rb = SC_CHUNK_ROW(s);
#pragma unroll
            for (int it = 0; it < 4; ++it) {
                f32x4 o = (f32x4){0.f, 0.f, 0.f, 0.f};
                const int tok = 16 * it + l15;
#pragma unroll
                for (int ks = 0; ks < 2; ++ks) {
                    const s16x4 lo = *(const LAS s16x4*)(lds + SC_POFF + tok * SC_PS + (32 * ks + 4 * G) * 2);
                    const s16x4 hi = *(const LAS s16x4*)(lds + SC_POFF + tok * SC_PS + (32 * ks + 16 + 4 * G) * 2);
                    o = __builtin_amdgcn_mfma_f32_16x16x32_bf16(vf[ks], cat8(lo, hi), o, 0, 0, 0);
                }
#pragma unroll
                for (int s4 = 0; s4 < 4; ++s4) {
                    const s16x4 lo = *(const LAS s16x4*)(Bq + tok * SC_QS + (32 * s4 + 4 * G) * 2);
                    const s16x4 hi = *(const LAS s16x4*)(Bq + tok * SC_QS + (32 * s4 + 16 + 4 * G) * 2);
                    o = __builtin_amdgcn_mfma_f32_16x16x32_bf16(Sp[s4], cat8(lo, hi), o, 0, 0, 0);
                }
                u32x2 wv; wv.x = cvt_pk_bf16(o[0], o[1]); wv.y = cvt_pk_bf16(o[2], o[3]);
                *(u32x2*)(Qd + (size_t)(rb + tok) * 1024 + h * 128 + 16 * w + 4 * G) = wv;
            }
        }
        if (OUTPUT ? (s + 1 < s_end || seg < 7) : true) {
            const int q = l15 >> 2, p = l15 & 3;
#pragma unroll
            for (int i = 0; i < 8; ++i) {
                f32x4 U = (f32x4){0.f, 0.f, 0.f, 0.f};
#pragma unroll
                for (int ks = 0; ks < 2; ++ks) {
                    const s16x4 lo = ds_tr(Bk + (32 * ks + 4 * G + q) * SC_KS + (16 * i + 4 * p) * 2);
                    const s16x4 hi = ds_tr(Bk + (32 * ks + 16 + 4 * G + q) * SC_KS + (16 * i + 4 * p) * 2);
                    U = __builtin_amdgcn_mfma_f32_16x16x32_bf16(cat8(lo, hi), vf[ks], U, 0, 0, 0);
                }
                const f32x4 e2 = *(const LAS f32x4*)(sd + 128 + 16 * i + 4 * G), de = *(const LAS f32x4*)(sd + 256 + 16 * i + 4 * G);
                S[i] = de * S[i] + e2 * U;
                if (!OUTPUT) Dp[i] = Dp[i] * de;
            }
        }
        if (s + 1 < s_end) SC_STAGE_STORE(cur ^ 1);
        LDS_WAIT(); __syncthreads();
    }
    if (!OUTPUT) {
        float* sp = sseg + ((size_t)(chain * 8 + seg) * 64 + w * 8) * 256 + lane * 4;
#pragma unroll
        for (int i = 0; i < 8; ++i) *(f32x4*)(sp + i * 256) = S[i];
        if (w == 0 && l15 == 0) { float* dp = dseg + (size_t)(chain * 8 + seg) * 128 + 4 * G;
#pragma unroll
            for (int i = 0; i < 8; ++i) *(f32x4*)(dp + 16 * i) = Dp[i]; }
    }
#undef SC_CHUNK_ROW
#undef SC_STAGE_LOAD
#undef SC_STAGE_STORE
}

struct Frame {
    LAS unsigned char* lds; int wave, G, gw, NGW;
};
enum ConvKind { CV_NAT = 0, CV_PERM8 = 1, CV_HG = 2, CV_UP = 3, CV_GATES = 4 };
struct ConvJob { int kind; const float* W; const float* W2; int K, N, ld; bf16_t* dst; };
__device__ __forceinline__ const float* conv_colptr(const ConvJob& j, int rho) {
    const int pn = rho >> 8, t = rho & 255, bj = t >> 7, wc = (t >> 5) & 3, n = (t >> 4) & 1, fq = (t >> 2) & 3, jj = t & 3;
    switch (j.kind) {
        case CV_NAT: return j.W + rho;
        case CV_PERM8: return j.W + (pn * 256 + bj * 128 + wc * 32 + fq * 8 + n * 4 + jj);
        case CV_HG: if (pn >= 16) return j.W + (pn * 256 + bj * 128 + wc * 32 + fq * 8 + n * 4 + jj);
                    return j.W + ((2 * bj + n) * 1024 + 64 * pn + 16 * wc + 4 * fq + jj);
        case CV_UP: return j.W + (bj * 2816 + 128 * pn + 32 * wc + 8 * fq + 4 * n + jj);
        default: {
            const int blk = pn >> 2, q = pn & 3, grp = 2 * bj + n, dd = grp >> 1, ax = grp & 1; const int jc = 64 * q + 16 * wc + 4 * fq + jj;
            return (ax ? j.W2 : j.W) + (size_t)(dd * 4 + blk) * 65536 + jc; }
    }
}
__device__ __forceinline__ void conv_item(const ConvJob& j, LAS float* scr, int item, int lane) {
    const int nblk = j.N / 32, kb = item / nblk, nb = item % nblk, k0 = 64 * kb, n0 = 32 * nb;
    const float* cp = conv_colptr(j, n0 + (lane & 31));
    float tv[32];
#pragma unroll
    for (int i = 0; i < 32; ++i) tv[i] = cp[(size_t)(k0 + 2 * i + (lane >> 5)) * j.ld];
#pragma unroll
    for (int i = 0; i < 32; ++i) scr[(2 * i + (lane >> 5)) * 33 + (lane & 31)] = tv[i];
    LDS_WAIT(); asm volatile("" ::: "memory");
    const int c = lane & 7;
#pragma unroll
    for (int jx = 0; jx < 4; ++jx) { const int n = (lane >> 3) + 8 * jx; const LAS float* s = scr + (8 * c) * 33 + n;
        u32x4 o; o.x = pk2(s[0 * 33], s[1 * 33]); o.y = pk2(s[2 * 33], s[3 * 33]); o.z = pk2(s[4 * 33], s[5 * 33]); o.w = pk2(s[6 * 33], s[7 * 33]);
        *(u32x4*)(j.dst + (size_t)(n0 + n) * j.K + k0 + 8 * c) = o; }
    LDS_WAIT(); asm volatile("" ::: "memory");
}
__device__ __forceinline__ void conv_job(const Frame& F, const ConvJob& j, int gw, int ngw) {
    LAS float* scr = (LAS float*)(F.lds + F.wave * 8448);
    const int nitems = (j.K / 64) * (j.N / 32);
    const int lane = lane_id_v();
    for (int it = gw; it < nitems; it += ngw) conv_item(j, scr, it, lane);
}

__device__ __forceinline__ void adaln_phase(const Frame& F, const float* c, const float* cctx, const float* w_ada, const float* b_ada, float* mod) {
    const int tid = F.wave * 64 + lane_id_v();
    LAS float* sc = (LAS float*)(F.lds + 70000);
    LAS float* red = sc + 3 * 1024;
    for (int item = blockIdx.x; item < 192; item += F.G) {
        const int l = item / 96, j0 = (item % 96) * 64;
        for (int i = tid; i < 1024; i += NTHR) { sc[i] = fsilu(c[i]); sc[1024 + i] = fsilu(c[1024 + i]); sc[2048 + i] = fsilu(cctx[i]); }
        __syncthreads();
        const int kp = tid >> 4, jq = (tid & 15) * 4;
        const float* W = w_ada + (size_t)l * 1024 * 6144 + j0 + jq;
        f32x4 a0 = (f32x4){0.f, 0.f, 0.f, 0.f}, a1 = a0, a2 = a0;
#pragma unroll 8
        for (int k = kp * 32; k < kp * 32 + 32; ++k) { const f32x4 wv = *(const f32x4*)(W + (size_t)k * 6144); a0 += sc[k] * wv; a1 += sc[1024 + k] * wv; a2 += sc[2048 + k] * wv; }
        *(LAS f32x4*)(red + (kp * 3 + 0) * 64 + jq) = a0; *(LAS f32x4*)(red + (kp * 3 + 1) * 64 + jq) = a1; *(LAS f32x4*)(red + (kp * 3 + 2) * 64 + jq) = a2;
        __syncthreads();
        if (tid < 192) { const int v = tid >> 6, j2 = tid & 63; float s = 0.f;
#pragma unroll
            for (int p = 0; p < 32; ++p) s += red[(p * 3 + v) * 64 + j2];
            mod[(size_t)(l * 3 + v) * 6144 + j0 + j2] = s + b_ada[(size_t)l * 6144 + j0 + j2]; }
        __syncthreads();
    }
}

__device__ __forceinline__ void norm_phase(const Frame& F, const float* latL, float* latC, const float* g, const float* mod, int sh_off, int sc_off, bf16_t* H, int nrows, const float* slab = nullptr, int nslab = 0) {
    const int lane = lane_id_v();
    for (int row = F.gw; row < nrows; row += F.NGW) {
        const int v = row < 8192 ? 0 : (row < ML ? 1 : 2);
        const float* x = row < ML ? latL + (size_t)row * 1024 : latC + (size_t)(row - ML) * 1024;
        const float* sh = mod + v * 6144 + sh_off; const float* sc = mod + v * 6144 + sc_off;
        f32x4 xv[4]; float ss = 0.f;
#pragma unroll
        for (int j = 0; j < 4; ++j) { xv[j] = *(const f32x4*)(x + (lane + 64 * j) * 4);
            if (nslab > 0 && row >= ML) {
                for (int k = 0; k < nslab; ++k) xv[j] += *(const f32x4*)(slab + ((size_t)k * 512 + (row - ML)) * 1024 + (lane + 64 * j) * 4);
                *(f32x4*)(latC + (size_t)(row - ML) * 1024 + (lane + 64 * j) * 4) = xv[j]; }
            ss += (xv[j][0] * xv[j][0] + xv[j][1] * xv[j][1]) + (xv[j][2] * xv[j][2] + xv[j][3] * xv[j][3]); }
        const float rstd = rsqrtf(wave_sum(ss) * (1.f / 1024.f) + 1e-6f);
#pragma unroll
        for (int j = 0; j < 4; ++j) { const int cidx = (lane + 64 * j) * 4; const f32x4 gv = *(const f32x4*)(g + cidx), sv = *(const f32x4*)(sc + cidx), hv = *(const f32x4*)(sh + cidx);
            const f32x4 y = xv[j] * rstd * gv * (sv + 1.f) + hv; u32x2 wv; wv.x = pk2(y[0], y[1]); wv.y = pk2(y[2], y[3]);
            *(u32x2*)(H + (size_t)row * 1024 + cidx) = wv; }
    }
}

__device__ __forceinline__ void readout_phase(const Frame& F, const bf16_t* OF, const bf16_t* OB, const bf16_t* SG, const float* gn, bf16_t* R) {
    const int lane = lane_id_v(); const int l15 = lane & 15;
    const f32x4 g0 = *(const f32x4*)(gn + l15 * 8), g1 = *(const f32x4*)(gn + l15 * 8 + 4);
    for (int row = F.gw; row < MT; row += F.NGW) {
#pragma unroll
        for (int ps = 0; ps < 2; ++ps) {
            const size_t off = (size_t)row * 1024 + (size_t)((lane >> 4) + 4 * ps) * 128 + l15 * 8;
            const u32x4 a = *(const u32x4*)(OF + off), b = *(const u32x4*)(OB + off), sg = *(const u32x4*)(SG + off);
            float o[8] = {bflo(a.x) + bflo(b.x), bfhi(a.x) + bfhi(b.x), bflo(a.y) + bflo(b.y), bfhi(a.y) + bfhi(b.y), bflo(a.z) + bflo(b.z), bfhi(a.z) + bfhi(b.z), bflo(a.w) + bflo(b.w), bfhi(a.w) + bfhi(b.w)};
            float ss = 0.f;
#pragma unroll
            for (int j = 0; j < 8; ++j) ss += o[j] * o[j];
#pragma unroll
            for (int m = 1; m < 16; m <<= 1) ss += __shfl_xor(ss, m);
            const float rstd = rsqrtf(ss * (1.f / 128.f) + 1e-6f);
            u32x4 wv; wv.x = pk2(o[0] * rstd * g0[0] * bflo(sg.x), o[1] * rstd * g0[1] * bfhi(sg.x)); wv.y = pk2(o[2] * rstd * g0[2] * bflo(sg.y), o[3] * rstd * g0[3] * bfhi(sg.y));
            wv.z = pk2(o[4] * rstd * g1[0] * bflo(sg.z), o[5] * rstd * g1[1] * bfhi(sg.z)); wv.w = pk2(o[6] * rstd * g1[2] * bflo(sg.w), o[7] * rstd * g1[3] * bfhi(sg.w));
            *(u32x4*)(R + off) = wv;
        }
    }
}

struct EpiLruIn {
    bf16_t* GG; bf16_t* XR;
    __device__ __forceinline__ void operator()(const f32x4 (&acc)[2][2][4][2], const Unit& u, int wr, int wc, int fr, int fq, LAS unsigned char*, int, int) const {
        const bool isx = u.pn >= 4; const int col0 = (u.pn & 3) * 256 + wc * 32 + 8 * fq;
        bf16_t* dst = isx ? XR : GG;
#pragma unroll
        for (int ai = 0; ai < 2; ++ai)
#pragma unroll
            for (int m = 0; m < 4; ++m) { const int row = u.pm * 256 + ai * HALF + wr * 64 + m * 16 + fr; int drow = row;
                if (isx && row < ML) { const int t = row & 8191; drow = (row & ~8191) + (t & 63) * 128 + (t >> 6); }
#pragma unroll
                for (int bj = 0; bj < 2; ++bj) { f32x4 v0 = acc[ai][bj][m][0], v1 = acc[ai][bj][m][1];
                    if (!isx) {
#pragma unroll
                        for (int j = 0; j < 4; ++j) { v0[j] = fgelu_tanh(v0[j]); v1[j] = fgelu_tanh(v1[j]); } }
                    u32x4 w; w.x = cvt_pk_bf16(v0[0], v0[1]); w.y = cvt_pk_bf16(v0[2], v0[3]); w.z = cvt_pk_bf16(v1[0], v1[1]); w.w = cvt_pk_bf16(v1[2], v1[3]);
                    *(u32x4*)((char*)dst + (unsigned)((drow * 1024 + col0 + bj * HALF) * 2)) = w; }
                asm volatile("" ::: "memory"); }
    }
};
struct EpiXrSlab {
    float* slab; int ksplit;
    __device__ __forceinline__ void operator()(const f32x4 (&acc)[2][2][4][2], const Unit& u, int wr, int wc, int fr, int fq, LAS unsigned char*, int, int) const {
        float* out = slab + ((size_t)(u.pn % ksplit) * 512 + (size_t)(u.pm - 64) * 256) * 1024;
        const int col0 = (u.pn / ksplit) * 256 + wc * 32 + 8 * fq;
#pragma unroll
        for (int ai = 0; ai < 2; ++ai)
#pragma unroll
            for (int m = 0; m < 4; ++m)
#pragma unroll
                for (int bj = 0; bj < 2; ++bj)
#pragma unroll
                    for (int n = 0; n < 2; ++n) *(f32x4*)(out + (size_t)(ai * HALF + wr * 64 + m * 16 + fr) * 1024 + col0 + bj * HALF + 4 * n) = acc[ai][bj][m][n];
    }
};
__device__ __forceinline__ void lru_conv_phase(const Frame& F, const bf16_t* XR, const float* xrslab, const float* cw, const float* cb, bf16_t* XC) {
    const int lane = lane_id_v(); const int gt = F.gw * 64 + lane, ngt = F.NGW * 64;
    for (int it = gt; it < MT * 128; it += ngt) {
        const int row = it >> 7, c8 = (it & 127) * 8;
        const int s0 = row < ML ? (row & ~8191) : (ML + ((row - ML) & ~255)), slen = row < ML ? 8192 : 256, p = row - s0;
        float a[8];
#pragma unroll
        for (int j = 0; j < 8; ++j) a[j] = cb[c8 + j];
#pragma unroll
        for (int k = 0; k < 4; ++k) { const int pp = p + k - 2;
            if (pp >= 0 && pp < slen) { const f32x4 w0 = *(const f32x4*)(cw + k * 1024 + c8), w1 = *(const f32x4*)(cw + k * 1024 + c8 + 4);
                if (row < ML) { const u32x4 xv = *(const u32x4*)(XR + (size_t)(s0 + pp) * 1024 + c8);
                    a[0] += w0[0] * bflo(xv.x); a[1] += w0[1] * bfhi(xv.x); a[2] += w0[2] * bflo(xv.y); a[3] += w0[3] * bfhi(xv.y);
                    a[4] += w1[0] * bflo(xv.z); a[5] += w1[1] * bfhi(xv.z); a[6] += w1[2] * bflo(xv.w); a[7] += w1[3] * bfhi(xv.w); }
                else { f32x4 x0 = (f32x4){0.f, 0.f, 0.f, 0.f}, x1 = x0;
#pragma unroll
                    for (int ks = 0; ks < 4; ++ks) { const float* sp = xrslab + ((size_t)ks * 512 + (s0 - ML + pp)) * 1024 + c8; x0 += *(const f32x4*)sp; x1 += *(const f32x4*)(sp + 4); }
                    a[0] += w0[0] * x0[0]; a[1] += w0[1] * x0[1]; a[2] += w0[2] * x0[2]; a[3] += w0[3] * x0[3]; a[4] += w1[0] * x1[0]; a[5] += w1[1] * x1[1]; a[6] += w1[2] * x1[2]; a[7] += w1[3] * x1[3]; } } }
        u32x4 o; o.x = pk2(a[0], a[1]); o.y = pk2(a[2], a[3]); o.z = pk2(a[4], a[5]); o.w = pk2(a[6], a[7]);
        *(u32x4*)(XC + (size_t)row * 1024 + c8) = o;
    }
}
struct EpiGates {
    const bf16_t* XC; bf16_t *HLf, *Pf, *HLb, *Pb; float* agg; const float* ba; const float* bx; const float* lam;
    __device__ __forceinline__ void operator()(const f32x4 (&acc)[2][2][4][2], const Unit& u, int wr, int wc, int fr, int fq, LAS unsigned char*, int, int) const {
        const int c0 = 256 * (u.pn >> 2) + 64 * (u.pn & 3) + 16 * wc + 4 * fq;
#pragma unroll
        for (int d = 0; d < 2; ++d) {
            const f32x4 bav = *(const f32x4*)(ba + d * 1024 + c0), bxv = *(const f32x4*)(bx + d * 1024 + c0), lmv = *(const f32x4*)(lam + d * 1024 + c0);
            f32x4 spv;
#pragma unroll
            for (int j = 0; j < 4; ++j) { const float l = lmv[j]; spv[j] = (l > 0.f) ? log1pf(__expf(-l)) : (-l + log1pf(__expf(l))); }
            bf16_t* HL = d ? HLb : HLf; bf16_t* PP = d ? Pb : Pf;
#pragma unroll
            for (int ai = 0; ai < 2; ++ai) {
                const int grow0 = u.pm * 256 + ai * HALF + wr * 64, gidx = grow0 >> 6;
                unsigned hlw[4][2], ppw[4][2];
                u32x2 xw[4];
#pragma unroll
                for (int m = 0; m < 4; ++m) xw[m] = *(const u32x2*)((const char*)XC + (unsigned)(((grow0 + m * 16 + fr) * 1024 + c0) * 2));
#pragma unroll
                for (int jp = 0; jp < 2; ++jp) {
                    __builtin_amdgcn_sched_barrier(0);
                    float A[4][2], U[4][2];
#pragma unroll
                    for (int m = 0; m < 4; ++m) { const unsigned xww = jp ? xw[m].y : xw[m].x; const float xc[2] = {bflo(xww), bfhi(xww)};
                        const f32x4 pa = d ? acc[ai][1][m][0] : acc[ai][0][m][0], px = d ? acc[ai][1][m][1] : acc[ai][0][m][1];
#pragma unroll
                        for (int jj = 0; jj < 2; ++jj) { const int j = 2 * jp + jj; const float r = fsigmoid(pa[j] + bav[j]), ig = fsigmoid(px[j] + bxv[j]); const float la = -8.f * r * spv[j];
                            A[m][jj] = __expf(la); U[m][jj] = sqrtf(fmaxf(1.f - __expf(2.f * la), 0.f)) * (ig * xc[jj]); } }
#pragma unroll
                    for (int jj = 0; jj < 2; ++jj) { const int j = 2 * jp + jj;
                        if (d == 0) {
#pragma unroll
                            for (int m = 0; m < 4; ++m) { float a = A[m][jj], x = U[m][jj]; float ap, up;
                                if (m > 0) { ap = MK_DPP(1.f, A[m - 1][jj], 0x121); up = MK_DPP(0.f, U[m - 1][jj], 0x121); if (fr == 0) { x = a * up + x; a = a * ap; } }
                                ap = MK_DPP(1.f, a, 0x111); up = MK_DPP(0.f, x, 0x111); x = a * up + x; a = a * ap;
                                ap = MK_DPP(1.f, a, 0x112); up = MK_DPP(0.f, x, 0x112); x = a * up + x; a = a * ap;
                                ap = MK_DPP(1.f, a, 0x114); up = MK_DPP(0.f, x, 0x114); x = a * up + x; a = a * ap;
                                ap = MK_DPP(1.f, a, 0x118); up = MK_DPP(0.f, x, 0x118); x = a * up + x; a = a * ap;
                                A[m][jj] = a; U[m][jj] = x; }
                            if (fr == 15) { agg[((size_t)(gidx * 2 + 0) * 2 + 0) * 1024 + c0 + j] = A[3][jj]; agg[((size_t)(gidx * 2 + 0) * 2 + 1) * 1024 + c0 + j] = U[3][jj]; }
                        } else {
#pragma unroll
                            for (int mm = 0; mm < 4; ++mm) { const int m = 3 - mm; float a = A[m][jj], x = U[m][jj]; float ap, up;
                                if (m < 3) { ap = MK_DPP(1.f, A[m + 1][jj], 0x12F); up = MK_DPP(0.f, U[m + 1][jj], 0x12F); if (fr == 15) { x = a * up + x; a = a * ap; } }
                                ap = MK_DPP(1.f, a, 0x101); up = MK_DPP(0.f, x, 0x101); x = a * up + x; a = a * ap;
                                ap = MK_DPP(1.f, a, 0x102); up = MK_DPP(0.f, x, 0x102); x = a * up + x; a = a * ap;
                                ap = MK_DPP(1.f, a, 0x104); up = MK_DPP(0.f, x, 0x104); x = a * up + x; a = a * ap;
                                ap = MK_DPP(1.f, a, 0x108); up = MK_DPP(0.f, x, 0x108); x = a * up + x; a = a * ap;
                                A[m][jj] = a; U[m][jj] = x; }
                            if (fr == 0) { agg[((size_t)(gidx * 2 + 1) * 2 + 0) * 1024 + c0 + j] = A[0][jj]; agg[((size_t)(gidx * 2 + 1) * 2 + 1) * 1024 + c0 + j] = U[0][jj]; }
                        }
                    }
#pragma unroll
                    for (int m = 0; m < 4; ++m) { hlw[m][jp] = cvt_pk_bf16(U[m][0], U[m][1]); ppw[m][jp] = cvt_pk_bf16(A[m][0], A[m][1]); }
                }
#pragma unroll
                for (int m = 0; m < 4; ++m) { const unsigned off = (unsigned)(((grow0 + m * 16 + fr) * 1024 + c0) * 2);
                    *(u32x2*)((char*)HL + off) = (u32x2){hlw[m][0], hlw[m][1]}; *(u32x2*)((char*)PP + off) = (u32x2){ppw[m][0], ppw[m][1]}; }
                asm volatile("" ::: "memory");
            }
        }
    }
};
__device__ __forceinline__ void lru_gscan_phase(const Frame& F, const float* agg, float* hin) {
    const int lane = lane_id_v(); const int gt = F.gw * 64 + lane;
    if (gt >= 4096) return;
    const int b = gt >> 11, d = (gt >> 10) & 1, c = gt & 1023;
    float h = 0.f;
#pragma unroll 1
    for (int s0 = 0; s0 < 132; s0 += 33) {
        float pt[33], ht[33];
#pragma unroll
        for (int k = 0; k < 33; ++k) { const int s = s0 + k; const int g = (s < 4) ? (256 + 4 * b + (d ? (3 - s) : s)) : (128 * b + (d ? (127 - (s - 4)) : (s - 4)));
            pt[k] = agg[((size_t)(g * 2 + d) * 2 + 0) * 1024 + c]; ht[k] = agg[((size_t)(g * 2 + d) * 2 + 1) * 1024 + c]; }
#pragma unroll
        for (int k = 0; k < 33; ++k) { const int s = s0 + k; const int g = (s < 4) ? (256 + 4 * b + (d ? (3 - s) : s)) : (128 * b + (d ? (127 - (s - 4)) : (s - 4)));
            hin[(size_t)(g * 2 + d) * 1024 + c] = h; h = pt[k] * h + ht[k]; }
    }
}
__device__ __forceinline__ void lru_final_phase(const Frame& F, const bf16_t* HLf, const bf16_t* Pf, const bf16_t* HLb, const bf16_t* Pb, const float* hin, const bf16_t* GG, bf16_t* Y) {
    const int lane = lane_id_v(); const int gt = F.gw * 64 + lane, ngt = F.NGW * 64;
    for (int it = gt; it < ML * 128; it += ngt) {
        const int row = it >> 7, c8 = (it & 127) * 8; const int t = row & 8191; const int prow = (row & ~8191) + (t & 63) * 128 + (t >> 6), g = prow >> 6;
        const size_t po = (size_t)prow * 1024 + c8;
        const u32x4 hf = *(const u32x4*)(HLf + po), pf = *(const u32x4*)(Pf + po), hb = *(const u32x4*)(HLb + po), pb = *(const u32x4*)(Pb + po), gg = *(const u32x4*)(GG + (size_t)row * 1024 + c8);
        const float* hif = hin + (size_t)(g * 2 + 0) * 1024 + c8; const float* hib = hin + (size_t)(g * 2 + 1) * 1024 + c8;
        const f32x4 f0 = *(const f32x4*)hif, f1 = *(const f32x4*)(hif + 4), b0 = *(const f32x4*)hib, b1 = *(const f32x4*)(hib + 4);
        float y[8];
        y[0] = (bflo(hf.x) + bflo(pf.x) * f0[0] + bflo(hb.x) + bflo(pb.x) * b0[0]) * bflo(gg.x); y[1] = (bfhi(hf.x) + bfhi(pf.x) * f0[1] + bfhi(hb.x) + bfhi(pb.x) * b0[1]) * bfhi(gg.x);
        y[2] = (bflo(hf.y) + bflo(pf.y) * f0[2] + bflo(hb.y) + bflo(pb.y) * b0[2]) * bflo(gg.y); y[3] = (bfhi(hf.y) + bfhi(pf.y) * f0[3] + bfhi(hb.y) + bfhi(pb.y) * b0[3]) * bfhi(gg.y);
        y[4] = (bflo(hf.z) + bflo(pf.z) * f1[0] + bflo(hb.z) + bflo(pb.z) * b1[0]) * bflo(gg.z); y[5] = (bfhi(hf.z) + bfhi(pf.z) * f1[1] + bfhi(hb.z) + bfhi(pb.z) * b1[1]) * bfhi(gg.z);
        y[6] = (bflo(hf.w) + bflo(pf.w) * f1[2] + bflo(hb.w) + bflo(pb.w) * b1[2]) * bflo(gg.w); y[7] = (bfhi(hf.w) + bfhi(pf.w) * f1[3] + bfhi(hb.w) + bfhi(pb.w) * b1[3]) * bfhi(gg.w);
        u32x4 o; o.x = pk2(y[0], y[1]); o.y = pk2(y[2], y[3]); o.z = pk2(y[4], y[5]); o.w = pk2(y[6], y[7]);
        *(u32x4*)(Y + (size_t)row * 1024 + c8) = o;
    }
}
__device__ __forceinline__ void final_norm_phase(const Frame& F, float* lat, const float* g, float dbg_s, float dbg_spike) {
    const int lane = lane_id_v();
    for (int row = F.gw; row < ML; row += F.NGW) {
        float* x = lat + (size_t)row * 1024; f32x4 xv[4]; float ss = 0.f;
#pragma unroll
        for (int j = 0; j < 4; ++j) { xv[j] = *(const f32x4*)(x + (lane + 64 * j) * 4); ss += (xv[j][0] * xv[j][0] + xv[j][1] * xv[j][1]) + (xv[j][2] * xv[j][2] + xv[j][3] * xv[j][3]); }
        const float rstd = rsqrtf(wave_sum(ss) * (1.f / 1024.f) + 1e-6f);
#pragma unroll
        for (int j = 0; j < 4; ++j) { const int cidx = (lane + 64 * j) * 4; f32x4 y = xv[j] * rstd * *(const f32x4*)(g + cidx);
            if (dbg_s != 0.f) { y[0] += dbg_s; y[1] -= dbg_s; y[2] += dbg_s; y[3] -= dbg_s; }
            if (dbg_spike != 0.f && row == 0 && cidx == 0) y[0] += dbg_spike;
            *(f32x4*)(x + cidx) = y; }
    }
}

struct Args { const float* in[25]; float* out; unsigned char* ws; int ph_lo, ph_hi; };
__global__ void __launch_bounds__(NTHR, 2) mega(Args args) {
    extern __shared__ __attribute__((aligned(16))) unsigned char lds_raw[];
    LAS unsigned char* lds = (LAS unsigned char*)lds_raw;
    Frame F; F.lds = lds; F.wave = __builtin_amdgcn_readfirstlane(threadIdx.x >> 6); F.G = gridDim.x;
    F.gw = blockIdx.x * NWAVES + F.wave; F.NGW = F.G * NWAVES;
    volatile LAS unsigned* MISC = (volatile LAS unsigned*)(lds + MISC_OFF);
    if (threadIdx.x < 64) MISC[threadIdx.x] = 0u;
    __syncthreads();
    unsigned char* ws = args.ws;
    XcdBarrier bar = xcd_barrier_post((unsigned*)(ws + WS_CTL) + CW_BAR, MISC + 8);
    const float* x = args.in[0]; const float* cvec = args.in[1]; const float* ctx = args.in[2]; const float* cctx = args.in[3];
    const float* w_ada = args.in[4]; const float* b_ada = args.in[5]; const float* norm_g = args.in[6];
    const float* hg_w_in = args.in[7]; const float* hg_lb = args.in[8]; const float* hg_gn = args.in[9]; const float* hg_w_out = args.in[10];
    float* MOD = (float*)(ws + WS_MOD); float* LB = (float*)(ws + WS_LB); float* CXLAT = (float*)(ws + WS_CXLAT); float* SIDE = (float*)(ws + WS_SIDE);
    bf16_t* W_HGIN = (bf16_t*)(ws + WS_W_HGIN); bf16_t* W_HGOUT = (bf16_t*)(ws + WS_W_HGOUT); bf16_t* W_UP = (bf16_t*)(ws + WS_W_UP); bf16_t* W_DN0 = (bf16_t*)(ws + WS_W_DN0);
    bf16_t* W_LRUIN = (bf16_t*)(ws + WS_W_LRUIN); bf16_t* W_GATES = (bf16_t*)(ws + WS_W_GATES); bf16_t* W_LRUOUT = (bf16_t*)(ws + WS_W_LRUOUT); bf16_t* W_DN1 = (bf16_t*)(ws + WS_W_DN1);
    bf16_t* UEDGE = (bf16_t*)(ws + WS_UEDGE);
    const float* lru_w_in = args.in[11]; const float* lru_cw = args.in[12]; const float* lru_cb = args.in[13]; const float* lru_wa = args.in[14]; const float* lru_ba = args.in[15];
    const float* lru_wx = args.in[16]; const float* lru_bx = args.in[17]; const float* lru_lam = args.in[18]; const float* lru_w_out = args.in[19];
    const float* ffn_up = args.in[20]; const float* ffn_cw = args.in[21]; const float* ffn_cb = args.in[22]; const float* ffn_down = args.in[23]; const float* final_g = args.in[24];
    bf16_t* ACT[6];
#pragma unroll
    for (int i = 0; i < 6; ++i) ACT[i] = (bf16_t*)(ws + WS_ACT + (size_t)i * ACT_SLOT);
    bf16_t* Hd = (bf16_t*)args.out;
    const int lo = args.ph_lo, hi = args.ph_hi;
#define IN(k) (lo <= (k) && (k) < hi)
#ifdef MK_TIMING
    unsigned long long* TS = (unsigned long long*)(ws + WS_CTL + 8192);
#define STAMP(k) do { if (blockIdx.x == 0 && F.wave == 0 && lane_id_v() == 0) TS[(k)] = __builtin_amdgcn_s_memrealtime(); } while (0)
#else
#define STAMP(k) do { } while (0)
#endif
    STAMP(0);
#define SEAM(k) do { if (IN(k) && IN((k) + 1)) xcd_barrier(bar, F.wave); STAMP((k) + 1); } while (0)

    if (IN(0)) {
        adaln_phase(F, cvec, cctx, w_ada, b_ada, MOD);
        if (blockIdx.x == F.G - 1) for (int i = F.wave * 64 + lane_id_v(); i < 2048; i += NTHR) { const float l0 = hg_lb[i], l1 = hg_lb[2048 + i]; const float m = fmaxf(l0, l1), e0 = __expf(l0 - m), e1 = __expf(l1 - m); LB[i] = e0 / (e0 + e1); }
        __syncthreads();
        { const int lane = lane_id_v(); for (int i = F.gw * 64 + lane; i < 512 * 256; i += F.NGW * 64) ((f32x4*)CXLAT)[i] = ((const f32x4*)ctx)[i]; }
        { ConvJob j{CV_HG, hg_w_in, nullptr, 1024, 5120, 5120, W_HGIN}; conv_job(F, j, F.gw, F.NGW); }
    }
    SEAM(0);
    if (IN(1)) norm_phase(F, x, (float*)ctx, norm_g, MOD, 0, 1024, Hd, MT);
    SEAM(1);
    if (IN(2)) {
        Gemm g{Hd, W_HGIN, 1024, 1024, 1024, 0, 0, 1}; StaticOrder S; S.init(NTM, 20, F.G, (int)blockIdx.x);
        EpiHgIn E{ACT[0], ACT[1], ACT[2], ACT[3], ACT[4], ACT[5], SIDE, LB};
        gemm_phase(lds, g, S, E, F.wave);
    }
    SEAM(2);
    float* SSEG = (float*)args.out; float* DSEG = (float*)args.out + (size_t)256 * 16384;
    if (IN(3)) {
        for (int u = blockIdx.x; u < 256; u += F.G) if ((u & 7) != 7) { const int dd = (u >> 3) & 1;
            hgrn_segment<false>(lds, dd ? ACT[2] : ACT[0], dd ? ACT[3] : ACT[1], ACT[4], SIDE, SSEG, DSEG, u >> 3, u & 7, F.wave); }
        { ConvJob j{CV_NAT, hg_w_out, nullptr, 1024, 1024, 1024, W_HGOUT}; conv_job(F, j, F.gw, F.NGW); }
        { ConvJob j{CV_UP, ffn_up, nullptr, 1024, 5632, 5632, W_UP}; conv_job(F, j, F.gw, F.NGW); }
        { ConvJob j{CV_NAT, ffn_down, nullptr, 2816, 1024, 1024, W_DN0}; conv_job(F, j, F.gw, F.NGW); }
        { ConvJob j{CV_PERM8, lru_w_in, nullptr, 1024, 2048, 2048, W_LRUIN}; conv_job(F, j, F.gw, F.NGW); }
        { ConvJob j{CV_GATES, lru_wa, lru_wx, 256, 4096, 256, W_GATES}; conv_job(F, j, F.gw, F.NGW); }
        { ConvJob j{CV_NAT, lru_w_out, nullptr, 1024, 1024, 1024, W_LRUOUT}; conv_job(F, j, F.gw, F.NGW); }
        { ConvJob j{CV_NAT, ffn_down + (size_t)2816 * 1024, nullptr, 2816, 1024, 1024, W_DN1}; conv_job(F, j, F.gw, F.NGW); }
    }
    SEAM(3);
    if (IN(4)) {
        for (int u = blockIdx.x; u < 256; u += F.G) { const int dd = (u >> 3) & 1;
            hgrn_segment<true>(lds, dd ? ACT[2] : ACT[0], dd ? ACT[3] : ACT[1], ACT[4], SIDE, SSEG, DSEG, u >> 3, u & 7, F.wave); }
    }
    SEAM(4);
    if (IN(5)) readout_phase(F, ACT[0], ACT[2], ACT[5], hg_gn, ACT[1]);
    SEAM(5);
    if (IN(6)) {
        { Gemm g{ACT[1], W_HGOUT, 1024, 1024, 1024, 0, 0, 1}; StaticOrder S; S.init(64, 4, F.G, (int)blockIdx.x);
          EpiResid E{x, ctx, args.out, CXLAT, MOD, 2048};
          gemm_phase(lds, g, S, E, F.wave); }
        { Gemm g{ACT[1], W_HGOUT, 1024, 1024, 256, 0, 0, 4}; StaticOrder S; S.init(2, 16, F.G, (int)blockIdx.x, 64);
          EpiSlab E{(float*)ACT[3], MOD, 2048, 4};
          gemm_phase(lds, g, S, E, F.wave); }
    }
    SEAM(6);
    if (IN(7)) norm_phase(F, args.out, CXLAT, norm_g + 1024, MOD, 3072, 4096, ACT[5], MT, (const float*)ACT[3], 4);
    SEAM(7);
    if (IN(8)) {
        Gemm g{ACT[5], W_UP, 1024, 1024, 1024, 0, 0, 1}; StaticOrder S; S.init(NTM, 22, F.G, (int)blockIdx.x);
        EpiUpConv E{ACT[0], UEDGE, ffn_cw, ffn_cb};
        gemm_phase(lds, g, S, E, F.wave);
    }
    SEAM(8);
    if (IN(9)) {
        StaticOrder S; S.init(64, 4, F.G, (int)blockIdx.x);
        StaticOrder S2; S2.init(2, 44, F.G, (int)blockIdx.x, 64);
        { Unit u; const int tid = F.wave * 64 + lane_id_v(); for (int i = 0; S.next(i, u); ++i) ffn_fix_edges(tid, u.pm, ACT[0], UEDGE, ffn_cw, ffn_cb);
          for (int i = 0; S2.next(i, u); ++i) ffn_fix_edges(tid, u.pm, ACT[0], UEDGE, ffn_cw, ffn_cb); }
        VM_WAIT(); __syncthreads();
        { Gemm g{ACT[0], W_DN0, 2816, 2816, 2816, 0, 0, 1};
          EpiResid E{args.out, CXLAT, args.out, CXLAT, MOD, 5120};
          gemm_phase(lds, g, S, E, F.wave); }
        { Gemm g{ACT[0], W_DN0, 2816, 2816, 256, 0, 0, 11};
          EpiSlab E{(float*)ACT[5], MOD, 5120, 11};
          gemm_phase(lds, g, S2, E, F.wave); }
    }
    SEAM(9);
    float* MOD1 = MOD + 3 * 6144; float* AGG = SIDE; float* HIN = (float*)(ws + WS_SIDE + 4 * MiB + 256 * 1024);
    if (IN(10)) {
        norm_phase(F, args.out, CXLAT, norm_g + 2048, MOD1, 0, 1024, ACT[0], MT, (const float*)ACT[5], 11);
    }
    SEAM(10);
    if (IN(11)) {
        { Gemm g{ACT[0], W_LRUIN, 1024, 1024, 1024, 0, 0, 1}; StaticOrder S; S.init(64, 8, F.G, (int)blockIdx.x);
          EpiLruIn E{ACT[1], ACT[2]};
          gemm_phase(lds, g, S, E, F.wave); }
        { Gemm g{ACT[0], W_LRUIN + (size_t)1024 * 1024, 1024, 1024, 256, 0, 0, 4}; StaticOrder S; S.init(2, 16, F.G, (int)blockIdx.x, 64);
          EpiXrSlab E{(float*)ACT[4], 4};
          gemm_phase(lds, g, S, E, F.wave); }
    }
    SEAM(11);
    if (IN(12)) lru_conv_phase(F, ACT[2], (const float*)ACT[4], lru_cw, lru_cb, ACT[3]);
    SEAM(12);
    if (IN(13)) {
        Gemm g{ACT[3], W_GATES, 1024, 256, 256, 2, 256, 1}; StaticOrder S; S.init(NTM, 16, F.G, (int)blockIdx.x);
        EpiGates E{ACT[3], ACT[0], ACT[4], ACT[5], ACT[2], AGG, lru_ba, lru_bx, lru_lam};
        gemm_phase(lds, g, S, E, F.wave);
    }
    SEAM(13);
    if (IN(14)) {
        if ((int)blockIdx.x < 8) lru_gscan_phase(F, AGG, HIN);
        else { const int gw2 = ((int)blockIdx.x - 8) * NWAVES + F.wave, ngw2 = (F.G - 8) * NWAVES;
            ConvJob j{CV_UP, ffn_up + (size_t)1024 * 5632, nullptr, 1024, 5632, 5632, W_UP}; conv_job(F, j, gw2, ngw2); }
    }
    SEAM(14);
    if (IN(15)) lru_final_phase(F, ACT[0], ACT[4], ACT[5], ACT[2], HIN, ACT[1], ACT[3]);
    SEAM(15);
    if (IN(16)) {
        Gemm g{ACT[3], W_LRUOUT, 1024, 1024, 1024, 0, 0, 1}; StaticOrder S; S.init(64, 4, F.G, (int)blockIdx.x);
        EpiResid E{args.out, CXLAT, args.out, CXLAT, MOD1, 2048};
        gemm_phase(lds, g, S, E, F.wave);
    }
    SEAM(16);
    if (IN(17)) norm_phase(F, args.out, CXLAT, norm_g + 3072, MOD1, 3072, 4096, ACT[5], ML);
    SEAM(17);
    if (IN(18)) {
        Gemm g{ACT[5], W_UP, 1024, 1024, 1024, 0, 0, 1}; StaticOrder S; S.init(64, 22, F.G, (int)blockIdx.x);
        EpiUpConv E{ACT[0], UEDGE, ffn_cw + 3 * 5632, ffn_cb + 5632};
        gemm_phase(lds, g, S, E, F.wave);
    }
    SEAM(18);
    if (IN(19)) {
        StaticOrder S; S.init(64, 4, F.G, (int)blockIdx.x);
        { Unit u; const int tid = F.wave * 64 + lane_id_v(); for (int i = 0; S.next(i, u); ++i) ffn_fix_edges(tid, u.pm, ACT[0], UEDGE, ffn_cw + 3 * 5632, ffn_cb + 5632); }
        VM_WAIT(); __syncthreads();
        Gemm g{ACT[0], W_DN1, 2816, 2816, 2816, 0, 0, 1};
        EpiResid E{args.out, CXLAT, args.out, CXLAT, MOD1, 5120};
        gemm_phase(lds, g, S, E, F.wave);
    }
    SEAM(19);
#ifdef MK_TIMING
    if (IN(20)) { const float t_a = (float)(TS[MK_T_A1] - TS[MK_T_A0]) * 0.01f, t_b = (float)(TS[MK_T_B1] - TS[MK_T_B0]) * 0.01f;
        final_norm_phase(F, args.out, final_g, sqrtf(t_a * 1e-6f), t_b * (1.f / 500.f)); }
#else
    if (IN(20)) final_norm_phase(F, args.out, final_g, 0.f, 0.f);
#endif
#undef IN
#undef SEAM
}
}
__global__ void __launch_bounds__(128) k_refscan(unsigned short* QF, const unsigned short* KF, unsigned short* QB, const unsigned short* KB, const unsigned short* V, const float* side) {
    const int ch = blockIdx.x, b = ch >> 4, h = (ch >> 1) & 7, d = ch & 1, t = threadIdx.x;
    unsigned short* Qd = d ? QB : QF; const unsigned short* Kd = d ? KB : KF;
    __shared__ float q[64][129], k[64][129], vs[64][128], P[64][65], e1[128], e2[128], dec[128];
    float S[128];
#pragma unroll
    for (int i = 0; i < 128; ++i) S[i] = 0.f;
    for (int s = 0; s < 132; ++s) {
        const int rb = (s < 4) ? (16384 + b * 256 + 64 * (d ? (3 - s) : s)) : (b * 8192 + 64 * (d ? (127 - (s - 4)) : (s - 4)));
        const int ck = rb >> 6;
        for (int idx = t; idx < 8192; idx += 128) { const int r = idx >> 7, c = idx & 127; const size_t g = (size_t)(rb + r) * 1024 + h * 128 + c;
            q[r][c] = mk::bf2f(Qd[g]); k[r][c] = mk::bf2f(Kd[g]); vs[r][c] = mk::bf2f(V[g]); }
        e1[t] = side[((size_t)(ck * 2 + d) * 3 + 0) * 1024 + h * 128 + t]; e2[t] = side[((size_t)(ck * 2 + d) * 3 + 1) * 1024 + h * 128 + t]; dec[t] = side[((size_t)(ck * 2 + d) * 3 + 2) * 1024 + h * 128 + t];
        __syncthreads();
        for (int idx = t; idx < 4096; idx += 128) { const int i = idx >> 6, j = idx & 63; const bool ok = d ? (j >= i) : (j <= i); float p = 0.f;
            if (ok) for (int c = 0; c < 128; ++c) p += q[i][c] * k[j][c];
            P[i][j] = p; }
        __syncthreads();
        for (int i = 0; i < 64; ++i) { float o = 0.f;
#pragma unroll
            for (int c = 0; c < 128; ++c)
#ifdef UNIT_SIDE
                o += q[i][c] * S[c];
#else
                o += q[i][c] * (e1[c] * S[c]);
#endif

            for (int j = 0; j < 64; ++j) o += P[i][j] * vs[j][t];
            Qd[(size_t)(rb + i) * 1024 + h * 128 + t] = (unsigned short)mk::f2bf(o); }
#pragma unroll
        for (int c = 0; c < 128; ++c) { float u = 0.f; for (int j = 0; j < 64; ++j) u += k[j][c] * vs[j][t];
#ifdef ZERO_STATE
            S[c] = 0.f;
#elif defined(UNIT_SIDE)
            S[c] = S[c] + u;
#else
            S[c] = dec[c] * S[c] + e2[c] * u;
#endif
        }
        __syncthreads();
    }
}

#ifndef MK_CUT
#define MK_CUT 1
#endif
#ifndef MK_ONE_LAUNCH
#define MK_ONE_LAUNCH 0
#endif
static void gemm(hipStream_t s, const float* A, int lda, const float* B, int ldb, float* C, int ldc, int M, int N, int K) {
    dim3 g(N / 64, (M + 63) / 64);
    hipLaunchKernelGGL(k_gemm, g, dim3(256), 0, s, A, lda, B, ldb, C, ldc, M, N, K);
}

extern "C" void kernel_launch(void* const* d_in, const int* in_sizes, int n_in, void* d_out, int out_size, void* d_ws, size_t ws_size, hipStream_t stream) {
    const float* norm_g = (const float*)d_in[6];
    const float* lru_w_in = (const float*)d_in[11]; const float* lru_cw = (const float*)d_in[12]; const float* lru_cb = (const float*)d_in[13];
    const float* lru_wa = (const float*)d_in[14]; const float* lru_ba = (const float*)d_in[15]; const float* lru_wx = (const float*)d_in[16]; const float* lru_bx = (const float*)d_in[17];
    const float* lru_lam = (const float*)d_in[18]; const float* lru_w_out = (const float*)d_in[19];
    const float* ffn_up = (const float*)d_in[20]; const float* ffn_cw = (const float*)d_in[21]; const float* ffn_cb = (const float*)d_in[22]; const float* ffn_down = (const float*)d_in[23];
    const float* final_g = (const float*)d_in[24];
    float* out = (float*)d_out;
    char* ws = (char*)d_ws;
    static int grid = 0;
    if (grid == 0) {
        int dev = 0, cus = 0, per_cu = 0;
        hipGetDevice(&dev); hipDeviceGetAttribute(&cus, hipDeviceAttributeMultiprocessorCount, dev);
        hipFuncSetAttribute((const void*)mk::mega, hipFuncAttributeMaxDynamicSharedMemorySize, mk::LDS_BYTES);
        hipOccupancyMaxActiveBlocksPerMultiprocessor(&per_cu, (const void*)mk::mega, mk::NTHR, mk::LDS_BYTES);
        (void)hipGetLastError();
        if (per_cu < 1) fprintf(stderr, "kernel_launch: occupancy query says %d blocks/CU\n", per_cu);
        grid = cus > 0 ? cus : 256;
    }
    hipMemsetAsync(ws + mk::WS_CTL, 0, 1u << 20, stream);
    mk::Args a{};
    for (int i = 0; i < 25; ++i) a.in[i] = (const float*)d_in[i];
    a.out = out; a.ws = (unsigned char*)d_ws;
    const int nph = (MK_CUT == 1) ? 6 : (MK_CUT == 2) ? 9 : (MK_CUT == 3) ? 17 : 21;
#if MK_ONE_LAUNCH
    a.ph_lo = 0; a.ph_hi = nph;
    hipLaunchKernelGGL(mk::mega, dim3(grid), dim3(mk::NTHR), mk::LDS_BYTES, stream, a);
#else
    for (int p = 0; p < nph; ++p) { a.ph_lo = p; a.ph_hi = p + 1;
#ifdef CMP_SCAN
        if (p == 3) { unsigned short* A0 = (unsigned short*)(ws + mk::WS_ACT); const size_t SL = mk::ACT_SLOT / 2; int* flag = (int*)(ws + 255 * (1u << 20));
            hipMemcpyAsync(d_out, A0, mk::ACT_SLOT, hipMemcpyDeviceToDevice, stream);
            hipLaunchKernelGGL(k_refscan, dim3(32), dim3(128), 0, stream, (unsigned short*)d_out, A0 + SL, A0 + 2 * SL, A0 + 3 * SL, A0 + 4 * SL, (const float*)(ws + mk::WS_SIDE));
            hipMemcpyAsync(A0 + 2 * SL, A0 + 2 * SL, 0, hipMemcpyDeviceToDevice, stream);
            hipLaunchKernelGGL(mk::mega, dim3(grid), dim3(mk::NTHR), mk::LDS_BYTES, stream, a);
            hipLaunchKernelGGL(k_flag1000, dim3(1), dim3(64), 0, stream, flag);
            hipLaunchKernelGGL(k_cmpscan, dim3(132, 16), dim3(256), 0, stream, A0, (const unsigned short*)d_out, flag);
            { const size_t n = (size_t)16384 * 1024; hipLaunchKernelGGL(k_diagout2, dim3((n + 255) / 256), dim3(256), 0, stream, (float*)d_out, n, flag); }
            return; }
#endif
#ifdef USE_REFSCAN
        if (p == 3) { unsigned short* A0 = (unsigned short*)(ws + mk::WS_ACT); const size_t SL = mk::ACT_SLOT / 2;
            hipLaunchKernelGGL(k_refscan, dim3(32), dim3(128), 0, stream, A0, A0 + SL, A0 + 2 * SL, A0 + 3 * SL, A0 + 4 * SL, (const float*)(ws + mk::WS_SIDE)); continue; }
#endif
        hipLaunchKernelGGL(mk::mega, dim3(grid), dim3(mk::NTHR), mk::LDS_BYTES, stream, a); }
#endif
    const size_t MB = 1u << 20;
    float* CXLAT = (float*)(ws + mk::WS_CXLAT);
    float* MOD = (float*)(ws + mk::WS_MOD);
    char* arena = ws + 14 * MB;
    const size_t RBD = (size_t)RB * D * 4;
    float* BUF_H = (float*)(arena);
    float* BUF_O = (float*)(arena + RBD);
    float* BUF_Z = (float*)(arena + 2 * RBD);
    auto ffn = [&](int l, float* lat_seq, int seq_len, const float* modv) {
        const float* sh2 = modv + 3 * D; const float* sc2 = modv + 4 * D; const float* g2 = modv + 5 * D;
        const float* Wup = ffn_up + (size_t)l * D * 2 * DFF; const float* Wdn = ffn_down + (size_t)l * DFF * D;
        const float* cw = ffn_cw + (size_t)l * 3 * 2 * DFF; const float* cb = ffn_cb + (size_t)l * 2 * DFF;
        float* Hn = BUF_H;
        hipLaunchKernelGGL(k_norm_mod, dim3(seq_len), dim3(256), 0, stream, lat_seq, Hn, norm_g + (size_t)(l * 2 + 1) * D, sh2, sc2, seq_len);
        const int CH = 2048;
        float* U = BUF_Z; float* G = BUF_Z + (size_t)(CH + 2) * 2 * DFF; float* Y = G + (size_t)CH * DFF;
        for (int r0 = 0; r0 < seq_len; r0 += CH) {
            const int r1 = (r0 + CH < seq_len) ? r0 + CH : seq_len;
            const int u0 = r0 > 0 ? r0 - 1 : 0, u1 = r1 < seq_len ? r1 + 1 : seq_len;
            gemm(stream, Hn + (size_t)u0 * D, D, Wup, 2 * DFF, U, 2 * DFF, u1 - u0, 2 * DFF, D);
            const size_t n = (size_t)(r1 - r0) * DFF;
            hipLaunchKernelGGL(k_ffn_conv, dim3((n + 255) / 256), dim3(256), 0, stream, U, u0, cw, cb, G, r0, r1, seq_len);
            gemm(stream, G, DFF, Wdn, D, Y, D, r1 - r0, D, DFF);
            const size_t n2 = (size_t)(r1 - r0) * D;
            hipLaunchKernelGGL(k_resid, dim3((n2 + 255) / 256), dim3(256), 0, stream, lat_seq + (size_t)r0 * D, Y, g2, lat_seq + (size_t)r0 * D, n2);
        }
    };
    for (int b = 0; b < BATCH; ++b) {
        float* latL = out + (size_t)b * SEQ * D; float* latC = CXLAT + (size_t)b * CTX * D;
        if (MK_CUT < 2) {
            const float* modL = MOD + (size_t)b * 6 * D; const float* modC = MOD + (size_t)2 * 6 * D;
            ffn(0, latL, SEQ, modL);
            ffn(0, latC, CTX, modC);
        }
        if (MK_CUT < 3) {
            const float* modL = MOD + (size_t)18 * D + (size_t)b * 6 * D; const float* modC = MOD + (size_t)18 * D + (size_t)2 * 6 * D;
            const float* ng = norm_g + (size_t)2 * D;
            hipLaunchKernelGGL(k_norm_mod, dim3(CTX), dim3(256), 0, stream, latC, BUF_H, ng, modC, modC + D, CTX);
            hipLaunchKernelGGL(k_norm_mod, dim3(SEQ), dim3(256), 0, stream, latL, BUF_H + (size_t)CTX * D, ng, modL, modL + D, SEQ);
            float* Z2 = BUF_Z; float* XC = BUF_Z + (size_t)RB * 2 * D; float* PA = XC + (size_t)RB * D; float* PX = PA + (size_t)RB * D;
            float* Hf = BUF_H; float* Hb = BUF_O;
            gemm(stream, BUF_H, D, lru_w_in, 2 * D, Z2, 2 * D, RB, 2 * D, D);
            { const size_t n = (size_t)RB * D; hipLaunchKernelGGL(k_lru_conv, dim3((n + 255) / 256), dim3(256), 0, stream, Z2, lru_cw, lru_cb, XC); }
            for (int d = 0; d < 2; ++d) {
                for (int nb = 0; nb < 4; ++nb) {
                    gemm(stream, XC + nb * 256, D, lru_wa + (size_t)(d * 4 + nb) * 256 * 256, 256, PA + nb * 256, D, RB, 256, 256);
                    gemm(stream, XC + nb * 256, D, lru_wx + (size_t)(d * 4 + nb) * 256 * 256, 256, PX + nb * 256, D, RB, 256, 256);
                }
                hipLaunchKernelGGL(k_lru_scan, dim3(D / 64), dim3(64), 0, stream, XC, PA, PX, lru_ba, lru_bx, lru_lam, d ? Hb : Hf, d);
            }
            float* Y = PA;
            { const size_t n = (size_t)SEQ * D; hipLaunchKernelGGL(k_lru_out, dim3((n + 255) / 256), dim3(256), 0, stream, Hf, Hb, Z2, Y); }
            float* Y2 = PX;
            gemm(stream, Y, D, lru_w_out, D, Y2, D, SEQ, D, D);
            { const size_t n = (size_t)SEQ * D; hipLaunchKernelGGL(k_resid, dim3((n + 255) / 256), dim3(256), 0, stream, latL, Y2, modL + 2 * D, latL, n); }
        }
        if (MK_CUT < 4) {
            const float* modL = MOD + (size_t)18 * D + (size_t)b * 6 * D;
            ffn(1, latL, SEQ, modL);
            hipLaunchKernelGGL(k_norm_mod, dim3(SEQ), dim3(256), 0, stream, latL, latL, final_g, (const float*)nullptr, (const float*)nullptr, SEQ);
        }
    }
}
```

```cpp
#define MK_CUT 4
#define MK_ONE_LAUNCH 1
#include <hip/hip_runtime.h>
#include <cstdint>
#include <cstdio>

constexpr int D = 1024, BATCH = 2, SEQ = 8192, CTX = 256, GW = 64, GROWS = SEQ / GW;
constexpr int NH = 8, DK = 128, DV = 128, DFF = 2816;
constexpr int RB = CTX + SEQ;
constexpr float EPS = 1e-6f;

__device__ __forceinline__ float sigmoidf_(float x) { return 1.f / (1.f + __expf(-x)); }
__device__ __forceinline__ float siluf_(float x) { return x * sigmoidf_(x); }
__device__ __forceinline__ float gelu_tanh(float x) { const float k = 0.7978845608028654f; return 0.5f * x * (1.f + tanhf(k * (x + 0.044715f * x * x * x))); }

__global__ void k_adaln(const float* __restrict__ c, const float* __restrict__ cctx, const float* __restrict__ W, const float* __restrict__ bias, float* __restrict__ mod) {
    __shared__ float s[3][D];
    for (int i = threadIdx.x; i < D; i += blockDim.x) { s[0][i] = siluf_(c[i]); s[1][i] = siluf_(c[D + i]); s[2][i] = siluf_(cctx[i]); }
    __syncthreads();
    const int j = blockIdx.x * blockDim.x + threadIdx.x;
    if (j >= 6 * D) return;
    float a0 = 0.f, a1 = 0.f, a2 = 0.f;
    for (int k = 0; k < D; ++k) { const float w = W[(size_t)k * 6 * D + j]; a0 += s[0][k] * w; a1 += s[1][k] * w; a2 += s[2][k] * w; }
    const float bb = bias[j];
    mod[j] = a0 + bb; mod[6 * D + j] = a1 + bb; mod[12 * D + j] = a2 + bb;
}

__global__ void k_lb(const float* __restrict__ logits, float* __restrict__ lb) {
    const int i = blockIdx.x * blockDim.x + threadIdx.x;
    if (i >= 2 * D) return;
    const float l0 = logits[i], l1 = logits[2 * D + i];
    const float m = fmaxf(l0, l1), e0 = __expf(l0 - m), e1 = __expf(l1 - m);
    lb[i] = e0 / (e0 + e1);
}

__global__ void k_norm_mod(const float* in, float* out, const float* __restrict__ g, const float* __restrict__ sh, const float* __restrict__ sc, int rows) {
    const int r = blockIdx.x; if (r >= rows) return;
    const float* x = in + (size_t)r * D; float* o = out + (size_t)r * D;
    float v[4]; float ss = 0.f;
    for (int i = 0; i < 4; ++i) { v[i] = x[threadIdx.x + 256 * i]; ss += v[i] * v[i]; }
    __shared__ float red[256];
    red[threadIdx.x] = ss; __syncthreads();
    for (int s = 128; s > 0; s >>= 1) { if (threadIdx.x < s) red[threadIdx.x] += red[threadIdx.x + s]; __syncthreads(); }
    const float rstd = rsqrtf(red[0] / D + EPS);
    for (int i = 0; i < 4; ++i) { const int cidx = threadIdx.x + 256 * i; float y = v[i] * rstd * g[cidx]; if (sc) y = y * (1.f + sc[cidx]) + sh[cidx]; o[cidx] = y; }
}

__global__ void __launch_bounds__(256) k_gemm(const float* __restrict__ A, int lda, const float* __restrict__ B, int ldb, float* __restrict__ C, int ldc, int M, int N, int K) {
    __shared__ float As[16][64 + 4], Bs[16][64 + 4];
    const int tx = threadIdx.x % 16, ty = threadIdx.x / 16;
    const int m0 = blockIdx.y * 64, n0 = blockIdx.x * 64;
    float acc[4][4] = {};
    for (int k0 = 0; k0 < K; k0 += 16) {
        for (int i = threadIdx.x; i < 64 * 16; i += 256) { const int r = i / 16, kk = i % 16; As[kk][r] = (m0 + r < M) ? A[(size_t)(m0 + r) * lda + k0 + kk] : 0.f; }
        for (int i = threadIdx.x; i < 64 * 16; i += 256) { const int kk = i / 64, cc = i % 64; Bs[kk][cc] = B[(size_t)(k0 + kk) * ldb + n0 + cc]; }
        __syncthreads();
#pragma unroll
        for (int kk = 0; kk < 16; ++kk) {
            float a[4], b[4];
#pragma unroll
            for (int i = 0; i < 4; ++i) { a[i] = As[kk][ty * 4 + i]; b[i] = Bs[kk][tx * 4 + i]; }
#pragma unroll
            for (int i = 0; i < 4; ++i)
#pragma unroll
                for (int j = 0; j < 4; ++j) acc[i][j] += a[i] * b[j];
        }
        __syncthreads();
    }
    for (int i = 0; i < 4; ++i) { const int r = m0 + ty * 4 + i; if (r < M) for (int j = 0; j < 4; ++j) C[(size_t)r * ldc + n0 + tx * 4 + j] = acc[i][j]; }
}

__global__ void __launch_bounds__(128) k_hgrn_scan(const float* __restrict__ Z, const float* __restrict__ lb, float* __restrict__ Of, float* __restrict__ Ob) {
    const int h = blockIdx.x, d = blockIdx.y, t = threadIdx.x;
    float* O = d ? Ob : Of;
    __shared__ float sq[DK], sf[DK], sk[DK];
    float S[DK];
#pragma unroll
    for (int i = 0; i < DK; ++i) S[i] = 0.f;
    const float lbv = lb[d * D + h * DK + t];
    for (int step = 0; step < RB; ++step) {
        int row;
        if (step < CTX) row = d ? (CTX - 1 - step) : step;
        else { const int s = step - CTX; row = CTX + (d ? (SEQ - 1 - s) : s); }
        const float* z = Z + (size_t)row * 5 * D;
        const float qv = siluf_(z[h * DK + t]);
        const float f = lbv + (1.f - lbv) * sigmoidf_(z[(1 + d) * D + h * DK + t]);
        sq[t] = qv; sf[t] = f; sk[t] = 1.f - f;
        const float v = z[3 * D + h * DV + t];
        __syncthreads();
        float o = 0.f;
#pragma unroll
        for (int i = 0; i < DK; ++i) { S[i] = sf[i] * S[i] + sk[i] * v; o += sq[i] * S[i]; }
        O[(size_t)row * D + h * DV + t] = o;
        __syncthreads();
    }
}

__global__ void __launch_bounds__(128) k_hgrn_readout(const float* Of, const float* Ob, const float* __restrict__ Z, const float* __restrict__ gn, float* R, int rows) {
    const int r = blockIdx.x; if (r >= rows) return;
    __shared__ float red[128];
    for (int h = 0; h < NH; ++h) {
        const int cidx = h * DV + threadIdx.x;
        const float o = Of[(size_t)r * D + cidx] + Ob[(size_t)r * D + cidx];
        red[threadIdx.x] = o * o; __syncthreads();
        for (int s = 64; s > 0; s >>= 1) { if (threadIdx.x < s) red[threadIdx.x] += red[threadIdx.x + s]; __syncthreads(); }
        const float rstd = rsqrtf(red[0] / DV + EPS);
        __syncthreads();
        const float gte = siluf_(Z[(size_t)r * 5 * D + 4 * D + cidx]);
        R[(size_t)r * D + cidx] = o * rstd * gn[threadIdx.x] * gte;
    }
}

__global__ void k_resid(const float* base, const float* Y, const float* __restrict__ gate, float* out, size_t n) {
    const size_t i = (size_t)blockIdx.x * blockDim.x + threadIdx.x; if (i >= n) return;
    out[i] = base[i] + gate[i % D] * Y[i];
}

__global__ void k_ffn_conv(const float* __restrict__ U, int urow0, const float* __restrict__ cw, const float* __restrict__ cb, float* __restrict__ G, int r0, int r1, int seq_len) {
    const size_t i = (size_t)blockIdx.x * blockDim.x + threadIdx.x;
    const size_t n = (size_t)(r1 - r0) * DFF; if (i >= n) return;
    const int r = r0 + (int)(i / DFF), cidx = (int)(i % DFF);
    float u[2];
    for (int half = 0; half < 2; ++half) {
        const int cc = cidx + half * DFF; float a = cb[cc];
        for (int k = 0; k < 3; ++k) { const int rr = r + k - 1; if (rr >= 0 && rr < seq_len) a += cw[k * 2 * DFF + cc] * U[(size_t)(rr - urow0) * 2 * DFF + cc]; }
        u[half] = a;
    }
    G[i] = siluf_(u[0]) * u[1];
}

__device__ __forceinline__ int lat_row_of_cm(int p) { return CTX + (p % GROWS) * GW + p / GROWS; }
__global__ void k_lru_conv(const float* __restrict__ Z2, const float* __restrict__ cw, const float* __restrict__ cb, float* __restrict__ XC) {
    const size_t i = (size_t)blockIdx.x * blockDim.x + threadIdx.x; if (i >= (size_t)RB * D) return;
    const int pos = (int)(i / D), cidx = (int)(i % D);
    float a = cb[cidx];
    if (pos < CTX) { for (int k = 0; k < 4; ++k) { const int pp = pos + k - 2; if (pp >= 0 && pp < CTX) a += cw[k * D + cidx] * Z2[(size_t)pp * 2 * D + D + cidx]; } }
    else { const int p = pos - CTX; for (int k = 0; k < 4; ++k) { const int pp = p + k - 2; if (pp >= 0 && pp < SEQ) a += cw[k * D + cidx] * Z2[(size_t)lat_row_of_cm(pp) * 2 * D + D + cidx]; } }
    XC[i] = a;
}
__global__ void k_lru_scan(const float* __restrict__ XC, const float* __restrict__ PA, const float* __restrict__ PX, const float* __restrict__ ba, const float* __restrict__ bx, const float* __restrict__ lam, float* __restrict__ Hd, int d) {
    const int cidx = blockIdx.x * blockDim.x + threadIdx.x; if (cidx >= D) return;
    const float bav = ba[d * D + cidx], bxv = bx[d * D + cidx];
    const float l = lam[d * D + cidx]; const float sp = (l > 0.f) ? log1pf(__expf(-l)) : (-l + log1pf(__expf(l)));
    float h = 0.f;
    for (int step = 0; step < RB; ++step) {
        int pos;
        if (step < CTX) pos = d ? (CTX - 1 - step) : step;
        else { const int s = step - CTX; pos = CTX + (d ? (SEQ - 1 - s) : s); }
        const size_t o = (size_t)pos * D + cidx;
        const float r = sigmoidf_(PA[o] + bav), ig = sigmoidf_(PX[o] + bxv);
        const float la = -8.f * r * sp; const float a = __expf(la); const float mult = sqrtf(-expm1f(2.f * la));
        h = a * h + mult * (ig * XC[o]);
        Hd[o] = h;
    }
}
__global__ void k_lru_out(const float* __restrict__ Hf, const float* __restrict__ Hb, const float* __restrict__ Z2, float* __restrict__ Y) {
    const size_t i = (size_t)blockIdx.x * blockDim.x + threadIdx.x; if (i >= (size_t)SEQ * D) return;
    const int t = (int)(i / D), cidx = (int)(i % D);
    const int p = (t % GW) * GROWS + t / GW; const size_t o = (size_t)(CTX + p) * D + cidx;
    Y[i] = (Hf[o] + Hb[o]) * gelu_tanh(Z2[(size_t)(CTX + t) * 2 * D + cidx]);
}
__global__ void k_copy(const float* __restrict__ a, float* __restrict__ b, size_t n) { const size_t i = (size_t)blockIdx.x * blockDim.x + threadIdx.x; if (i < n) b[i] = a[i]; }


namespace mk {
#define LAS __attribute__((address_space(3)))
typedef unsigned short bf16_t;
typedef short bf16x8 __attribute__((ext_vector_type(8)));
typedef short s16x4 __attribute__((ext_vector_type(4)));
typedef float f32x4 __attribute__((ext_vector_type(4)));
typedef float f32x2 __attribute__((ext_vector_type(2)));
typedef unsigned u32x4 __attribute__((ext_vector_type(4)));
typedef unsigned u32x2 __attribute__((ext_vector_type(2)));

constexpr int NWAVES = 8, NTHR = 512;
constexpr int MT = 16896, ML = 16384, NTM = 66;
constexpr size_t MiB = 1u << 20;
constexpr size_t WS_CTL = 0;
constexpr size_t WS_MOD = 1 * MiB;
constexpr size_t WS_LB = WS_MOD + 160 * 1024;
constexpr size_t WS_CXLAT = 2 * MiB;
constexpr size_t WS_SIDE = 4 * MiB;
constexpr size_t WS_UEDGE = 10 * MiB + 512 * 1024;
constexpr size_t WS_W_HGIN = 14 * MiB, WS_W_HGOUT = 24 * MiB, WS_W_UP = 26 * MiB, WS_W_DN0 = 37 * MiB;
constexpr size_t WS_W_LRUIN = 43 * MiB, WS_W_GATES = 47 * MiB, WS_W_LRUOUT = 49 * MiB, WS_W_DN1 = 51 * MiB;
constexpr size_t WS_ACT = 57 * MiB, ACT_SLOT = 33 * MiB;
constexpr int CW_BAR = 4096;
constexpr int STAGE_BYTES = 131072;
constexpr int EPI_OFF = STAGE_BYTES;
constexpr int MISC_OFF = STAGE_BYTES + 12288;
constexpr int LDS_BYTES = 147456;

#define LDS_WAIT() asm volatile("s_waitcnt lgkmcnt(0)" ::: "memory")
#define VM_WAIT() asm volatile("s_waitcnt vmcnt(0)" ::: "memory")
__device__ __forceinline__ unsigned f2bf(float f) { unsigned u = __builtin_bit_cast(unsigned, f); return (u + 0x7fffu + ((u >> 16) & 1u)) >> 16; }
__device__ __forceinline__ unsigned pk2(float lo, float hi) { return f2bf(lo) | (f2bf(hi) << 16); }
__device__ __forceinline__ float bf2f(unsigned short h) { return __builtin_bit_cast(float, (unsigned)h << 16); }
__device__ __forceinline__ float bflo(unsigned w) { return __builtin_bit_cast(float, w << 16); }
__device__ __forceinline__ float bfhi(unsigned w) { return __builtin_bit_cast(float, w & 0xffff0000u); }
__device__ __forceinline__ float fsigmoid(float x) { return __builtin_amdgcn_rcpf(1.f + __expf(-x)); }
__device__ __forceinline__ float fsilu(float x) { return x * fsigmoid(x); }
__device__ __forceinline__ float fgelu_tanh(float x) { const float u = 0.7978845608028654f * (x + 0.044715f * x * x * x); const float e = __expf(2.f * u); return x * (1.f - __builtin_amdgcn_rcpf(e + 1.f)); }
__device__ __forceinline__ int lane_id_v() { int le; asm volatile("v_mbcnt_lo_u32_b32 %0, -1, 0\n\tv_mbcnt_hi_u32_b32 %0, -1, %0" : "=v"(le)); return le; }
__device__ __forceinline__ float wave_sum(float v) {
#pragma unroll
    for (int o = 1; o < 64; o <<= 1) v += __shfl_xor(v, o);
    return v;
}

#define XB_TMO      128
#define XB_XCNT(j)  (256  + 64 * (j))
#define XB_XSUB(j)  (1280 + 64 * (j))
#define XB_XGEN(j)  (2304 + 64 * (j))
#define XB_TOP      3328
#define XB_TOPGEN   3392
#define XCD_BAR_WORDS 3456
#define XB_SPIN_CAP (1u << 20)
__device__ __forceinline__ unsigned xb_ld(unsigned* p)              { return __hip_atomic_load(p, __ATOMIC_RELAXED, __HIP_MEMORY_SCOPE_AGENT); }
__device__ __forceinline__ unsigned xb_add(unsigned* p, unsigned v) { return __hip_atomic_fetch_add(p, v, __ATOMIC_RELAXED, __HIP_MEMORY_SCOPE_AGENT); }
__device__ __forceinline__ unsigned xb_xcc_id() { return (unsigned)__builtin_amdgcn_s_getreg((3 << 11) | 20) & 0xFu; }
#define XB_SPIN(cond, bar) do { unsigned _sp = 0; while (cond) { __builtin_amdgcn_s_sleep(1); \
    if ((++_sp & 255u) == 0u) { if (xb_ld(&(bar)[XB_TMO])) break; if (_sp > XB_SPIN_CAP) { atomicAdd(&(bar)[XB_TMO], 1u); break; } } } } while (0)
struct XcdBarrier { unsigned* bar; unsigned x; volatile LAS unsigned* st; };
__device__ __forceinline__ XcdBarrier xcd_barrier_post(unsigned* bar, volatile LAS unsigned* st) {
    XcdBarrier b; b.bar = bar; b.x = xb_xcc_id(); b.st = st;
    if (threadIdx.x == 0) (void)xb_add(&bar[XB_XCNT(b.x)], 1u);
    return b;
}
__device__ __forceinline__ void xcd_barrier_complete(unsigned* bar, unsigned x, unsigned& nloc, unsigned& nx) {
    const unsigned G = gridDim.x * gridDim.y * gridDim.z;
    unsigned sum, cnt, mine, sp = 0u;
    for (;;) {
        sum = 0u; cnt = 0u; mine = 0u;
#pragma unroll
        for (unsigned j = 0; j < 16; ++j) { const unsigned c = xb_ld(&bar[XB_XCNT(j)]); sum += c; cnt += (c > 0u) ? 1u : 0u; mine = (j == x) ? c : mine; }
        if (sum == G) break;
        __builtin_amdgcn_s_sleep(1);
        if ((++sp & 255u) == 0u) { if (xb_ld(&bar[XB_TMO])) break; if (sp > XB_SPIN_CAP) { atomicAdd(&bar[XB_TMO], 1u); break; } }
    }
    nloc = mine > 0u ? mine : 1u; nx = cnt > 0u ? cnt : 1u;
}
__device__ __forceinline__ void xcd_barrier(const XcdBarrier& b, int wave_s) {
    asm volatile("s_waitcnt vmcnt(0)" ::: "memory");
    __syncthreads();
    if (wave_s == 0 && lane_id_v() == 0) {
        unsigned* bar = b.bar;
        __builtin_amdgcn_s_waitcnt(0);
        unsigned nloc = b.st[0], nx = b.st[1];
        if (nloc == 0u) { xcd_barrier_complete(bar, b.x, nloc, nx); b.st[0] = nloc; b.st[1] = nx; }
        const unsigned old = xb_add(&bar[XB_XSUB(b.x)], 1u);
        const unsigned gen = old / nloc;
        if (old + 1u == (gen + 1u) * nloc) {
            __builtin_amdgcn_fence(__ATOMIC_RELEASE, "agent");
            asm volatile("s_waitcnt vmcnt(0)" ::: "memory");
            const unsigned og = xb_add(&bar[XB_TOP], 1u);
            const unsigned tg = og / nx;
            if (og + 1u == (tg + 1u) * nx) xb_add(&bar[XB_TOPGEN], 1u);
            else XB_SPIN(xb_ld(&bar[XB_TOPGEN]) == tg, bar);
            __builtin_amdgcn_fence(__ATOMIC_ACQUIRE, "agent");
            xb_add(&bar[XB_XGEN(b.x)], 1u);
            asm volatile("s_waitcnt vmcnt(0)" ::: "memory");
        } else {
            XB_SPIN(xb_ld(&bar[XB_XGEN(b.x)]) == gen, bar);
            __builtin_amdgcn_fence(__ATOMIC_ACQUIRE, "agent");
            asm volatile("s_waitcnt vmcnt(0)" ::: "memory");
        }
    }
    __syncthreads();
}

constexpr int BM = 256, BK = 64, HALF = 128, HTB = HALF * BK * 2, NXCD = 8, WGM = 8;
__host__ __device__ __forceinline__ int lds_byte(int r, int c) { const int st = (r >> 4) * 2 + (c >> 5), rr = r & 15, cc = c & 31, ob = rr * 64 + cc * 2; return st * 1024 + (ob ^ (((ob >> 9) & 1) << 5)); }
__host__ __device__ __forceinline__ void stage_rc(int b, int& R, int& C) { const int st = b / 1024, sb = b % 1024, swz = sb ^ (((sb >> 9) & 1) << 5); R = (st >> 1) * 16 + swz / 64; C = (st & 1) * 32 + (swz % 64) / 2; }
struct Unit { int pm, pn; };
struct Gemm { const bf16_t* A; const bf16_t* Bt; int lda, ldb, K; int acol_shift, acol_step; int ksplit; };
struct StaticOrder {
    int nM, nN, nwg, G, c, pm_off;
    __device__ __forceinline__ void init(int nM_, int nN_, int G_, int c_, int pm_off_ = 0) { nM = nM_; nN = nN_; nwg = nM * nN; G = G_; c = c_; pm_off = pm_off_; }
    __device__ __forceinline__ bool next(int i, Unit& u) const {
        const long L = (long)i * G + c; if (L >= nwg) return false;
        int wgid = (int)L; { const int q = nwg / NXCD, r = nwg % NXCD, xcd = wgid % NXCD, off = wgid / NXCD; wgid = (xcd < r ? xcd * (q + 1) : r * (q + 1) + (xcd - r) * q) + off; }
        const int nig = WGM * nN, gid = wgid / nig, fm = gid * WGM, gsz = (nM - fm) < WGM ? (nM - fm) : WGM;
        u.pm = pm_off + fm + ((wgid % nig) % gsz); u.pn = (wgid % nig) / gsz; return true;
    }
};
typedef __bf16 bf16x2_t __attribute__((ext_vector_type(2)));
__device__ __forceinline__ unsigned cvt_pk_bf16(float lo, float hi) { f32x2 v = {lo, hi}; bf16x2_t b = __builtin_convertvector(v, bf16x2_t); return __builtin_bit_cast(unsigned, b); }

template <class Epi>
__device__ __forceinline__ void gemm_phase(LAS unsigned char* lds, const Gemm g, const StaticOrder& S, const Epi& E, int wave_s) {
    const int wid = wave_s, lane = lane_id_v(), tid = wid * 64 + lane, wr = wid >> 2, wc = wid & 3, fr = lane & 15, fq = lane >> 4;
    const int K = g.K, nt = K / BK;
    unsigned voffA[2], voffB[2];
#pragma unroll
    for (int i = 0; i < 2; ++i) { int R, C; stage_rc(tid * 16 + i * 8192, R, C); voffA[i] = (unsigned)(R * g.lda + C) * 2u; voffB[i] = (unsigned)(R * g.ldb + C) * 2u; }
    const size_t kstep = (size_t)(BK * 2);
    const size_t hstepA = (size_t)HALF * g.lda * 2, hstepB = (size_t)HALF * g.ldb * 2;
    const size_t tstepA = 2 * hstepA, tstepB = 2 * hstepB;
    const unsigned ldsw = (unsigned)wid * 1024u;
    const int aoff = lds_byte(wr * 64 + fr, fq * 8), boff = lds_byte(wc * 32 + fr, fq * 8);
#define PG8_SA(b, h) (((b) * 2 + (h)) * HTB)
#define PG8_SB(b, h) ((4 + (b) * 2 + (h)) * HTB)
#define PG8_STAGE(bufoff, gbase, voff) do { _Pragma("unroll") for (int _i = 0; _i < 2; ++_i) \
        __builtin_amdgcn_global_load_lds((const unsigned*)((const char*)(gbase) + (voff)[_i]), (LAS unsigned*)(lds + (bufoff) + ldsw + _i * 8192), 16, 0, 0); } while (0)
#define PG8_LDA(dst, b, h) do { _Pragma("unroll") for (int m = 0; m < 4; ++m) _Pragma("unroll") for (int k = 0; k < 2; ++k) dst[m][k] = *(const LAS bf16x8*)(lds + PG8_SA(b, h) + aoff + m * 2048 + k * 1024); } while (0)
#define PG8_LDB(dst, b, h) do { _Pragma("unroll") for (int n = 0; n < 2; ++n) _Pragma("unroll") for (int k = 0; k < 2; ++k) dst[n][k] = *(const LAS bf16x8*)(lds + PG8_SB(b, h) + boff + n * 2048 + k * 1024); } while (0)
#define PG8_MMA(ai, bj, At, Bt) do { __builtin_amdgcn_s_setprio(1); _Pragma("unroll") for (int m = 0; m < 4; ++m) _Pragma("unroll") for (int n = 0; n < 2; ++n) _Pragma("unroll") for (int k = 0; k < 2; ++k) \
        acc[ai][bj][m][n] = __builtin_amdgcn_mfma_f32_16x16x32_bf16(Bt[n][k], At[m][k], acc[ai][bj][m][n], 0, 0, 0); __builtin_amdgcn_s_setprio(0); } while (0)
#define PG8_WAIT_V(n) asm volatile("s_waitcnt vmcnt(" #n ")" ::: "memory")
#define PG8_WAIT_L(n) asm volatile("s_waitcnt lgkmcnt(" #n ")" ::: "memory")
#define PG8_BAR __builtin_amdgcn_s_barrier()
#define PG8_SCHED __builtin_amdgcn_sched_barrier(0)
    Unit cur, nxt; int ui = 0;
    if (!S.next(0, cur)) return;
    f32x4 acc[2][2][4][2];
#pragma unroll
    for (int a = 0; a < 2; ++a)
#pragma unroll
        for (int b = 0; b < 2; ++b)
#pragma unroll
            for (int m = 0; m < 4; ++m)
#pragma unroll
                for (int n = 0; n < 2; ++n) acc[a][b][m][n] = (f32x4){0.f, 0.f, 0.f, 0.f};
    bf16x8 At[4][2], B0[2][2], B1[2][2];
#define PG8_UA(u_) ((const char*)g.A + (size_t)(u_).pm * tstepA + (size_t)(((u_).pn >> g.acol_shift) * g.acol_step + ((u_).pn % g.ksplit) * (g.ksplit > 1 ? g.K : 0)) * 2)
#define PG8_UB(u_) ((const char*)g.Bt + (size_t)((u_).pn / g.ksplit) * tstepB + (size_t)(((u_).pn % g.ksplit) * (g.ksplit > 1 ? g.K : 0)) * 2)
    const char* cA = PG8_UA(cur); const char* cB = PG8_UB(cur);
    {
        PG8_STAGE(PG8_SB(0, 0), cB, voffB); PG8_STAGE(PG8_SB(0, 1), cB + hstepB, voffB); PG8_STAGE(PG8_SA(0, 0), cA, voffA); PG8_STAGE(PG8_SA(0, 1), cA + hstepA, voffA);
        if (wr == 1) PG8_BAR;
        PG8_WAIT_V(2); PG8_BAR;
        PG8_STAGE(PG8_SB(1, 0), cB + kstep, voffB); PG8_STAGE(PG8_SA(1, 0), cA + kstep, voffA); PG8_STAGE(PG8_SB(1, 1), cB + hstepB + kstep, voffB);
        PG8_WAIT_V(6); PG8_BAR;
    }
    for (;;) {
        const bool has_next = S.next(ui + 1, nxt);
        const char* nA = has_next ? PG8_UA(nxt) : cA; const char* nB = has_next ? PG8_UB(nxt) : cB;
#pragma unroll 1
        for (int t = 0; t < nt; t += 2) {
            const bool last = (t == nt - 2);
            const char* a1 = cA + (size_t)(t + 1) * kstep;
            const char* a2 = last ? nA : cA + (size_t)(t + 2) * kstep; const char* b2 = last ? nB : cB + (size_t)(t + 2) * kstep;
            const char* a3 = a2 + kstep; const char* b3 = b2 + kstep;
            PG8_LDB(B0, 0, 0); PG8_LDB(B1, 0, 1); PG8_SCHED; PG8_LDA(At, 0, 0); PG8_STAGE(PG8_SA(1, 1), a1 + hstepA, voffA);
            PG8_WAIT_V(8); PG8_WAIT_L(0); PG8_BAR; PG8_MMA(0, 0, At, B0); PG8_MMA(0, 1, At, B1); PG8_BAR; PG8_SCHED;
            PG8_LDA(At, 0, 1); PG8_STAGE(PG8_SB(0, 0), b2, voffB); PG8_STAGE(PG8_SB(0, 1), b2 + hstepB, voffB); PG8_STAGE(PG8_SA(0, 0), a2, voffA);
            PG8_WAIT_V(8); PG8_WAIT_L(0); PG8_BAR; PG8_MMA(1, 0, At, B0); PG8_MMA(1, 1, At, B1); PG8_BAR; PG8_SCHED;
            PG8_LDB(B0, 1, 0); PG8_LDB(B1, 1, 1); PG8_SCHED; PG8_LDA(At, 1, 0); PG8_STAGE(PG8_SA(0, 1), a2 + hstepA, voffA);
            PG8_WAIT_V(8); PG8_WAIT_L(0); PG8_BAR; PG8_MMA(0, 0, At, B0); PG8_MMA(0, 1, At, B1); PG8_BAR; PG8_SCHED;
            PG8_LDA(At, 1, 1); PG8_STAGE(PG8_SB(1, 0), b3, voffB); PG8_STAGE(PG8_SB(1, 1), b3 + hstepB, voffB); PG8_STAGE(PG8_SA(1, 0), a3, voffA);
            PG8_WAIT_V(8); PG8_WAIT_L(0); PG8_BAR; PG8_MMA(1, 0, At, B0); PG8_MMA(1, 1, At, B1); PG8_BAR; PG8_SCHED;
        }
        if (wr == 0) PG8_BAR;
        { const int le = lane_id_v();
          E(acc, cur, wr, wc, le & 15, le >> 4, lds + EPI_OFF, wid, le); }
        if (!has_next) break;
#pragma unroll
        for (int a = 0; a < 2; ++a)
#pragma unroll
            for (int b = 0; b < 2; ++b)
#pragma unroll
                for (int m = 0; m < 4; ++m)
#pragma unroll
                    for (int n = 0; n < 2; ++n) acc[a][b][m][n] = (f32x4){0.f, 0.f, 0.f, 0.f};
        cur = nxt; cA = nA; cB = nB; ++ui;
        if (wr == 1) PG8_BAR;
    }
    PG8_WAIT_V(0);
    PG8_BAR;
#undef PG8_UA
#undef PG8_UB
#undef PG8_SA
#undef PG8_SB
#undef PG8_STAGE
#undef PG8_LDA
#undef PG8_LDB
#undef PG8_MMA
#undef PG8_WAIT_V
#undef PG8_WAIT_L
#undef PG8_SCHED
}
#define MK_BAR __builtin_amdgcn_s_barrier()
#define MK_DPP(oldv, src, ctrl) __builtin_bit_cast(float, __builtin_amdgcn_update_dpp(__builtin_bit_cast(int, (float)(oldv)), __builtin_bit_cast(int, (float)(src)), ctrl, 0xF, 0xF, false))

__device__ __forceinline__ int mod_variant(int pm) { return pm < 32 ? 0 : (pm < 64 ? 1 : 2); }

struct EpiResid {
    const float* baseL; const float* baseC; float* outL; float* outC; const float* mod; int gate_off;
    __device__ __forceinline__ void operator()(const f32x4 (&acc)[2][2][4][2], const Unit& u, int wr, int wc, int fr, int fq, LAS unsigned char*, int, int) const {
        const int v = mod_variant(u.pm);
        const float* gate = mod + v * 6144 + gate_off;
        const float* base = u.pm < 64 ? baseL + (size_t)u.pm * 256 * 1024 : baseC + (size_t)(u.pm - 64) * 256 * 1024;
        float* out = u.pm < 64 ? outL + (size_t)u.pm * 256 * 1024 : outC + (size_t)(u.pm - 64) * 256 * 1024;
        const int col0 = u.pn * BM + wc * 32 + 4 * fq;
        f32x4 gv[2][2];
#pragma unroll
        for (int bj = 0; bj < 2; ++bj)
#pragma unroll
            for (int n = 0; n < 2; ++n) gv[bj][n] = *(const f32x4*)(gate + col0 + bj * HALF + n * 16);
#pragma unroll
        for (int ai = 0; ai < 2; ++ai)
#pragma unroll
            for (int m = 0; m < 4; ++m) { const size_t off = (size_t)(ai * HALF + wr * 64 + m * 16 + fr) * 1024 + col0;
#pragma unroll
                for (int bj = 0; bj < 2; ++bj)
#pragma unroll
                    for (int n = 0; n < 2; ++n) { const f32x4 bs = *(const f32x4*)(base + off + bj * HALF + n * 16); *(f32x4*)(out + off + bj * HALF + n * 16) = bs + gv[bj][n] * acc[ai][bj][m][n]; } }
    }
};


struct EpiSlab {
    float* slab; const float* mod; int gate_off; int ksplit;
    __device__ __forceinline__ void operator()(const f32x4 (&acc)[2][2][4][2], const Unit& u, int wr, int wc, int fr, int fq, LAS unsigned char*, int, int) const {
        const float* gate = mod + 2 * 6144 + gate_off;
        float* out = slab + ((size_t)(u.pn % ksplit) * 512 + (size_t)(u.pm - 64) * 256) * 1024;
        const int col0 = (u.pn / ksplit) * BM + wc * 32 + 4 * fq;
#pragma unroll
        for (int bj = 0; bj < 2; ++bj)
#pragma unroll
            for (int n = 0; n < 2; ++n) { const f32x4 gv = *(const f32x4*)(gate + col0 + bj * HALF + n * 16);
#pragma unroll
                for (int ai = 0; ai < 2; ++ai)
#pragma unroll
                    for (int m = 0; m < 4; ++m) *(f32x4*)(out + (size_t)(ai * HALF + wr * 64 + m * 16 + fr) * 1024 + col0 + bj * HALF + n * 16) = gv * acc[ai][bj][m][n]; }
    }
};

struct EpiHgIn {
    bf16_t *QmF, *KmF, *QmB, *KmB, *V, *SG; float* side; const float* lb;
    __device__ __forceinline__ void operator()(const f32x4 (&acc)[2][2][4][2], const Unit& u, int wr, int wc, int fr, int fq, LAS unsigned char*, int, int) const {
        const int row0 = u.pm * BM + wr * 64 + fr;
        if (u.pn >= 16) {
            const int col0 = (u.pn - 16) * BM + wc * 32 + 8 * fq;
#pragma unroll
            for (int ai = 0; ai < 2; ++ai)
#pragma unroll
                for (int m = 0; m < 4; ++m) { char* rowp = (char*)SG + (unsigned)(((row0 + ai * HALF + m * 16) * 1024 + col0) * 2);
#pragma unroll
                    for (int bj = 0; bj < 2; ++bj) { f32x4 v0 = acc[ai][bj][m][0], v1 = acc[ai][bj][m][1]; asm volatile("" : "+v"(v0), "+v"(v1)); u32x4 w;
                        w.x = cvt_pk_bf16(fsilu(v0[0]), fsilu(v0[1])); w.y = cvt_pk_bf16(fsilu(v0[2]), fsilu(v0[3])); w.z = cvt_pk_bf16(fsilu(v1[0]), fsilu(v1[1])); w.w = cvt_pk_bf16(fsilu(v1[2]), fsilu(v1[3]));
                        *(u32x4*)(rowp + bj * HALF * 2) = w; }
                    asm volatile("" ::: "memory"); }
            return;
        }
        const int c0 = 64 * u.pn + 16 * wc + 4 * fq;
        const f32x4 lbf = *(const f32x4*)(lb + c0), lbb = *(const f32x4*)(lb + 1024 + c0);
#pragma unroll
        for (int ai = 0; ai < 2; ++ai) {
            const int ck = u.pm * 4 + ai * 2 + wr;
#pragma unroll
            for (int m = 0; m < 4; ++m) { const f32x4 vv = acc[ai][1][m][1]; u32x2 w; w.x = cvt_pk_bf16(vv[0], vv[1]); w.y = cvt_pk_bf16(vv[2], vv[3]);
                *(u32x2*)((char*)V + (unsigned)(((row0 + ai * HALF + m * 16) * 1024 + c0) * 2)) = w; }
#pragma unroll
            for (int d = 0; d < 2; ++d) {
                const f32x4 lbv = d ? lbb : lbf;
                float db[4][4];
                float* sp = (float*)((char*)side + (unsigned)((((ck * 2 + d) * 3) * 1024 + c0) * 4));
#pragma unroll
                for (int j = 0; j < 4; ++j) {
                    float lf[4], bs[4];
#pragma unroll
                    for (int m = 0; m < 4; ++m) { const float z = d ? acc[ai][1][m][0][j] : acc[ai][0][m][1][j]; lf[m] = __logf(lbv[j] + (1.f - lbv[j]) * fsigmoid(z)); }
                    float tot0, bmid;
                    if (d == 0) {
#pragma unroll
                        for (int m = 0; m < 4; ++m) { float x = lf[m];
                            if (m > 0) { const float c = MK_DPP(0.f, bs[m - 1], 0x121); if (fr == 0) x += c; }
                            x += MK_DPP(0.f, x, 0x111); x += MK_DPP(0.f, x, 0x112); x += MK_DPP(0.f, x, 0x114); x += MK_DPP(0.f, x, 0x118); bs[m] = x; }
                        tot0 = MK_DPP(0.f, bs[3], 0x121);
                        bmid = __shfl(bs[2], 0, 16);
                    } else {
#pragma unroll
                        for (int mm = 0; mm < 4; ++mm) { const int m = 3 - mm; float x = lf[m];
                            if (m < 3) { const float c = MK_DPP(0.f, bs[m + 1], 0x12F); if (fr == 15) x += c; }
                            x += MK_DPP(0.f, x, 0x101); x += MK_DPP(0.f, x, 0x102); x += MK_DPP(0.f, x, 0x104); x += MK_DPP(0.f, x, 0x108); bs[m] = x; }
                        tot0 = bs[0];
                        bmid = __shfl(bs[1], 15, 16); }
#pragma unroll
                    for (int m = 0; m < 4; ++m) db[m][j] = bs[m] - bmid;
                    if (fr == 0) { sp[j] = __expf(bmid); sp[1024 + j] = __expf(tot0 - bmid); sp[2048 + j] = __expf(tot0); }
                }
                bf16_t* Qd = d ? QmB : QmF; bf16_t* Kd = d ? KmB : KmF;
#pragma unroll
                for (int m = 0; m < 4; ++m) { const f32x4 qz = acc[ai][0][m][0]; const f32x4 z = d ? acc[ai][1][m][0] : acc[ai][0][m][1]; float qo[4], ko[4];
#pragma unroll
                    for (int j = 0; j < 4; ++j) { const float kv = (1.f - lbv[j]) * (1.f - fsigmoid(z[j])); qo[j] = fsilu(qz[j]) * __expf(db[m][j]); ko[j] = kv * __expf(-db[m][j]); }
                    const unsigned off = (unsigned)(((row0 + ai * HALF + m * 16) * 1024 + c0) * 2);
                    u32x2 w; w.x = cvt_pk_bf16(qo[0], qo[1]); w.y = cvt_pk_bf16(qo[2], qo[3]); *(u32x2*)((char*)Qd + off) = w;
                    w.x = cvt_pk_bf16(ko[0], ko[1]); w.y = cvt_pk_bf16(ko[2], ko[3]); *(u32x2*)((char*)Kd + off) = w;
                    asm volatile("" ::: "memory"); }
            }
        }
    }
};


__device__ __forceinline__ float dpp_f(float oldv, float src, const int ctrl_sel) {
    const int o = __builtin_bit_cast(int, oldv), x = __builtin_bit_cast(int, src); int r;
    if (ctrl_sel == 0) r = __builtin_amdgcn_update_dpp(o, x, 0x111, 0xF, 0xF, false);
    else if (ctrl_sel == 1) r = __builtin_amdgcn_update_dpp(o, x, 0x101, 0xF, 0xF, false);
    else if (ctrl_sel == 2) r = __builtin_amdgcn_update_dpp(o, x, 0x121, 0xF, 0xF, false);
    else r = __builtin_amdgcn_update_dpp(o, x, 0x12F, 0xF, 0xF, false);
    return __builtin_bit_cast(float, r);
}
struct EpiUpConv {
    bf16_t* G; bf16_t* uedge; const float* cw; const float* cb;
    __device__ __forceinline__ void operator()(const f32x4 (&acc)[2][2][4][2], const Unit& u, int wr, int wc, int fr, int fq, LAS unsigned char* epi, int, int) const {
        LAS float* EX = (LAS float*)epi;
        const int colb = 32 * wc + 4 * fq;
        const int ch0 = 128 * u.pn + 32 * wc + 8 * fq;
#pragma unroll
        for (int ai = 0; ai < 2; ++ai) { const int g = 2 * ai + wr;
#pragma unroll
            for (int bj = 0; bj < 2; ++bj)
#pragma unroll
                for (int n = 0; n < 2; ++n) {
                    if (fr == 0) *(LAS f32x4*)(EX + (g * 2 + 0) * 256 + 128 * bj + 16 * n + colb) = acc[ai][bj][0][n];
                    if (fr == 15) *(LAS f32x4*)(EX + (g * 2 + 1) * 256 + 128 * bj + 16 * n + colb) = acc[ai][bj][3][n];
                } }
        {
            const bool lo = (wr == 0) && (fr < 2), hi = (wr == 1) && (fr >= 14);
            if (lo || hi) { const int slot = lo ? fr : (fr - 12); bf16_t* ue = uedge + ((size_t)u.pm * 4 + slot) * 5632 + ch0;
#pragma unroll
                for (int bj = 0; bj < 2; ++bj)
#pragma unroll
                    for (int n = 0; n < 2; ++n) { const f32x4 x = lo ? acc[0][bj][0][n] : acc[1][bj][3][n]; u32x2 w; w.x = cvt_pk_bf16(x[0], x[1]); w.y = cvt_pk_bf16(x[2], x[3]); *(u32x2*)(ue + bj * 2816 + 4 * n) = w; } }
        }
        LDS_WAIT(); MK_BAR; asm volatile("" ::: "memory");
#pragma unroll
        for (int n = 0; n < 2; ++n) {
            f32x4 wg[4], wv[4];
#pragma unroll
            for (int k = 0; k < 3; ++k) { wg[k] = *(const f32x4*)(cw + k * 5632 + ch0 + 4 * n); wv[k] = *(const f32x4*)(cw + k * 5632 + 2816 + ch0 + 4 * n); }
            wg[3] = *(const f32x4*)(cb + ch0 + 4 * n); wv[3] = *(const f32x4*)(cb + 2816 + ch0 + 4 * n);
#pragma unroll
            for (int ai = 0; ai < 2; ++ai) { const int g = 2 * ai + wr;
                f32x4 pe[2], ne[2];
#pragma unroll
                for (int bj = 0; bj < 2; ++bj) {
                    pe[bj] = (g > 0) ? *(const LAS f32x4*)(EX + ((g - 1) * 2 + 1) * 256 + 128 * bj + 16 * n + colb) : (f32x4){0.f, 0.f, 0.f, 0.f};
                    ne[bj] = (g < 3) ? *(const LAS f32x4*)(EX + ((g + 1) * 2 + 0) * 256 + 128 * bj + 16 * n + colb) : (f32x4){0.f, 0.f, 0.f, 0.f}; }
#pragma unroll
                for (int m = 0; m < 4; ++m) {
                    f32x4 cv2[2];
#pragma unroll
                    for (int bj = 0; bj < 2; ++bj) { const f32x4 x = acc[ai][bj][m][n]; const f32x4* wt = bj ? wv : wg; f32x4 c;
#pragma unroll
                        for (int j = 0; j < 4; ++j) {
                            const float pold = (m > 0) ? dpp_f(0.f, acc[ai][bj][m > 0 ? m - 1 : 0][n][j], 2) : pe[bj][j];
                            const float nold = (m < 3) ? dpp_f(0.f, acc[ai][bj][m < 3 ? m + 1 : 3][n][j], 3) : ne[bj][j];
                            const float pv = dpp_f(pold, x[j], 0), nv = dpp_f(nold, x[j], 1);
                            c[j] = wt[3][j] + wt[0][j] * pv + wt[1][j] * x[j] + wt[2][j] * nv; }
                        cv2[bj] = c; }
                    u32x2 w; w.x = cvt_pk_bf16(fsilu(cv2[0][0]) * cv2[1][0], fsilu(cv2[0][1]) * cv2[1][1]); w.y = cvt_pk_bf16(fsilu(cv2[0][2]) * cv2[1][2], fsilu(cv2[0][3]) * cv2[1][3]);
                    *(u32x2*)((char*)G + (unsigned)(((u.pm * 256 + ai * HALF + wr * 64 + m * 16 + fr) * 2816 + ch0 + 4 * n) * 2)) = w;
                    asm volatile("" ::: "memory");
                }
            }
        }
        LDS_WAIT(); MK_BAR; asm volatile("" ::: "memory");
    }
};
__device__ __forceinline__ void ffn_fix_edges(int tid, int pm, bf16_t* G, const bf16_t* uedge, const float* cw, const float* cb) {
    const bool sstart = (pm == 0) || (pm == 32) || (pm >= 64), send = (pm == 31) || (pm == 63) || (pm >= 64);
    for (int idx = tid; idx < 2 * 2816; idx += NTHR) {
        const int which = idx >= 2816, ch = idx - which * 2816;
        const bf16_t* UE = uedge + (size_t)pm * 4 * 5632;
        float cg = 0.f, cvv = 0.f;
#pragma unroll
        for (int half = 0; half < 2; ++half) { const int col = half * 2816 + ch; float pv, cu, nv;
            if (which == 0) { pv = sstart ? 0.f : bf2f(uedge[((size_t)(pm - 1) * 4 + 3) * 5632 + col]); cu = bf2f(UE[col]); nv = bf2f(UE[5632 + col]); }
            else { pv = bf2f(UE[2 * 5632 + col]); cu = bf2f(UE[3 * 5632 + col]); nv = send ? 0.f : bf2f(uedge[((size_t)(pm + 1) * 4) * 5632 + col]); }
            const float c = cb[col] + cw[col] * pv + cw[5632 + col] * cu + cw[2 * 5632 + col] * nv;
            if (half == 0) cg = c; else cvv = c; }
        G[(size_t)(pm * 256 + (which ? 255 : 0)) * 2816 + ch] = (bf16_t)f2bf(fsilu(cg) * cvv);
    }
}

constexpr int SC_QS = 272, SC_KS = 288;
constexpr int SC_QOFF = 0, SC_KOFF = 64 * SC_QS, SC_VOFF = SC_KOFF + 64 * SC_KS, SC_BUF = SC_VOFF + 64 * SC_KS;
constexpr int SC_POFF = 2 * SC_BUF, SC_PS = 144, SC_SIDE = SC_POFF + 64 * SC_PS;
__device__ __forceinline__ s16x4 ds_tr(const LAS unsigned char* p) { typedef short v4i16_t __attribute__((ext_vector_type(4))); return __builtin_bit_cast(s16x4, __builtin_amdgcn_ds_read_tr16_b64_v4i16((LAS v4i16_t*)p)); }
__device__ __forceinline__ bf16x8 cat8(s16x4 a, s16x4 b) { return (bf16x8){a[0], a[1], a[2], a[3], b[0], b[1], b[2], b[3]}; }

template <bool OUTPUT>
__device__ __forceinline__ void hgrn_segment(LAS unsigned char* lds, bf16_t* Qd, const bf16_t* Kd, const bf16_t* Vt, const float* side, float* sseg, float* dseg,
                                             int chain, int seg, int wave_s, unsigned long long* seg_ts = nullptr) {
    const int b = chain >> 4, h = (chain >> 1) & 7, d = chain & 1;
    const int w = wave_s, lane = lane_id_v(), tid = w * 64 + lane, l15 = lane & 15, G = lane >> 4;
    const int s_begin = seg == 0 ? 0 : 4 + 16 * seg, s_end = 20 + 16 * seg;
#define SC_LBAR() do { asm volatile("s_waitcnt lgkmcnt(0)" ::: "memory"); __builtin_amdgcn_s_barrier(); asm volatile("" ::: "memory"); } while (0)
#define SC_CHUNK_ROW(s_) (((s_) < 4) ? (ML + b * 256 + 64 * (d ? (3 - (s_)) : (s_))) : (b * 8192 + 64 * (d ? (127 - ((s_) - 4)) : ((s_) - 4))))
    u32x4 sqA0, sqA1, skA0, skA1, svA0, svA1; f32x4 ssdA = (f32x4){0.f, 0.f, 0.f, 0.f};
    const int st_r0 = tid >> 4, st_c = tid & 15, st_r1 = st_r0 + 32;
#define SC_STAGE_LOAD(X, s_) do { const int rb_ = SC_CHUNK_ROW(s_); \
        const size_t g0_ = (size_t)(rb_ + st_r0) * 1024 + h * 128 + st_c * 8, g1_ = (size_t)(rb_ + st_r1) * 1024 + h * 128 + st_c * 8; \
        if (OUTPUT) { sq##X##0 = *(const u32x4*)(Qd + g0_); sq##X##1 = *(const u32x4*)(Qd + g1_); } \
        sk##X##0 = *(const u32x4*)(Kd + g0_); sv##X##0 = *(const u32x4*)(Vt + g0_); sk##X##1 = *(const u32x4*)(Kd + g1_); sv##X##1 = *(const u32x4*)(Vt + g1_); \
        if (tid < 96) { const int ck_ = rb_ >> 6; ssd##X = *(const f32x4*)(side + ((size_t)(ck_ * 2 + d) * 3 + (tid >> 5)) * 1024 + h * 128 + (tid & 31) * 4); } } while (0)
#define SC_STAGE_STORE(X, buf_) do { LAS unsigned char* B_ = lds + (buf_) * SC_BUF; \
        if (OUTPUT) { *(LAS u32x4*)(B_ + SC_QOFF + st_r0 * SC_QS + st_c * 16) = sq##X##0; *(LAS u32x4*)(B_ + SC_QOFF + st_r1 * SC_QS + st_c * 16) = sq##X##1; } \
        *(LAS u32x4*)(B_ + SC_KOFF + st_r0 * SC_KS + st_c * 16) = sk##X##0; *(LAS u32x4*)(B_ + SC_VOFF + st_r0 * SC_KS + st_c * 16) = sv##X##0; \
        *(LAS u32x4*)(B_ + SC_KOFF + st_r1 * SC_KS + st_c * 16) = sk##X##1; *(LAS u32x4*)(B_ + SC_VOFF + st_r1 * SC_KS + st_c * 16) = sv##X##1; \
        if (tid < 96) *(LAS f32x4*)(lds + SC_SIDE + (buf_) * 1536 + tid * 16) = ssd##X; } while (0)
#ifdef MK_TIMING
#define SEG_STAMP(k) do { if (OUTPUT && blockIdx.x == 7 && w == 0 && lane == 0) seg_ts[(k)] = __builtin_amdgcn_s_memrealtime(); } while (0)
#else
#define SEG_STAMP(k) do { } while (0)
#endif
    SEG_STAMP(0);
    SC_STAGE_LOAD(A, s_begin);
    f32x4 S[8], Dp[8];
#pragma unroll
    for (int i = 0; i < 8; ++i) { S[i] = (f32x4){0.f, 0.f, 0.f, 0.f}; Dp[i] = (f32x4){1.f, 1.f, 1.f, 1.f}; }
    if (OUTPUT) {
        for (int j = 0; j < seg; ++j) { const float* sp = sseg + ((size_t)(chain * 8 + j) * 64 + w * 8) * 256 + lane * 4; const float* dp = dseg + (size_t)(chain * 8 + j) * 128 + 4 * G;
#pragma unroll
            for (int i = 0; i < 8; ++i) { const f32x4 sv = *(const f32x4*)(sp + i * 256), dv = *(const f32x4*)(dp + 16 * i); S[i] = dv * S[i] + sv; } }
    }
    SC_STAGE_STORE(A, 0);
    SC_LBAR();
    SEG_STAMP(1);
    const int ti = w >> 1, tj0 = (w & 1) * 2;
    for (int s = s_begin; s < s_end; ++s) {
      {
        const int cur = (s - s_begin) & 1;
        const LAS unsigned char* Bq = lds + cur * SC_BUF + SC_QOFF; const LAS unsigned char* Bk = lds + cur * SC_BUF + SC_KOFF; const LAS unsigned char* Bv = lds + cur * SC_BUF + SC_VOFF;
        const LAS float* sd = (const LAS float*)(lds + SC_SIDE + cur * 1536);
        if (s + 1 < s_end) SC_STAGE_LOAD(A, s + 1);
        bf16x8 Sp[4];
        if (OUTPUT) {
            f32x4 p0 = (f32x4){0.f, 0.f, 0.f, 0.f}, p1 = p0;
            bf16x8 fbq[4], fa0[4], fa1[4];
#pragma unroll
            for (int ks = 0; ks < 4; ++ks) {
                fbq[ks] = *(const LAS bf16x8*)(Bq + (16 * ti + l15) * SC_QS + (32 * ks + 8 * G) * 2);
                fa0[ks] = *(const LAS bf16x8*)(Bk + (16 * tj0 + l15) * SC_KS + (32 * ks + 8 * G) * 2);
                fa1[ks] = *(const LAS bf16x8*)(Bk + (16 * (tj0 + 1) + l15) * SC_KS + (32 * ks + 8 * G) * 2); }
#pragma unroll
            for (int ks = 0; ks < 4; ++ks) {
                p0 = __builtin_amdgcn_mfma_f32_16x16x32_bf16(fa0[ks], fbq[ks], p0, 0, 0, 0);
                p1 = __builtin_amdgcn_mfma_f32_16x16x32_bf16(fa1[ks], fbq[ks], p1, 0, 0, 0);
            }
            const int i = 16 * ti + l15;
#pragma unroll
            for (int r = 0; r < 4; ++r) { const int j0 = 16 * tj0 + 4 * G + r, j1 = j0 + 16;
                if (d == 0) { if (j0 > i) p0[r] = 0.f; if (j1 > i) p1[r] = 0.f; } else { if (j0 < i) p0[r] = 0.f; if (j1 < i) p1[r] = 0.f; } }
            u32x2 w0, w1; w0.x = cvt_pk_bf16(p0[0], p0[1]); w0.y = cvt_pk_bf16(p0[2], p0[3]); w1.x = cvt_pk_bf16(p1[0], p1[1]); w1.y = cvt_pk_bf16(p1[2], p1[3]);
            *(LAS u32x2*)(lds + SC_POFF + i * SC_PS + (16 * tj0 + 4 * G) * 2) = w0;
            *(LAS u32x2*)(lds + SC_POFF + i * SC_PS + (16 * (tj0 + 1) + 4 * G) * 2) = w1;
#pragma unroll
            for (int s4 = 0; s4 < 4; ++s4) {
                const f32x4 e0 = *(const LAS f32x4*)(sd + 16 * (2 * s4) + 4 * G), e1 = *(const LAS f32x4*)(sd + 16 * (2 * s4 + 1) + 4 * G);
                const f32x4 x0 = S[2 * s4] * e0, x1 = S[2 * s4 + 1] * e1;
                u32x4 t; t.x = cvt_pk_bf16(x0[0], x0[1]); t.y = cvt_pk_bf16(x0[2], x0[3]); t.z = cvt_pk_bf16(x1[0], x1[1]); t.w = cvt_pk_bf16(x1[2], x1[3]);
                Sp[s4] = __builtin_bit_cast(bf16x8, t);
            }
            SC_LBAR();
        }
        bf16x8 vf[2];
        {
            const int q = l15 >> 2, p = l15 & 3;
#pragma unroll
            for (int ks = 0; ks < 2; ++ks) {
                const s16x4 lo = ds_tr(Bv + (32 * ks + 4 * G + q) * SC_KS + (16 * w + 4 * p) * 2);
                const s16x4 hi = ds_tr(Bv + (32 * ks + 16 + 4 * G + q) * SC_KS + (16 * w + 4 * p) * 2);
                vf[ks] = cat8(lo, hi);
            }
        }
        if (OUTPUT) {
            const int rb = SC_CHUNK_ROW(s);
#pragma unroll
            for (int ih = 0; ih < 2; ++ih) {
                s16x4 plo[2][2], phi[2][2], qlo[2][4], qhi[2][4];
#pragma unroll
                for (int ii = 0; ii < 2; ++ii) { const int tok = 16 * (2 * ih + ii) + l15;
#pragma unroll
                    for (int ks = 0; ks < 2; ++ks) { plo[ii][ks] = *(const LAS s16x4*)(lds + SC_POFF + tok * SC_PS + (32 * ks + 4 * G) * 2); phi[ii][ks] = *(const LAS s16x4*)(lds + SC_POFF + tok * SC_PS + (32 * ks + 16 + 4 * G) * 2); }
#pragma unroll
                    for (int s4 = 0; s4 < 4; ++s4) { qlo[ii][s4] = *(const LAS s16x4*)(Bq + tok * SC_QS + (32 * s4 + 4 * G) * 2); qhi[ii][s4] = *(const LAS s16x4*)(Bq + tok * SC_QS + (32 * s4 + 16 + 4 * G) * 2); } }
                f32x4 o[2];
#pragma unroll
                for (int ii = 0; ii < 2; ++ii) o[ii] = (f32x4){0.f, 0.f, 0.f, 0.f};
#pragma unroll
                for (int ks = 0; ks < 2; ++ks)
#pragma unroll
                    for (int ii = 0; ii < 2; ++ii) o[ii] = __builtin_amdgcn_mfma_f32_16x16x32_bf16(vf[ks], cat8(plo[ii][ks], phi[ii][ks]), o[ii], 0, 0, 0);
#pragma unroll
                for (int s4 = 0; s4 < 4; ++s4)
#pragma unroll
                    for (int ii = 0; ii < 2; ++ii) o[ii] = __builtin_amdgcn_mfma_f32_16x16x32_bf16(Sp[s4], cat8(qlo[ii][s4], qhi[ii][s4]), o[ii], 0, 0, 0);
#pragma unroll
                for (int ii = 0; ii < 2; ++ii) { const int tok = 16 * (2 * ih + ii) + l15; u32x2 wv; wv.x = cvt_pk_bf16(o[ii][0], o[ii][1]); wv.y = cvt_pk_bf16(o[ii][2], o[ii][3]);
                    *(u32x2*)(Qd + (size_t)(rb + tok) * 1024 + h * 128 + 16 * w + 4 * G) = wv; }
            }
        }
        if (OUTPUT ? (s + 1 < s_end || seg < 7) : true) {
            const int q = l15 >> 2, p = l15 & 3;
#pragma unroll
            for (int ih = 0; ih < 4; ++ih) {
                s16x4 klo[2][2], khi[2][2]; f32x4 e2v[2], dev[2];
#pragma unroll
                for (int ii = 0; ii < 2; ++ii) { const int i = 2 * ih + ii;
#pragma unroll
                    for (int ks = 0; ks < 2; ++ks) { klo[ii][ks] = ds_tr(Bk + (32 * ks + 4 * G + q) * SC_KS + (16 * i + 4 * p) * 2); khi[ii][ks] = ds_tr(Bk + (32 * ks + 16 + 4 * G + q) * SC_KS + (16 * i + 4 * p) * 2); }
                    e2v[ii] = *(const LAS f32x4*)(sd + 128 + 16 * i + 4 * G); dev[ii] = *(const LAS f32x4*)(sd + 256 + 16 * i + 4 * G); }
                f32x4 U[2];
#pragma unroll
                for (int ii = 0; ii < 2; ++ii) U[ii] = (f32x4){0.f, 0.f, 0.f, 0.f};
#pragma unroll
                for (int ks = 0; ks < 2; ++ks)
#pragma unroll
                    for (int ii = 0; ii < 2; ++ii) U[ii] = __builtin_amdgcn_mfma_f32_16x16x32_bf16(cat8(klo[ii][ks], khi[ii][ks]), vf[ks], U[ii], 0, 0, 0);
#pragma unroll
                for (int ii = 0; ii < 2; ++ii) { const int i = 2 * ih + ii; S[i] = dev[ii] * S[i] + e2v[ii] * U[ii]; if (!OUTPUT) Dp[i] = Dp[i] * dev[ii]; }
            }
        }
        if (s + 1 < s_end) SC_STAGE_STORE(A, cur ^ 1);
        SC_LBAR();
      }
    }
    SEG_STAMP(2);
    if (!OUTPUT) {
        float* sp = sseg + ((size_t)(chain * 8 + seg) * 64 + w * 8) * 256 + lane * 4;
#pragma unroll
        for (int i = 0; i < 8; ++i) *(f32x4*)(sp + i * 256) = S[i];
        if (w == 0 && l15 == 0) { float* dp = dseg + (size_t)(chain * 8 + seg) * 128 + 4 * G;
#pragma unroll
            for (int i = 0; i < 8; ++i) *(f32x4*)(dp + 16 * i) = Dp[i]; }
    }
#undef SC_LBAR
#undef SC_CHUNK_ROW
#undef SC_STAGE_LOAD
#undef SC_STAGE_STORE
}

struct Frame {
    LAS unsigned char* lds; int wave, G, gw, NGW;
};
enum ConvKind { CV_NAT = 0, CV_PERM8 = 1, CV_HG = 2, CV_UP = 3, CV_GATES = 4 };
struct ConvJob { int kind; const float* W; const float* W2; int K, N, ld; bf16_t* dst; };
__device__ __forceinline__ const float* conv_colptr(const ConvJob& j, int rho) {
    const int pn = rho >> 8, t = rho & 255, bj = t >> 7, wc = (t >> 5) & 3, n = (t >> 4) & 1, fq = (t >> 2) & 3, jj = t & 3;
    switch (j.kind) {
        case CV_NAT: return j.W + rho;
        case CV_PERM8: return j.W + (pn * 256 + bj * 128 + wc * 32 + fq * 8 + n * 4 + jj);
        case CV_HG: if (pn >= 16) return j.W + (pn * 256 + bj * 128 + wc * 32 + fq * 8 + n * 4 + jj);
                    return j.W + ((2 * bj + n) * 1024 + 64 * pn + 16 * wc + 4 * fq + jj);
        case CV_UP: return j.W + (bj * 2816 + 128 * pn + 32 * wc + 8 * fq + 4 * n + jj);
        default: {
            const int blk = pn >> 2, q = pn & 3, grp = 2 * bj + n, dd = grp >> 1, ax = grp & 1; const int jc = 64 * q + 16 * wc + 4 * fq + jj;
            return (ax ? j.W2 : j.W) + (size_t)(dd * 4 + blk) * 65536 + jc; }
    }
}
__device__ __forceinline__ void conv_item(const ConvJob& j, LAS float* scr, int item, int lane) {
    const int nblk = j.N / 32, kb = item / nblk, nb = item % nblk, k0 = 64 * kb, n0 = 32 * nb;
    const float* cp = conv_colptr(j, n0 + (lane & 31));
    float tv[32];
#pragma unroll
    for (int i = 0; i < 32; ++i) tv[i] = cp[(size_t)(k0 + 2 * i + (lane >> 5)) * j.ld];
#pragma unroll
    for (int i = 0; i < 32; ++i) scr[(2 * i + (lane >> 5)) * 33 + (lane & 31)] = tv[i];
    LDS_WAIT(); asm volatile("" ::: "memory");
    const int c = lane & 7;
#pragma unroll
    for (int jx = 0; jx < 4; ++jx) { const int n = (lane >> 3) + 8 * jx; const LAS float* s = scr + (8 * c) * 33 + n;
        u32x4 o; o.x = pk2(s[0 * 33], s[1 * 33]); o.y = pk2(s[2 * 33], s[3 * 33]); o.z = pk2(s[4 * 33], s[5 * 33]); o.w = pk2(s[6 * 33], s[7 * 33]);
        *(u32x4*)(j.dst + (size_t)(n0 + n) * j.K + k0 + 8 * c) = o; }
    LDS_WAIT(); asm volatile("" ::: "memory");
}
__device__ __forceinline__ void conv_job(const Frame& F, const ConvJob& j, int gw, int ngw) {
    LAS float* scr = (LAS float*)(F.lds + F.wave * 8448);
    const int nitems = (j.K / 64) * (j.N / 32);
    const int lane = lane_id_v();
    for (int it = gw; it < nitems; it += ngw) conv_item(j, scr, it, lane);
}

__device__ __forceinline__ void adaln_phase(const Frame& F, const float* c, const float* cctx, const float* w_ada, const float* b_ada, float* mod) {
    const int tid = F.wave * 64 + lane_id_v();
    LAS float* sc = (LAS float*)(F.lds + 70000);
    LAS float* red = sc + 3 * 1024;
    for (int item = blockIdx.x; item < 192; item += F.G) {
        const int l = item / 96, j0 = (item % 96) * 64;
        for (int i = tid; i < 1024; i += NTHR) { sc[i] = fsilu(c[i]); sc[1024 + i] = fsilu(c[1024 + i]); sc[2048 + i] = fsilu(cctx[i]); }
        __syncthreads();
        const int kp = tid >> 4, jq = (tid & 15) * 4;
        const float* W = w_ada + (size_t)l * 1024 * 6144 + j0 + jq;
        f32x4 a0 = (f32x4){0.f, 0.f, 0.f, 0.f}, a1 = a0, a2 = a0;
#pragma unroll 8
        for (int k = kp * 32; k < kp * 32 + 32; ++k) { const f32x4 wv = *(const f32x4*)(W + (size_t)k * 6144); a0 += sc[k] * wv; a1 += sc[1024 + k] * wv; a2 += sc[2048 + k] * wv; }
        *(LAS f32x4*)(red + (kp * 3 + 0) * 64 + jq) = a0; *(LAS f32x4*)(red + (kp * 3 + 1) * 64 + jq) = a1; *(LAS f32x4*)(red + (kp * 3 + 2) * 64 + jq) = a2;
        __syncthreads();
        if (tid < 192) { const int v = tid >> 6, j2 = tid & 63; float s = 0.f;
#pragma unroll
            for (int p = 0; p < 32; ++p) s += red[(p * 3 + v) * 64 + j2];
            mod[(size_t)(l * 3 + v) * 6144 + j0 + j2] = s + b_ada[(size_t)l * 6144 + j0 + j2]; }
        __syncthreads();
    }
}

__device__ __forceinline__ void norm_phase(const Frame& F, const float* latL, float* latC, const float* g, const float* mod, int sh_off, int sc_off, bf16_t* H, int nrows, const float* slab = nullptr, int nslab = 0) {
    const int lane = lane_id_v();
    for (int row = F.gw; row < nrows; row += F.NGW) {
        const int v = row < 8192 ? 0 : (row < ML ? 1 : 2);
        const float* x = row < ML ? latL + (size_t)row * 1024 : latC + (size_t)(row - ML) * 1024;
        const float* sh = mod + v * 6144 + sh_off; const float* sc = mod + v * 6144 + sc_off;
        f32x4 xv[4]; float ss = 0.f;
#pragma unroll
        for (int j = 0; j < 4; ++j) { xv[j] = *(const f32x4*)(x + (lane + 64 * j) * 4);
            if (nslab > 0 && row >= ML) {
                for (int k = 0; k < nslab; ++k) xv[j] += *(const f32x4*)(slab + ((size_t)k * 512 + (row - ML)) * 1024 + (lane + 64 * j) * 4);
                *(f32x4*)(latC + (size_t)(row - ML) * 1024 + (lane + 64 * j) * 4) = xv[j]; }
            ss += (xv[j][0] * xv[j][0] + xv[j][1] * xv[j][1]) + (xv[j][2] * xv[j][2] + xv[j][3] * xv[j][3]); }
        const float rstd = rsqrtf(wave_sum(ss) * (1.f / 1024.f) + 1e-6f);
#pragma unroll
        for (int j = 0; j < 4; ++j) { const int cidx = (lane + 64 * j) * 4; const f32x4 gv = *(const f32x4*)(g + cidx), sv = *(const f32x4*)(sc + cidx), hv = *(const f32x4*)(sh + cidx);
            const f32x4 y = xv[j] * rstd * gv * (sv + 1.f) + hv; u32x2 wv; wv.x = pk2(y[0], y[1]); wv.y = pk2(y[2], y[3]);
            *(u32x2*)(H + (size_t)row * 1024 + cidx) = wv; }
    }
}

__device__ __forceinline__ void readout_phase(const Frame& F, const bf16_t* OF, const bf16_t* OB, const bf16_t* SG, const float* gn, bf16_t* R) {
    const int lane = lane_id_v(); const int l15 = lane & 15;
    const f32x4 g0 = *(const f32x4*)(gn + l15 * 8), g1 = *(const f32x4*)(gn + l15 * 8 + 4);
    for (int row = F.gw; row < MT; row += F.NGW) {
#pragma unroll
        for (int ps = 0; ps < 2; ++ps) {
            const size_t off = (size_t)row * 1024 + (size_t)((lane >> 4) + 4 * ps) * 128 + l15 * 8;
            const u32x4 a = *(const u32x4*)(OF + off), b = *(const u32x4*)(OB + off), sg = *(const u32x4*)(SG + off);
            float o[8] = {bflo(a.x) + bflo(b.x), bfhi(a.x) + bfhi(b.x), bflo(a.y) + bflo(b.y), bfhi(a.y) + bfhi(b.y), bflo(a.z) + bflo(b.z), bfhi(a.z) + bfhi(b.z), bflo(a.w) + bflo(b.w), bfhi(a.w) + bfhi(b.w)};
            float ss = 0.f;
#pragma unroll
            for (int j = 0; j < 8; ++j) ss += o[j] * o[j];
#pragma unroll
            for (int m = 1; m < 16; m <<= 1) ss += __shfl_xor(ss, m);
            const float rstd = rsqrtf(ss * (1.f / 128.f) + 1e-6f);
            u32x4 wv; wv.x = pk2(o[0] * rstd * g0[0] * bflo(sg.x), o[1] * rstd * g0[1] * bfhi(sg.x)); wv.y = pk2(o[2] * rstd * g0[2] * bflo(sg.y), o[3] * rstd * g0[3] * bfhi(sg.y));
            wv.z = pk2(o[4] * rstd * g1[0] * bflo(sg.z), o[5] * rstd * g1[1] * bfhi(sg.z)); wv.w = pk2(o[6] * rstd * g1[2] * bflo(sg.w), o[7] * rstd * g1[3] * bfhi(sg.w));
            *(u32x4*)(R + off) = wv;
        }
    }
}

struct EpiLruIn {
    bf16_t* GG; bf16_t* XR;
    __device__ __forceinline__ void operator()(const f32x4 (&acc)[2][2][4][2], const Unit& u, int wr, int wc, int fr, int fq, LAS unsigned char*, int, int) const {
        const bool isx = u.pn >= 4; const int col0 = (u.pn & 3) * 256 + wc * 32 + 8 * fq;
        bf16_t* dst = isx ? XR : GG;
#pragma unroll
        for (int ai = 0; ai < 2; ++ai)
#pragma unroll
            for (int m = 0; m < 4; ++m) { const int row = u.pm * 256 + ai * HALF + wr * 64 + m * 16 + fr; int drow = row;
                if (isx && row < ML) { const int t = row & 8191; drow = (row & ~8191) + (t & 63) * 128 + (t >> 6); }
#pragma unroll
                for (int bj = 0; bj < 2; ++bj) { f32x4 v0 = acc[ai][bj][m][0], v1 = acc[ai][bj][m][1];
                    if (!isx) {
#pragma unroll
                        for (int j = 0; j < 4; ++j) { v0[j] = fgelu_tanh(v0[j]); v1[j] = fgelu_tanh(v1[j]); } }
                    u32x4 w; w.x = cvt_pk_bf16(v0[0], v0[1]); w.y = cvt_pk_bf16(v0[2], v0[3]); w.z = cvt_pk_bf16(v1[0], v1[1]); w.w = cvt_pk_bf16(v1[2], v1[3]);
                    *(u32x4*)((char*)dst + (unsigned)((drow * 1024 + col0 + bj * HALF) * 2)) = w; }
                asm volatile("" ::: "memory"); }
    }
};
struct EpiXrSlab {
    float* slab; int ksplit;
    __device__ __forceinline__ void operator()(const f32x4 (&acc)[2][2][4][2], const Unit& u, int wr, int wc, int fr, int fq, LAS unsigned char*, int, int) const {
        float* out = slab + ((size_t)(u.pn % ksplit) * 512 + (size_t)(u.pm - 64) * 256) * 1024;
        const int col0 = (u.pn / ksplit) * 256 + wc * 32 + 8 * fq;
#pragma unroll
        for (int ai = 0; ai < 2; ++ai)
#pragma unroll
            for (int m = 0; m < 4; ++m)
#pragma unroll
                for (int bj = 0; bj < 2; ++bj)
#pragma unroll
                    for (int n = 0; n < 2; ++n) *(f32x4*)(out + (size_t)(ai * HALF + wr * 64 + m * 16 + fr) * 1024 + col0 + bj * HALF + 4 * n) = acc[ai][bj][m][n];
    }
};
__device__ __forceinline__ void lru_conv_phase(const Frame& F, const bf16_t* XR, const float* xrslab, const float* cw, const float* cb, bf16_t* XC) {
    const int lane = lane_id_v(); const int gt = F.gw * 64 + lane, ngt = F.NGW * 64;
    for (int it = gt; it < MT * 128; it += ngt) {
        const int row = it >> 7, c8 = (it & 127) * 8;
        const int s0 = row < ML ? (row & ~8191) : (ML + ((row - ML) & ~255)), slen = row < ML ? 8192 : 256, p = row - s0;
        float a[8];
#pragma unroll
        for (int j = 0; j < 8; ++j) a[j] = cb[c8 + j];
#pragma unroll
        for (int k = 0; k < 4; ++k) { const int pp = p + k - 2;
            if (pp >= 0 && pp < slen) { const f32x4 w0 = *(const f32x4*)(cw + k * 1024 + c8), w1 = *(const f32x4*)(cw + k * 1024 + c8 + 4);
                if (row < ML) { const u32x4 xv = *(const u32x4*)(XR + (size_t)(s0 + pp) * 1024 + c8);
                    a[0] += w0[0] * bflo(xv.x); a[1] += w0[1] * bfhi(xv.x); a[2] += w0[2] * bflo(xv.y); a[3] += w0[3] * bfhi(xv.y);
                    a[4] += w1[0] * bflo(xv.z); a[5] += w1[1] * bfhi(xv.z); a[6] += w1[2] * bflo(xv.w); a[7] += w1[3] * bfhi(xv.w); }
                else { f32x4 x0 = (f32x4){0.f, 0.f, 0.f, 0.f}, x1 = x0;
#pragma unroll
                    for (int ks = 0; ks < 4; ++ks) { const float* sp = xrslab + ((size_t)ks * 512 + (s0 - ML + pp)) * 1024 + c8; x0 += *(const f32x4*)sp; x1 += *(const f32x4*)(sp + 4); }
                    a[0] += w0[0] * x0[0]; a[1] += w0[1] * x0[1]; a[2] += w0[2] * x0[2]; a[3] += w0[3] * x0[3]; a[4] += w1[0] * x1[0]; a[5] += w1[1] * x1[1]; a[6] += w1[2] * x1[2]; a[7] += w1[3] * x1[3]; } } }
        u32x4 o; o.x = pk2(a[0], a[1]); o.y = pk2(a[2], a[3]); o.z = pk2(a[4], a[5]); o.w = pk2(a[6], a[7]);
        *(u32x4*)(XC + (size_t)row * 1024 + c8) = o;
    }
}
struct EpiGates {
    const bf16_t* XC; bf16_t *HLf, *Pf, *HLb, *Pb; float* agg; const float* ba; const float* bx; const float* lam;
    __device__ __forceinline__ void operator()(const f32x4 (&acc)[2][2][4][2], const Unit& u, int wr, int wc, int fr, int fq, LAS unsigned char*, int, int) const {
        const int c0 = 256 * (u.pn >> 2) + 64 * (u.pn & 3) + 16 * wc + 4 * fq;
#pragma unroll
        for (int d = 0; d < 2; ++d) {
            const f32x4 bav = *(const f32x4*)(ba + d * 1024 + c0), bxv = *(const f32x4*)(bx + d * 1024 + c0), lmv = *(const f32x4*)(lam + d * 1024 + c0);
            f32x4 spv;
#pragma unroll
            for (int j = 0; j < 4; ++j) { const float l = lmv[j]; spv[j] = (l > 0.f) ? log1pf(__expf(-l)) : (-l + log1pf(__expf(l))); }
            bf16_t* HL = d ? HLb : HLf; bf16_t* PP = d ? Pb : Pf;
#pragma unroll
            for (int ai = 0; ai < 2; ++ai) {
                const int grow0 = u.pm * 256 + ai * HALF + wr * 64, gidx = grow0 >> 6;
                unsigned hlw[4][2], ppw[4][2];
                u32x2 xw[4];
#pragma unroll
                for (int m = 0; m < 4; ++m) xw[m] = *(const u32x2*)((const char*)XC + (unsigned)(((grow0 + m * 16 + fr) * 1024 + c0) * 2));
#pragma unroll
                for (int jp = 0; jp < 2; ++jp) {
                    __builtin_amdgcn_sched_barrier(0);
                    float A[4][2], U[4][2];
#pragma unroll
                    for (int m = 0; m < 4; ++m) { const unsigned xww = jp ? xw[m].y : xw[m].x; const float xc[2] = {bflo(xww), bfhi(xww)};
                        const f32x4 pa = d ? acc[ai][1][m][0] : acc[ai][0][m][0], px = d ? acc[ai][1][m][1] : acc[ai][0][m][1];
#pragma unroll
                        for (int jj = 0; jj < 2; ++jj) { const int j = 2 * jp + jj; const float r = fsigmoid(pa[j] + bav[j]), ig = fsigmoid(px[j] + bxv[j]); const float la = -8.f * r * spv[j];
                            A[m][jj] = __expf(la); U[m][jj] = sqrtf(fmaxf(1.f - __expf(2.f * la), 0.f)) * (ig * xc[jj]); } }
#pragma unroll
                    for (int jj = 0; jj < 2; ++jj) { const int j = 2 * jp + jj;
                        if (d == 0) {
#pragma unroll
                            for (int m = 0; m < 4; ++m) { float a = A[m][jj], x = U[m][jj]; float ap, up;
                                if (m > 0) { ap = MK_DPP(1.f, A[m - 1][jj], 0x121); up = MK_DPP(0.f, U[m - 1][jj], 0x121); if (fr == 0) { x = a * up + x; a = a * ap; } }
                                ap = MK_DPP(1.f, a, 0x111); up = MK_DPP(0.f, x, 0x111); x = a * up + x; a = a * ap;
                                ap = MK_DPP(1.f, a, 0x112); up = MK_DPP(0.f, x, 0x112); x = a * up + x; a = a * ap;
                                ap = MK_DPP(1.f, a, 0x114); up = MK_DPP(0.f, x, 0x114); x = a * up + x; a = a * ap;
                                ap = MK_DPP(1.f, a, 0x118); up = MK_DPP(0.f, x, 0x118); x = a * up + x; a = a * ap;
                                A[m][jj] = a; U[m][jj] = x; }
                            if (fr == 15) { agg[((size_t)(gidx * 2 + 0) * 2 + 0) * 1024 + c0 + j] = A[3][jj]; agg[((size_t)(gidx * 2 + 0) * 2 + 1) * 1024 + c0 + j] = U[3][jj]; }
                        } else {
#pragma unroll
                            for (int mm = 0; mm < 4; ++mm) { const int m = 3 - mm; float a = A[m][jj], x = U[m][jj]; float ap, up;
                                if (m < 3) { ap = MK_DPP(1.f, A[m + 1][jj], 0x12F); up = MK_DPP(0.f, U[m + 1][jj], 0x12F); if (fr == 15) { x = a * up + x; a = a * ap; } }
                                ap = MK_DPP(1.f, a, 0x101); up = MK_DPP(0.f, x, 0x101); x = a * up + x; a = a * ap;
                                ap = MK_DPP(1.f, a, 0x102); up = MK_DPP(0.f, x, 0x102); x = a * up + x; a = a * ap;
                                ap = MK_DPP(1.f, a, 0x104); up = MK_DPP(0.f, x, 0x104); x = a * up + x; a = a * ap;
                                ap = MK_DPP(1.f, a, 0x108); up = MK_DPP(0.f, x, 0x108); x = a * up + x; a = a * ap;
                                A[m][jj] = a; U[m][jj] = x; }
                            if (fr == 0) { agg[((size_t)(gidx * 2 + 1) * 2 + 0) * 1024 + c0 + j] = A[0][jj]; agg[((size_t)(gidx * 2 + 1) * 2 + 1) * 1024 + c0 + j] = U[0][jj]; }
                        }
                    }
#pragma unroll
                    for (int m = 0; m < 4; ++m) { hlw[m][jp] = cvt_pk_bf16(U[m][0], U[m][1]); ppw[m][jp] = cvt_pk_bf16(A[m][0], A[m][1]); }
                }
#pragma unroll
                for (int m = 0; m < 4; ++m) { const unsigned off = (unsigned)(((grow0 + m * 16 + fr) * 1024 + c0) * 2);
                    *(u32x2*)((char*)HL + off) = (u32x2){hlw[m][0], hlw[m][1]}; *(u32x2*)((char*)PP + off) = (u32x2){ppw[m][0], ppw[m][1]}; }
                asm volatile("" ::: "memory");
            }
        }
    }
};
__device__ __forceinline__ void lru_gscan_phase(const Frame& F, const float* agg, float* hin) {
    const int lane = lane_id_v(); const int gt = F.gw * 64 + lane;
    if (gt >= 4096) return;
    const int b = gt >> 11, d = (gt >> 10) & 1, c = gt & 1023;
    float h = 0.f;
#pragma unroll 1
    for (int s0 = 0; s0 < 132; s0 += 33) {
        float pt[33], ht[33];
#pragma unroll
        for (int k = 0; k < 33; ++k) { const int s = s0 + k; const int g = (s < 4) ? (256 + 4 * b + (d ? (3 - s) : s)) : (128 * b + (d ? (127 - (s - 4)) : (s - 4)));
            pt[k] = agg[((size_t)(g * 2 + d) * 2 + 0) * 1024 + c]; ht[k] = agg[((size_t)(g * 2 + d) * 2 + 1) * 1024 + c]; }
#pragma unroll
        for (int k = 0; k < 33; ++k) { const int s = s0 + k; const int g = (s < 4) ? (256 + 4 * b + (d ? (3 - s) : s)) : (128 * b + (d ? (127 - (s - 4)) : (s - 4)));
            hin[(size_t)(g * 2 + d) * 1024 + c] = h; h = pt[k] * h + ht[k]; }
    }
}
__device__ __forceinline__ void lru_final_phase(const Frame& F, const bf16_t* HLf, const bf16_t* Pf, const bf16_t* HLb, const bf16_t* Pb, const float* hin, const bf16_t* GG, bf16_t* Y) {
    const int lane = lane_id_v(); const int gt = F.gw * 64 + lane, ngt = F.NGW * 64;
    for (int it = gt; it < ML * 128; it += ngt) {
        const int row = it >> 7, c8 = (it & 127) * 8; const int t = row & 8191; const int prow = (row & ~8191) + (t & 63) * 128 + (t >> 6), g = prow >> 6;
        const size_t po = (size_t)prow * 1024 + c8;
        const u32x4 hf = *(const u32x4*)(HLf + po), pf = *(const u32x4*)(Pf + po), hb = *(const u32x4*)(HLb + po), pb = *(const u32x4*)(Pb + po), gg = *(const u32x4*)(GG + (size_t)row * 1024 + c8);
        const float* hif = hin + (size_t)(g * 2 + 0) * 1024 + c8; const float* hib = hin + (size_t)(g * 2 + 1) * 1024 + c8;
        const f32x4 f0 = *(const f32x4*)hif, f1 = *(const f32x4*)(hif + 4), b0 = *(const f32x4*)hib, b1 = *(const f32x4*)(hib + 4);
        float y[8];
        y[0] = (bflo(hf.x) + bflo(pf.x) * f0[0] + bflo(hb.x) + bflo(pb.x) * b0[0]) * bflo(gg.x); y[1] = (bfhi(hf.x) + bfhi(pf.x) * f0[1] + bfhi(hb.x) + bfhi(pb.x) * b0[1]) * bfhi(gg.x);
        y[2] = (bflo(hf.y) + bflo(pf.y) * f0[2] + bflo(hb.y) + bflo(pb.y) * b0[2]) * bflo(gg.y); y[3] = (bfhi(hf.y) + bfhi(pf.y) * f0[3] + bfhi(hb.y) + bfhi(pb.y) * b0[3]) * bfhi(gg.y);
        y[4] = (bflo(hf.z) + bflo(pf.z) * f1[0] + bflo(hb.z) + bflo(pb.z) * b1[0]) * bflo(gg.z); y[5] = (bfhi(hf.z) + bfhi(pf.z) * f1[1] + bfhi(hb.z) + bfhi(pb.z) * b1[1]) * bfhi(gg.z);
        y[6] = (bflo(hf.w) + bflo(pf.w) * f1[2] + bflo(hb.w) + bflo(pb.w) * b1[2]) * bflo(gg.w); y[7] = (bfhi(hf.w) + bfhi(pf.w) * f1[3] + bfhi(hb.w) + bfhi(pb.w) * b1[3]) * bfhi(gg.w);
        u32x4 o; o.x = pk2(y[0], y[1]); o.y = pk2(y[2], y[3]); o.z = pk2(y[4], y[5]); o.w = pk2(y[6], y[7]);
        *(u32x4*)(Y + (size_t)row * 1024 + c8) = o;
    }
}
__device__ __forceinline__ void final_norm_phase(const Frame& F, float* lat, const float* g, float dbg_s, float dbg_spike) {
    const int lane = lane_id_v();
    for (int row = F.gw; row < ML; row += F.NGW) {
        float* x = lat + (size_t)row * 1024; f32x4 xv[4]; float ss = 0.f;
#pragma unroll
        for (int j = 0; j < 4; ++j) { xv[j] = *(const f32x4*)(x + (lane + 64 * j) * 4); ss += (xv[j][0] * xv[j][0] + xv[j][1] * xv[j][1]) + (xv[j][2] * xv[j][2] + xv[j][3] * xv[j][3]); }
        const float rstd = rsqrtf(wave_sum(ss) * (1.f / 1024.f) + 1e-6f);
#pragma unroll
        for (int j = 0; j < 4; ++j) { const int cidx = (lane + 64 * j) * 4; f32x4 y = xv[j] * rstd * *(const f32x4*)(g + cidx);
            if (dbg_s != 0.f) { y[0] += dbg_s; y[1] -= dbg_s; y[2] += dbg_s; y[3] -= dbg_s; }
            if (dbg_spike != 0.f && row == 0 && cidx == 0) y[0] += dbg_spike;
            *(f32x4*)(x + cidx) = y; }
    }
}

struct Args { const float* in[25]; float* out; unsigned char* ws; int ph_lo, ph_hi; };
__global__ void __launch_bounds__(NTHR, 2) mega(Args args) {
    extern __shared__ __attribute__((aligned(16))) unsigned char lds_raw[];
    LAS unsigned char* lds = (LAS unsigned char*)lds_raw;
    Frame F; F.lds = lds; F.wave = __builtin_amdgcn_readfirstlane(threadIdx.x >> 6); F.G = gridDim.x;
    F.gw = blockIdx.x * NWAVES + F.wave; F.NGW = F.G * NWAVES;
    volatile LAS unsigned* MISC = (volatile LAS unsigned*)(lds + MISC_OFF);
    if (threadIdx.x < 64) MISC[threadIdx.x] = 0u;
    __syncthreads();
    unsigned char* ws = args.ws;
    XcdBarrier bar = xcd_barrier_post((unsigned*)(ws + WS_CTL) + CW_BAR, MISC + 8);
    const float* x = args.in[0]; const float* cvec = args.in[1]; const float* ctx = args.in[2]; const float* cctx = args.in[3];
    const float* w_ada = args.in[4]; const float* b_ada = args.in[5]; const float* norm_g = args.in[6];
    const float* hg_w_in = args.in[7]; const float* hg_lb = args.in[8]; const float* hg_gn = args.in[9]; const float* hg_w_out = args.in[10];
    float* MOD = (float*)(ws + WS_MOD); float* LB = (float*)(ws + WS_LB); float* CXLAT = (float*)(ws + WS_CXLAT); float* SIDE = (float*)(ws + WS_SIDE);
    bf16_t* W_HGIN = (bf16_t*)(ws + WS_W_HGIN); bf16_t* W_HGOUT = (bf16_t*)(ws + WS_W_HGOUT); bf16_t* W_UP = (bf16_t*)(ws + WS_W_UP); bf16_t* W_DN0 = (bf16_t*)(ws + WS_W_DN0);
    bf16_t* W_LRUIN = (bf16_t*)(ws + WS_W_LRUIN); bf16_t* W_GATES = (bf16_t*)(ws + WS_W_GATES); bf16_t* W_LRUOUT = (bf16_t*)(ws + WS_W_LRUOUT); bf16_t* W_DN1 = (bf16_t*)(ws + WS_W_DN1);
    bf16_t* UEDGE = (bf16_t*)(ws + WS_UEDGE);
    const float* lru_w_in = args.in[11]; const float* lru_cw = args.in[12]; const float* lru_cb = args.in[13]; const float* lru_wa = args.in[14]; const float* lru_ba = args.in[15];
    const float* lru_wx = args.in[16]; const float* lru_bx = args.in[17]; const float* lru_lam = args.in[18]; const float* lru_w_out = args.in[19];
    const float* ffn_up = args.in[20]; const float* ffn_cw = args.in[21]; const float* ffn_cb = args.in[22]; const float* ffn_down = args.in[23]; const float* final_g = args.in[24];
    bf16_t* ACT[6];
#pragma unroll
    for (int i = 0; i < 6; ++i) ACT[i] = (bf16_t*)(ws + WS_ACT + (size_t)i * ACT_SLOT);
    bf16_t* Hd = (bf16_t*)args.out;
    const int lo = args.ph_lo, hi = args.ph_hi;
#define IN(k) (lo <= (k) && (k) < hi)
#ifdef MK_TIMING
    unsigned long long* TS = (unsigned long long*)(ws + WS_CTL + 8192);
#define STAMP(k) do { if (blockIdx.x == 0 && F.wave == 0 && lane_id_v() == 0) TS[(k)] = __builtin_amdgcn_s_memrealtime(); } while (0)
#else
#define STAMP(k) do { } while (0)
#endif
    STAMP(0);
#define SEAM(k) do { if (IN(k) && IN((k) + 1)) xcd_barrier(bar, F.wave); STAMP((k) + 1); } while (0)

    if (IN(0)) {
        adaln_phase(F, cvec, cctx, w_ada, b_ada, MOD);
        if (blockIdx.x == F.G - 1) for (int i = F.wave * 64 + lane_id_v(); i < 2048; i += NTHR) { const float l0 = hg_lb[i], l1 = hg_lb[2048 + i]; const float m = fmaxf(l0, l1), e0 = __expf(l0 - m), e1 = __expf(l1 - m); LB[i] = e0 / (e0 + e1); }
        __syncthreads();
        { const int lane = lane_id_v(); for (int i = F.gw * 64 + lane; i < 512 * 256; i += F.NGW * 64) ((f32x4*)CXLAT)[i] = ((const f32x4*)ctx)[i]; }
        { ConvJob j{CV_HG, hg_w_in, nullptr, 1024, 5120, 5120, W_HGIN}; conv_job(F, j, F.gw, F.NGW); }
    }
    SEAM(0);
    if (IN(1)) norm_phase(F, x, (float*)ctx, norm_g, MOD, 0, 1024, Hd, MT);
    SEAM(1);
    if (IN(2)) {
        Gemm g{Hd, W_HGIN, 1024, 1024, 1024, 0, 0, 1}; StaticOrder S; S.init(NTM, 20, F.G, (int)blockIdx.x);
        EpiHgIn E{ACT[0], ACT[1], ACT[2], ACT[3], ACT[4], ACT[5], SIDE, LB};
        gemm_phase(lds, g, S, E, F.wave);
        const int nfull = (NTM * 20) % F.G;
        if (nfull == 0 || (int)blockIdx.x >= nfull) {
            const int gw2 = nfull ? ((int)blockIdx.x - nfull) * NWAVES + F.wave : F.gw, ngw2 = nfull ? (F.G - nfull) * NWAVES : F.NGW;
            { ConvJob j{CV_NAT, hg_w_out, nullptr, 1024, 1024, 1024, W_HGOUT}; conv_job(F, j, gw2, ngw2); }
            { ConvJob j{CV_UP, ffn_up, nullptr, 1024, 5632, 5632, W_UP}; conv_job(F, j, gw2, ngw2); }
            { ConvJob j{CV_NAT, ffn_down, nullptr, 2816, 1024, 1024, W_DN0}; conv_job(F, j, gw2, ngw2); }
            { ConvJob j{CV_PERM8, lru_w_in, nullptr, 1024, 2048, 2048, W_LRUIN}; conv_job(F, j, gw2, ngw2); }
            { ConvJob j{CV_GATES, lru_wa, lru_wx, 256, 4096, 256, W_GATES}; conv_job(F, j, gw2, ngw2); }
            { ConvJob j{CV_NAT, lru_w_out, nullptr, 1024, 1024, 1024, W_LRUOUT}; conv_job(F, j, gw2, ngw2); }
            { ConvJob j{CV_NAT, ffn_down + (size_t)2816 * 1024, nullptr, 2816, 1024, 1024, W_DN1}; conv_job(F, j, gw2, ngw2); }
        }
    }
    SEAM(2);
    float* SSEG = (float*)args.out; float* DSEG = (float*)args.out + (size_t)256 * 16384;
    if (IN(3)) {
        for (int u = blockIdx.x; u < 256; u += F.G) if ((u & 7) != 7) { const int dd = (u >> 3) & 1;
            hgrn_segment<false>(lds, dd ? ACT[2] : ACT[0], dd ? ACT[3] : ACT[1], ACT[4], SIDE, SSEG, DSEG, u >> 3, u & 7, F.wave); }
    }
    SEAM(3);
    if (IN(4)) {
        for (int u = blockIdx.x; u < 256; u += F.G) { const int dd = (u >> 3) & 1;
            hgrn_segment<true>(lds, dd ? ACT[2] : ACT[0], dd ? ACT[3] : ACT[1], ACT[4], SIDE, SSEG, DSEG, u >> 3, u & 7, F.wave, (unsigned long long*)(ws + WS_CTL + 8192) + 100); }
    }
    SEAM(4);
    if (IN(5)) readout_phase(F, ACT[0], ACT[2], ACT[5], hg_gn, ACT[1]);
    SEAM(5);
    if (IN(6)) {
        { Gemm g{ACT[1], W_HGOUT, 1024, 1024, 1024, 0, 0, 1}; StaticOrder S; S.init(64, 4, F.G, (int)blockIdx.x);
          EpiResid E{x, ctx, args.out, CXLAT, MOD, 2048};
          gemm_phase(lds, g, S, E, F.wave); }
        { Gemm g{ACT[1], W_HGOUT, 1024, 1024, 256, 0, 0, 4}; StaticOrder S; S.init(2, 16, F.G, (int)blockIdx.x, 64);
          EpiSlab E{(float*)ACT[3], MOD, 2048, 4};
          gemm_phase(lds, g, S, E, F.wave); }
    }
    SEAM(6);
    if (IN(7)) norm_phase(F, args.out, CXLAT, norm_g + 1024, MOD, 3072, 4096, ACT[5], MT, (const float*)ACT[3], 4);
    SEAM(7);
    if (IN(8)) {
        Gemm g{ACT[5], W_UP, 1024, 1024, 1024, 0, 0, 1}; StaticOrder S; S.init(NTM, 22, F.G, (int)blockIdx.x);
        EpiUpConv E{ACT[0], UEDGE, ffn_cw, ffn_cb};
        gemm_phase(lds, g, S, E, F.wave);
    }
    SEAM(8);
    if (IN(9)) {
        StaticOrder S; S.init(64, 4, F.G, (int)blockIdx.x);
        StaticOrder S2; S2.init(2, 44, F.G, (int)blockIdx.x, 64);
        { Unit u; const int tid = F.wave * 64 + lane_id_v(); for (int i = 0; S.next(i, u); ++i) ffn_fix_edges(tid, u.pm, ACT[0], UEDGE, ffn_cw, ffn_cb);
          for (int i = 0; S2.next(i, u); ++i) ffn_fix_edges(tid, u.pm, ACT[0], UEDGE, ffn_cw, ffn_cb); }
        VM_WAIT(); __syncthreads();
        { Gemm g{ACT[0], W_DN0, 2816, 2816, 2816, 0, 0, 1};
          EpiResid E{args.out, CXLAT, args.out, CXLAT, MOD, 5120};
          gemm_phase(lds, g, S, E, F.wave); }
        { Gemm g{ACT[0], W_DN0, 2816, 2816, 256, 0, 0, 11};
          EpiSlab E{(float*)ACT[5], MOD, 5120, 11};
          gemm_phase(lds, g, S2, E, F.wave); }
    }
    SEAM(9);
    float* MOD1 = MOD + 3 * 6144; float* AGG = SIDE; float* HIN = (float*)(ws + WS_SIDE + 4 * MiB + 256 * 1024);
    if (IN(10)) {
        norm_phase(F, args.out, CXLAT, norm_g + 2048, MOD1, 0, 1024, ACT[0], MT, (const float*)ACT[5], 11);
    }
    SEAM(10);
    if (IN(11)) {
        { Gemm g{ACT[0], W_LRUIN, 1024, 1024, 1024, 0, 0, 1}; StaticOrder S; S.init(64, 8, F.G, (int)blockIdx.x);
          EpiLruIn E{ACT[1], ACT[2]};
          gemm_phase(lds, g, S, E, F.wave); }
        { Gemm g{ACT[0], W_LRUIN + (size_t)1024 * 1024, 1024, 1024, 256, 0, 0, 4}; StaticOrder S; S.init(2, 16, F.G, (int)blockIdx.x, 64);
          EpiXrSlab E{(float*)ACT[4], 4};
          gemm_phase(lds, g, S, E, F.wave); }
    }
    SEAM(11);
    if (IN(12)) lru_conv_phase(F, ACT[2], (const float*)ACT[4], lru_cw, lru_cb, ACT[3]);
    SEAM(12);
    if (IN(13)) {
        Gemm g{ACT[3], W_GATES, 1024, 256, 256, 2, 256, 1}; StaticOrder S; S.init(NTM, 16, F.G, (int)blockIdx.x);
        EpiGates E{ACT[3], ACT[0], ACT[4], ACT[5], ACT[2], AGG, lru_ba, lru_bx, lru_lam};
        gemm_phase(lds, g, S, E, F.wave);
    }
    SEAM(13);
    if (IN(14)) {
        if ((int)blockIdx.x < 8) lru_gscan_phase(F, AGG, HIN);
        else { const int gw2 = ((int)blockIdx.x - 8) * NWAVES + F.wave, ngw2 = (F.G - 8) * NWAVES;
            ConvJob j{CV_UP, ffn_up + (size_t)1024 * 5632, nullptr, 1024, 5632, 5632, W_UP}; conv_job(F, j, gw2, ngw2); }
    }
    SEAM(14);
    if (IN(15)) lru_final_phase(F, ACT[0], ACT[4], ACT[5], ACT[2], HIN, ACT[1], ACT[3]);
    SEAM(15);
    if (IN(16)) {
        Gemm g{ACT[3], W_LRUOUT, 1024, 1024, 1024, 0, 0, 1}; StaticOrder S; S.init(64, 4, F.G, (int)blockIdx.x);
        EpiResid E{args.out, CXLAT, args.out, CXLAT, MOD1, 2048};
        gemm_phase(lds, g, S, E, F.wave);
    }
    SEAM(16);
    if (IN(17)) norm_phase(F, args.out, CXLAT, norm_g + 3072, MOD1, 3072, 4096, ACT[5], ML);
    SEAM(17);
    if (IN(18)) {
        Gemm g{ACT[5], W_UP, 1024, 1024, 1024, 0, 0, 1}; StaticOrder S; S.init(64, 22, F.G, (int)blockIdx.x);
        EpiUpConv E{ACT[0], UEDGE, ffn_cw + 3 * 5632, ffn_cb + 5632};
        gemm_phase(lds, g, S, E, F.wave);
    }
    SEAM(18);
    if (IN(19)) {
        StaticOrder S; S.init(64, 4, F.G, (int)blockIdx.x);
        { Unit u; const int tid = F.wave * 64 + lane_id_v(); for (int i = 0; S.next(i, u); ++i) ffn_fix_edges(tid, u.pm, ACT[0], UEDGE, ffn_cw + 3 * 5632, ffn_cb + 5632); }
        VM_WAIT(); __syncthreads();
        Gemm g{ACT[0], W_DN1, 2816, 2816, 2816, 0, 0, 1};
        EpiResid E{args.out, CXLAT, args.out, CXLAT, MOD1, 5120};
        gemm_phase(lds, g, S, E, F.wave);
    }
    SEAM(19);
#ifdef MK_TIMING
    if (IN(20)) {
#define TSX(i) (TS[(i)])
        const float t_a = (float)(TSX(MK_T_A1) - TSX(MK_T_A0)) * 0.01f, t_b = (float)(TSX(MK_T_B1) - TSX(MK_T_B0)) * 0.01f;
        final_norm_phase(F, args.out, final_g, sqrtf(t_a * 1e-6f), t_b * (1.f / 500.f)); }
#else
    if (IN(20)) final_norm_phase(F, args.out, final_g, 0.f, 0.f);
#endif
#undef IN
#undef SEAM
}
}
__global__ void __launch_bounds__(128) k_refscan(unsigned short* QF, const unsigned short* KF, unsigned short* QB, const unsigned short* KB, const unsigned short* V, const float* side) {
    const int ch = blockIdx.x, b = ch >> 4, h = (ch >> 1) & 7, d = ch & 1, t = threadIdx.x;
    unsigned short* Qd = d ? QB : QF; const unsigned short* Kd = d ? KB : KF;
    __shared__ float q[64][129], k[64][129], vs[64][128], P[64][65], e1[128], e2[128], dec[128];
    float S[128];
#pragma unroll
    for (int i = 0; i < 128; ++i) S[i] = 0.f;
    for (int s = 0; s < 132; ++s) {
        const int rb = (s < 4) ? (16384 + b * 256 + 64 * (d ? (3 - s) : s)) : (b * 8192 + 64 * (d ? (127 - (s - 4)) : (s - 4)));
        const int ck = rb >> 6;
        for (int idx = t; idx < 8192; idx += 128) { const int r = idx >> 7, c = idx & 127; const size_t g = (size_t)(rb + r) * 1024 + h * 128 + c;
            q[r][c] = mk::bf2f(Qd[g]); k[r][c] = mk::bf2f(Kd[g]); vs[r][c] = mk::bf2f(V[g]); }
        e1[t] = side[((size_t)(ck * 2 + d) * 3 + 0) * 1024 + h * 128 + t]; e2[t] = side[((size_t)(ck * 2 + d) * 3 + 1) * 1024 + h * 128 + t]; dec[t] = side[((size_t)(ck * 2 + d) * 3 + 2) * 1024 + h * 128 + t];
        __syncthreads();
        for (int idx = t; idx < 4096; idx += 128) { const int i = idx >> 6, j = idx & 63; const bool ok = d ? (j >= i) : (j <= i); float p = 0.f;
            if (ok) for (int c = 0; c < 128; ++c) p += q[i][c] * k[j][c];
            P[i][j] = p; }
        __syncthreads();
        for (int i = 0; i < 64; ++i) { float o = 0.f;
#pragma unroll
            for (int c = 0; c < 128; ++c)
#ifdef UNIT_SIDE
                o += q[i][c] * S[c];
#else
                o += q[i][c] * (e1[c] * S[c]);
#endif

            for (int j = 0; j < 64; ++j) o += P[i][j] * vs[j][t];
            Qd[(size_t)(rb + i) * 1024 + h * 128 + t] = (unsigned short)mk::f2bf(o); }
#pragma unroll
        for (int c = 0; c < 128; ++c) { float u = 0.f; for (int j = 0; j < 64; ++j) u += k[j][c] * vs[j][t];
#ifdef ZERO_STATE
            S[c] = 0.f;
#elif defined(UNIT_SIDE)
            S[c] = S[c] + u;
#else
            S[c] = dec[c] * S[c] + e2[c] * u;
#endif
        }
        __syncthreads();
    }
}

#ifndef MK_CUT
#define MK_CUT 1
#endif
#ifndef MK_ONE_LAUNCH
#define MK_ONE_LAUNCH 0
#endif
static void gemm(hipStream_t s, const float* A, int lda, const float* B, int ldb, float* C, int ldc, int M, int N, int K) {
    dim3 g(N / 64, (M + 63) / 64);
    hipLaunchKernelGGL(k_gemm, g, dim3(256), 0, s, A, lda, B, ldb, C, ldc, M, N, K);
}

extern "C" void kernel_launch(void* const* d_in, const int* in_sizes, int n_in, void* d_out, int out_size, void* d_ws, size_t ws_size, hipStream_t stream) {
    const float* norm_g = (const float*)d_in[6];
    const float* lru_w_in = (const float*)d_in[11]; const float* lru_cw = (const float*)d_in[12]; const float* lru_cb = (const float*)d_in[13];
    const float* lru_wa = (const float*)d_in[14]; const float* lru_ba = (const float*)d_in[15]; const float* lru_wx = (const float*)d_in[16]; const float* lru_bx = (const float*)d_in[17];
    const float* lru_lam = (const float*)d_in[18]; const float* lru_w_out = (const float*)d_in[19];
    const float* ffn_up = (const float*)d_in[20]; const float* ffn_cw = (const float*)d_in[21]; const float* ffn_cb = (const float*)d_in[22]; const float* ffn_down = (const float*)d_in[23];
    const float* final_g = (const float*)d_in[24];
    float* out = (float*)d_out;
    char* ws = (char*)d_ws;
    static int grid = 0;
    if (grid == 0) {
        int dev = 0, cus = 0, per_cu = 0;
        hipGetDevice(&dev); hipDeviceGetAttribute(&cus, hipDeviceAttributeMultiprocessorCount, dev);
        hipFuncSetAttribute((const void*)mk::mega, hipFuncAttributeMaxDynamicSharedMemorySize, mk::LDS_BYTES);
        hipOccupancyMaxActiveBlocksPerMultiprocessor(&per_cu, (const void*)mk::mega, mk::NTHR, mk::LDS_BYTES);
        (void)hipGetLastError();
        if (per_cu < 1) fprintf(stderr, "kernel_launch: occupancy query says %d blocks/CU\n", per_cu);
        grid = cus > 0 ? cus : 256;
    }
    hipMemsetAsync(ws + mk::WS_CTL, 0, 1u << 20, stream);
    mk::Args a{};
    for (int i = 0; i < 25; ++i) a.in[i] = (const float*)d_in[i];
    a.out = out; a.ws = (unsigned char*)d_ws;
    const int nph = (MK_CUT == 1) ? 6 : (MK_CUT == 2) ? 9 : (MK_CUT == 3) ? 17 : 21;
#if MK_ONE_LAUNCH
    a.ph_lo = 0; a.ph_hi = nph;
    hipLaunchKernelGGL(mk::mega, dim3(grid), dim3(mk::NTHR), mk::LDS_BYTES, stream, a);
#else
    for (int p = 0; p < nph; ++p) { a.ph_lo = p; a.ph_hi = p + 1;
#ifdef CMP_SCAN
        if (p == 3) { unsigned short* A0 = (unsigned short*)(ws + mk::WS_ACT); const size_t SL = mk::ACT_SLOT / 2; int* flag = (int*)(ws + 255 * (1u << 20));
            hipMemcpyAsync(d_out, A0, mk::ACT_SLOT, hipMemcpyDeviceToDevice, stream);
            hipLaunchKernelGGL(k_refscan, dim3(32), dim3(128), 0, stream, (unsigned short*)d_out, A0 + SL, A0 + 2 * SL, A0 + 3 * SL, A0 + 4 * SL, (const float*)(ws + mk::WS_SIDE));
            hipMemcpyAsync(A0 + 2 * SL, A0 + 2 * SL, 0, hipMemcpyDeviceToDevice, stream);
            hipLaunchKernelGGL(mk::mega, dim3(grid), dim3(mk::NTHR), mk::LDS_BYTES, stream, a);
            hipLaunchKernelGGL(k_flag1000, dim3(1), dim3(64), 0, stream, flag);
            hipLaunchKernelGGL(k_cmpscan, dim3(132, 16), dim3(256), 0, stream, A0, (const unsigned short*)d_out, flag);
            { const size_t n = (size_t)16384 * 1024; hipLaunchKernelGGL(k_diagout2, dim3((n + 255) / 256), dim3(256), 0, stream, (float*)d_out, n, flag); }
            return; }
#endif
#ifdef USE_REFSCAN
        if (p == 3) { unsigned short* A0 = (unsigned short*)(ws + mk::WS_ACT); const size_t SL = mk::ACT_SLOT / 2;
            hipLaunchKernelGGL(k_refscan, dim3(32), dim3(128), 0, stream, A0, A0 + SL, A0 + 2 * SL, A0 + 3 * SL, A0 + 4 * SL, (const float*)(ws + mk::WS_SIDE)); continue; }
#endif
        hipLaunchKernelGGL(mk::mega, dim3(grid), dim3(mk::NTHR), mk::LDS_BYTES, stream, a); }
#endif
    const size_t MB = 1u << 20;
    float* CXLAT = (float*)(ws + mk::WS_CXLAT);
    float* MOD = (float*)(ws + mk::WS_MOD);
    char* arena = ws + 14 * MB;
    const size_t RBD = (size_t)RB * D * 4;
    float* BUF_H = (float*)(arena);
    float* BUF_O = (float*)(arena + RBD);
    float* BUF_Z = (float*)(arena + 2 * RBD);
    auto ffn = [&](int l, float* lat_seq, int seq_len, const float* modv) {
        const float* sh2 = modv + 3 * D; const float* sc2 = modv + 4 * D; const float* g2 = modv + 5 * D;
        const float* Wup = ffn_up + (size_t)l * D * 2 * DFF; const float* Wdn = ffn_down + (size_t)l * DFF * D;
        const float* cw = ffn_cw + (size_t)l * 3 * 2 * DFF; const float* cb = ffn_cb + (size_t)l * 2 * DFF;
        float* Hn = BUF_H;
        hipLaunchKernelGGL(k_norm_mod, dim3(seq_len), dim3(256), 0, stream, lat_seq, Hn, norm_g + (size_t)(l * 2 + 1) * D, sh2, sc2, seq_len);
        const int CH = 2048;
        float* U = BUF_Z; float* G = BUF_Z + (size_t)(CH + 2) * 2 * DFF; float* Y = G + (size_t)CH * DFF;
        for (int r0 = 0; r0 < seq_len; r0 += CH) {
            const int r1 = (r0 + CH < seq_len) ? r0 + CH : seq_len;
            const int u0 = r0 > 0 ? r0 - 1 : 0, u1 = r1 < seq_len ? r1 + 1 : seq_len;
            gemm(stream, Hn + (size_t)u0 * D, D, Wup, 2 * DFF, U, 2 * DFF, u1 - u0, 2 * DFF, D);
            const size_t n = (size_t)(r1 - r0) * DFF;
            hipLaunchKernelGGL(k_ffn_conv, dim3((n + 255) / 256), dim3(256), 0, stream, U, u0, cw, cb, G, r0, r1, seq_len);
            gemm(stream, G, DFF, Wdn, D, Y, D, r1 - r0, D, DFF);
            const size_t n2 = (size_t)(r1 - r0) * D;
            hipLaunchKernelGGL(k_resid, dim3((n2 + 255) / 256), dim3(256), 0, stream, lat_seq + (size_t)r0 * D, Y, g2, lat_seq + (size_t)r0 * D, n2);
        }
    };
    for (int b = 0; b < BATCH; ++b) {
        float* latL = out + (size_t)b * SEQ * D; float* latC = CXLAT + (size_t)b * CTX * D;
        if (MK_CUT < 2) {
            const float* modL = MOD + (size_t)b * 6 * D; const float* modC = MOD + (size_t)2 * 6 * D;
            ffn(0, latL, SEQ, modL);
            ffn(0, latC, CTX, modC);
        }
        if (MK_CUT < 3) {
            const float* modL = MOD + (size_t)18 * D + (size_t)b * 6 * D; const float* modC = MOD + (size_t)18 * D + (size_t)2 * 6 * D;
            const float* ng = norm_g + (size_t)2 * D;
            hipLaunchKernelGGL(k_norm_mod, dim3(CTX), dim3(256), 0, stream, latC, BUF_H, ng, modC, modC + D, CTX);
            hipLaunchKernelGGL(k_norm_mod, dim3(SEQ), dim3(256), 0, stream, latL, BUF_H + (size_t)CTX * D, ng, modL, modL + D, SEQ);
            float* Z2 = BUF_Z; float* XC = BUF_Z + (size_t)RB * 2 * D; float* PA = XC + (size_t)RB * D; float* PX = PA + (size_t)RB * D;
            float* Hf = BUF_H; float* Hb = BUF_O;
            gemm(stream, BUF_H, D, lru_w_in, 2 * D, Z2, 2 * D, RB, 2 * D, D);
            { const size_t n = (size_t)RB * D; hipLaunchKernelGGL(k_lru_conv, dim3((n + 255) / 256), dim3(256), 0, stream, Z2, lru_cw, lru_cb, XC); }
            for (int d = 0; d < 2; ++d) {
                for (int nb = 0; nb < 4; ++nb) {
                    gemm(stream, XC + nb * 256, D, lru_wa + (size_t)(d * 4 + nb) * 256 * 256, 256, PA + nb * 256, D, RB, 256, 256);
                    gemm(stream, XC + nb * 256, D, lru_wx + (size_t)(d * 4 + nb) * 256 * 256, 256, PX + nb * 256, D, RB, 256, 256);
                }
                hipLaunchKernelGGL(k_lru_scan, dim3(D / 64), dim3(64), 0, stream, XC, PA, PX, lru_ba, lru_bx, lru_lam, d ? Hb : Hf, d);
            }
            float* Y = PA;
            { const size_t n = (size_t)SEQ * D; hipLaunchKernelGGL(k_lru_out, dim3((n + 255) / 256), dim3(256), 0, stream, Hf, Hb, Z2, Y); }
            float* Y2 = PX;
            gemm(stream, Y, D, lru_w_out, D, Y2, D, SEQ, D, D);
            { const size_t n = (size_t)SEQ * D; hipLaunchKernelGGL(k_resid, dim3((n + 255) / 256), dim3(256), 0, stream, latL, Y2, modL + 2 * D, latL, n); }
        }
        if (MK_CUT < 4) {
            const float* modL = MOD + (size_t)18 * D + (size_t)b * 6 * D;
            ffn(1, latL, SEQ, modL);
            hipLaunchKernelGGL(k_norm_mod, dim3(SEQ), dim3(256), 0, stream, latL, latL, final_g, (const float*)nullptr, (const float*)nullptr, SEQ);
        }
    }
}
```
